# Optimizing an MI355X kernel written in HIP

```python
import math
import jax, jax.numpy as jnp
from jax import lax
import numpy as np

D_MODEL = 1024
BATCH = 8
SEQ = 4096
DEPTH = 2

GRID_W = 64
CTX_LEN = 256
EPS = 1e-6
ROPE_BASE = 10000.0

ATT_HEADS = 4
ATT_QK = 64
ATT_V = 2 * ATT_QK
ATT_W = ATT_HEADS * ATT_V
ATT_BLOCK = 128

RET_HEADS = 4
RET_QK = 64
RET_V = 64
RET_W = RET_HEADS * RET_V
RET_CHUNK = 128

LRU_W = 256
LRU_BLOCKS = 4
LRU_BW = LRU_W // LRU_BLOCKS
LRU_CONV = 4
LRU_C = 8.0

MIX_W = ATT_W + RET_W + LRU_W
IN_SPLITS = (ATT_HEADS * 2 * ATT_QK, ATT_HEADS * 2 * ATT_QK, ATT_W,
             RET_HEADS * RET_QK, RET_HEADS * RET_QK, RET_W, RET_W, LRU_W, LRU_W)
IN_COLS = sum(IN_SPLITS)

N_EXPERTS = 16
EC_CAPACITY = 2
MOE_FF = 1024

kernel_name = 'hybrid_diffusion_diffattn_retention_rglru_ecmoe'


def _rms(x, g):
    xf = x.astype(jnp.float32)
    y = xf * lax.rsqrt(jnp.mean(xf * xf, axis=-1, keepdims=True) + EPS)
    return (y * g.astype(jnp.float32)).astype(x.dtype)


def _modulate(h, shift, scale):
    return h * (1 + scale) + shift


def _rope_tables(n_tokens):
    rows = n_tokens // GRID_W
    row = jnp.repeat(jnp.arange(rows), GRID_W).astype(jnp.float32)
    col = jnp.tile(jnp.arange(GRID_W), rows).astype(jnp.float32)
    axis_dim = ATT_QK // 2
    inv = 1.0 / (ROPE_BASE ** (jnp.arange(0, axis_dim, 2, dtype=jnp.float32) / axis_dim))
    ang = jnp.concatenate([row[:, None] * inv, col[:, None] * inv], axis=-1)
    return jnp.cos(ang), jnp.sin(ang)


def _rotate(t, cos, sin):
    n = t.shape[-1] // 2
    t1, t2 = t[..., :n], t[..., n:]
    return jnp.concatenate([t1 * cos - t2 * sin, t1 * sin + t2 * cos], axis=-1)


def _axial_rope(x, cos, sin):
    a = ATT_QK // 2
    f = a // 2
    out = jnp.concatenate([_rotate(x[..., :a], cos[:, :f], sin[:, :f]),
                           _rotate(x[..., a:], cos[:, f:], sin[:, f:])], axis=-1)
    return out.astype(x.dtype)


def _diff_attn_block(q, k, v, lam):
    s = jnp.einsum('bhmqd,bhmkd->bhmqk', q, k).astype(jnp.float32) * (ATT_QK ** -0.5)
    p = jax.nn.softmax(s, axis=-1)
    a = p[:, :, 0] - lam * p[:, :, 1]
    return jnp.einsum('bhqk,bhkv->bhqv', a, v.astype(jnp.float32))


def _diff_attn_latent(q, k, v, lam):
    b, h, _, n, d = q.shape
    nb = n // ATT_BLOCK
    qb = jnp.moveaxis(q.reshape(b, h, 2, nb, ATT_BLOCK, d), 3, 0)
    ob = lax.map(lambda qq: _diff_attn_block(qq, k, v, lam), qb)
    return jnp.moveaxis(ob, 0, 2).reshape(b, h, n, ATT_V)


def _retention_scan(q, k, v, log_g, s0, inclusive):
    b, h, n_tok, dk = q.shape
    dv = v.shape[-1]
    nc = n_tok // RET_CHUNK
    idx = jnp.arange(RET_CHUNK, dtype=jnp.float32)
    diff = idx[:, None] - idx[None, :]
    mask = (diff >= 0) if inclusive else (diff > 0)
    decay_mat = jnp.where(mask, jnp.exp(log_g[:, None, None] * jnp.where(mask, diff, 0.0)), 0.0)
    cross = jnp.exp(log_g[:, None] * (idx + 1.0))[..., None]
    inner = jnp.exp(log_g[:, None] * (RET_CHUNK - 1.0 - idx))[..., None]
    chunk_decay = jnp.exp(log_g * RET_CHUNK)[:, None, None]
    qs = jnp.moveaxis(q.reshape(b, h, nc, RET_CHUNK, dk), 2, 0)
    ks = jnp.moveaxis(k.reshape(b, h, nc, RET_CHUNK, dk), 2, 0)
    vs = jnp.moveaxis(v.reshape(b, h, nc, RET_CHUNK, dv), 2, 0)

    def step(s, inp):
        qc, kc, vc = inp
        sc = jnp.einsum('bhnd,bhmd->bhnm', qc, kc) * decay_mat
        o = jnp.einsum('bhnm,bhmv->bhnv', sc, vc) + jnp.einsum('bhnd,bhdv->bhnv', qc, s) * cross
        s = s * chunk_decay + jnp.einsum('bhmd,bhmv->bhdv', kc * inner, vc)
        return s, o

    s, o = lax.scan(step, s0, (qs, ks, vs))
    return jnp.moveaxis(o, 0, 2).reshape(b, h, n_tok, dv), s


def _retention_state(k, v, log_g):
    n_tok = k.shape[2]
    w = jnp.exp(log_g[:, None] * (n_tok - 1.0 - jnp.arange(n_tok, dtype=jnp.float32)))
    return jnp.einsum('bhld,hl,bhlv->bhdv', k, w, v)


def _short_conv(t, w, bias):
    y = lax.conv_general_dilated(t, w[:, None, :].astype(t.dtype), window_strides=(1,),
                                 padding=[(LRU_CONV // 2, LRU_CONV - 1 - LRU_CONV // 2)],
                                 dimension_numbers=('NWC', 'WIO', 'NWC'),
                                 feature_group_count=LRU_W)
    return y + bias


def _lin_combine(left, right):
    a1, b1 = left
    a2, b2 = right
    return a1 * a2, a2 * b1 + b2


def _rglru(x, gate_w, gate_b, lam, h0):
    x = x.astype(jnp.float32)
    b, n_tok, _ = x.shape
    xb = x.reshape(b, n_tok, LRU_BLOCKS, LRU_BW)
    gates = jnp.einsum('blnc,gncd->gblnd', xb, gate_w.astype(jnp.float32)).reshape(2, b, n_tok, LRU_W)
    gates = gates + gate_b.astype(jnp.float32)[:, None, None, :]
    r = jax.nn.sigmoid(gates[0])
    i = jax.nn.sigmoid(gates[1])
    log_a = -LRU_C * jax.nn.softplus(-lam.astype(jnp.float32)) * r
    a = jnp.exp(log_a)
    u = jnp.sqrt(-jnp.expm1(2.0 * log_a)) * (i * x)
    u = u.at[:, 0].add(a[:, 0] * h0)
    _, h = lax.associative_scan(_lin_combine, (a, u), axis=1)
    return h


def _mixer(hl, hc, cos, sin, layer_idx, need_ctx, w_in, w_out, q_norm_g, k_norm_g, lam_p, subln_g,
           ret_log_decay, ret_norm_g, conv_w, conv_b, gate_w, gate_b, lru_lam, lru_norm_g):
    f32 = jnp.float32
    cuts = np.cumsum(IN_SPLITS)[:-1].tolist()
    qa_l, ka_l, va_l, qr_l, kr_l, vr_l, gr_l, xu_l, gu_l = jnp.split(hl @ w_in, cuts, axis=-1)
    qa_c, ka_c, va_c, qr_c, kr_c, vr_c, gr_c, xu_c, gu_c = jnp.split(hc @ w_in, cuts, axis=-1)

    def qk_heads(t, g):
        b_, n_, _ = t.shape
        return _rms(t.reshape(b_, n_, ATT_HEADS, 2, ATT_QK).transpose(0, 2, 3, 1, 4), g)

    def heads(t, hd):
        b_, n_, _ = t.shape
        return t.reshape(b_, n_, -1, hd).transpose(0, 2, 1, 3)

    def merge(o):
        b_, h_, n_, hd = o.shape
        return o.transpose(0, 2, 1, 3).reshape(b_, n_, h_ * hd)

    lam_init = 0.8 - 0.6 * math.exp(-0.3 * layer_idx)
    lp = lam_p.astype(f32)
    lam = jnp.exp(jnp.sum(lp[0] * lp[1])) - jnp.exp(jnp.sum(lp[2] * lp[3])) + lam_init
    q_l = _axial_rope(qk_heads(qa_l, q_norm_g), cos, sin)
    k_l = _axial_rope(qk_heads(ka_l, k_norm_g), cos, sin)
    k_c = qk_heads(ka_c, k_norm_g)
    v_l = heads(va_l, ATT_V)
    v_c = heads(va_c, ATT_V)
    k_all = jnp.concatenate([k_c, k_l], axis=3)
    v_all = jnp.concatenate([v_c, v_l], axis=2)

    def att_out(o):
        return merge(_rms(o, subln_g) * (1.0 - lam_init))

    att_l = att_out(_diff_attn_latent(q_l, k_all, v_all, lam))

    flip = lambda t: t[:, :, ::-1]
    lg_f = ret_log_decay[0].astype(f32)
    lg_b = ret_log_decay[1].astype(f32)
    kscale = RET_QK ** -0.5
    rq_l = heads(qr_l, RET_QK).astype(f32)
    rk_l = (heads(kr_l, RET_QK) * kscale).astype(f32)
    rv_l = heads(vr_l, RET_V).astype(f32)
    rk_c = (heads(kr_c, RET_QK) * kscale).astype(f32)
    rv_c = heads(vr_c, RET_V).astype(f32)
    if need_ctx:
        rq_c = heads(qr_c, RET_QK).astype(f32)
        zero_s = jnp.zeros((hc.shape[0], RET_HEADS, RET_QK, RET_V), f32)
        o_cf, s_cf = _retention_scan(rq_c, rk_c, rv_c, lg_f, zero_s, True)
        o_cb, s_cb = _retention_scan(flip(rq_c), flip(rk_c), flip(rv_c), lg_b, zero_s, False)
    else:
        s_cf = _retention_state(rk_c, rv_c, lg_f)
        s_cb = _retention_state(flip(rk_c), flip(rv_c), lg_b)
    o_lf, _ = _retention_scan(rq_l, rk_l, rv_l, lg_f, s_cf, True)
    o_lb, _ = _retention_scan(flip(rq_l), flip(rk_l), flip(rv_l), lg_b, s_cb, False)

    def ret_out(o, g):
        return merge(_rms(o, ret_norm_g)) * jax.nn.silu(g.astype(f32))

    ret_l = ret_out(o_lf + flip(o_lb), gr_l)

    u_l = _short_conv(xu_l, conv_w, conv_b)
    u_c = _short_conv(xu_c, conv_w, conv_b)
    h0 = jnp.zeros((hc.shape[0], LRU_W), f32)
    lc_f = _rglru(u_c, gate_w[0], gate_b[0], lru_lam[0], h0)
    ll_f = _rglru(u_l, gate_w[0], gate_b[0], lru_lam[0], lc_f[:, -1])
    lc_b = _rglru(u_c[:, ::-1], gate_w[1], gate_b[1], lru_lam[1], h0)
    ll_b = _rglru(u_l[:, ::-1], gate_w[1], gate_b[1], lru_lam[1], lc_b[:, -1])

    def lru_out(hf, hb_rev, g):
        return _rms((hf + hb_rev[:, ::-1]) * jax.nn.gelu(g.astype(f32)), lru_norm_g)

    lru_l = lru_out(ll_f, ll_b, gu_l)

    mix_l = jnp.concatenate([att_l, ret_l, lru_l], axis=-1).astype(hl.dtype) @ w_out
    if not need_ctx:
        return mix_l, None
    att_c = att_out(_diff_attn_block(qk_heads(qa_c, q_norm_g), k_c, v_c, lam))
    ret_c = ret_out(o_cf + flip(o_cb), gr_c)
    lru_c = lru_out(lc_f, lc_b, gu_c)
    mix_c = jnp.concatenate([att_c, ret_c, lru_c], axis=-1).astype(hc.dtype) @ w_out
    return mix_l, mix_c


def _expert_choice_ffn(h, router_w, w_gate, w_up, w_down):
    b, n_tok, _ = h.shape
    cap = EC_CAPACITY * n_tok // N_EXPERTS
    probs = jax.nn.softmax((h @ router_w).astype(jnp.float32), axis=-1)
    aff, idx = lax.top_k(jnp.swapaxes(probs, 1, 2), cap)
    bidx = jnp.arange(b)[:, None, None]
    xs = h[bidx, idx]
    hid = jax.nn.silu(jnp.einsum('becd,edf->becf', xs, w_gate)) * jnp.einsum('becd,edf->becf', xs, w_up)
    out = jnp.einsum('becf,efd->becd', hid, w_down) * aff[..., None]
    return jnp.zeros_like(h).at[bidx, idx].add(out.astype(h.dtype))


def setup_inputs(seed: int = 0) -> dict:
    key = jax.random.key(seed)
    ks = jax.random.split(key, 32)
    f32 = jnp.float32
    D = D_MODEL

    def nrm(k, shape, scale):
        return jax.random.normal(k, shape, f32) * scale

    ret_base = jnp.asarray(np.log(1.0 - 2.0 ** (-5.0 - np.arange(RET_HEADS))), f32)
    u = jax.random.uniform(ks[20], (DEPTH, 2, LRU_W), f32, 0.9, 0.999)
    a0 = u ** (1.0 / LRU_C)
    return {
        'x': nrm(ks[0], (BATCH, SEQ, D), 1.0),
        'c': nrm(ks[1], (BATCH, D), 1.0),
        'ctx': nrm(ks[2], (BATCH, CTX_LEN, D), 1.0),
        'c_ctx': nrm(ks[3], (D,), 1.0),
        'mod_w': nrm(ks[4], (DEPTH, D, 6 * D), 0.5 * D ** -0.5),
        'mod_b': nrm(ks[5], (DEPTH, 6 * D), 0.01),
        'norm1_g': 1.0 + nrm(ks[6], (DEPTH, D), 0.02),
        'norm2_g': 1.0 + nrm(ks[7], (DEPTH, D), 0.02),
        'w_in': nrm(ks[8], (DEPTH, D, IN_COLS), D ** -0.5),
        'w_out': nrm(ks[9], (DEPTH, MIX_W, D), MIX_W ** -0.5),
        'att_q_norm_g': 1.0 + nrm(ks[10], (DEPTH, ATT_QK), 0.02),
        'att_k_norm_g': 1.0 + nrm(ks[11], (DEPTH, ATT_QK), 0.02),
        'att_lambda': nrm(ks[12], (DEPTH, 4, ATT_QK), 0.1),
        'att_subln_g': 1.0 + nrm(ks[13], (DEPTH, ATT_V), 0.02),
        'ret_log_decay': ret_base * jnp.exp(nrm(ks[14], (DEPTH, 2, RET_HEADS), 0.1)),
        'ret_norm_g': 1.0 + nrm(ks[15], (DEPTH, RET_V), 0.02),
        'lru_conv_w': nrm(ks[16], (DEPTH, LRU_CONV, LRU_W), LRU_CONV ** -0.5),
        'lru_conv_b': nrm(ks[17], (DEPTH, LRU_W), 0.01),
        'lru_gate_w': nrm(ks[18], (DEPTH, 2, 2, LRU_BLOCKS, LRU_BW, LRU_BW), LRU_BW ** -0.5),
        'lru_gate_b': nrm(ks[19], (DEPTH, 2, 2, LRU_W), 0.01),
        'lru_lambda': jnp.log(a0) - jnp.log1p(-a0),
        'lru_norm_g': 1.0 + nrm(ks[21], (DEPTH, LRU_W), 0.02),
        'router_w': nrm(ks[22], (DEPTH, D, N_EXPERTS), D ** -0.5),
        'exp_w_gate': nrm(ks[23], (DEPTH, N_EXPERTS, D, MOE_FF), D ** -0.5),
        'exp_w_up': nrm(ks[24], (DEPTH, N_EXPERTS, D, MOE_FF), D ** -0.5),
        'exp_w_down': nrm(ks[25], (DEPTH, N_EXPERTS, MOE_FF, D), MOE_FF ** -0.5),
    }


def reference(x, c, ctx, c_ctx, mod_w, mod_b, norm1_g, norm2_g, w_in, w_out, att_q_norm_g, att_k_norm_g,
              att_lambda, att_subln_g, ret_log_decay, ret_norm_g, lru_conv_w, lru_conv_b, lru_gate_w,
              lru_gate_b, lru_lambda, lru_norm_g, router_w, exp_w_gate, exp_w_up, exp_w_down):
    cos, sin = _rope_tables(x.shape[1])
    silu_c = jax.nn.silu(c)
    silu_cc = jax.nn.silu(c_ctx)
    xl, xc = x, ctx
    for i in range(DEPTH):
        need_ctx = i < DEPTH - 1
        sh1_l, sc1_l, g1_l, sh2_l, sc2_l, g2_l = jnp.split((silu_c @ mod_w[i] + mod_b[i])[:, None, :], 6, axis=-1)
        sh1_c, sc1_c, g1_c, sh2_c, sc2_c, g2_c = jnp.split(silu_cc @ mod_w[i] + mod_b[i], 6, axis=-1)
        hl = _modulate(_rms(xl, norm1_g[i]), sh1_l, sc1_l)
        hc = _modulate(_rms(xc, norm1_g[i]), sh1_c, sc1_c)
        mix_l, mix_c = _mixer(hl, hc, cos, sin, i, need_ctx, w_in[i], w_out[i], att_q_norm_g[i],
                              att_k_norm_g[i], att_lambda[i], att_subln_g[i], ret_log_decay[i], ret_norm_g[i],
                              lru_conv_w[i], lru_conv_b[i], lru_gate_w[i], lru_gate_b[i], lru_lambda[i],
                              lru_norm_g[i])
        xl = xl + g1_l * mix_l
        xl = xl + g2_l * _expert_choice_ffn(_modulate(_rms(xl, norm2_g[i]), sh2_l, sc2_l),
                                            router_w[i], exp_w_gate[i], exp_w_up[i], exp_w_down[i])
        if need_ctx:
            xc = xc + g1_c * mix_c
            xc = xc + g2_c * _expert_choice_ffn(_modulate(_rms(xc, norm2_g[i]), sh2_c, sc2_c),
                                                router_w[i], exp_w_gate[i], exp_w_up[i], exp_w_down[i])
    return xl
```

```cpp
#include <hip/hip_runtime.h>
#include <hip/hip_cooperative_groups.h>
#include <cstdio>
#include <cstdint>
namespace cg = cooperative_groups;
#define DEV __device__ __forceinline__
#ifndef PM
#define PM 0xffff
#endif
#ifndef USE_FP8_MOE1
#define USE_FP8_MOE1 1
#endif
#ifndef USE_FP8_MOE2
#define USE_FP8_MOE2 1
#endif
#ifndef USE_MFMA_LRU
#define USE_MFMA_LRU 1
#endif
#ifndef USE_GEMM_GATHER
#define USE_GEMM_GATHER 1
#endif
#ifndef USE_MFMA_RET
#define USE_MFMA_RET 1
#endif
#ifndef USE_MFMA_ATTN
#define USE_MFMA_ATTN 1
#endif
#ifndef USE_MFMA_GEMM
#define USE_MFMA_GEMM 1
#endif
#ifndef N_LAUNCH_MODE
#define N_LAUNCH_MODE 1
#endif

typedef unsigned short bf16_t;
typedef float f32x4 __attribute__((ext_vector_type(4)));
typedef unsigned u32x4 __attribute__((ext_vector_type(4)));
typedef unsigned u32x2 __attribute__((ext_vector_type(2)));
typedef short bf16x8_t __attribute__((ext_vector_type(8)));
typedef float f32x16 __attribute__((ext_vector_type(16)));
__device__ __forceinline__ int crow16(int r, int hi) { return (r & 3) + 8 * (r >> 2) + 4 * hi; }
typedef __bf16 bf16x2_t __attribute__((ext_vector_type(2)));
DEV float dot2bf(unsigned w, unsigned x, float acc) { return __builtin_amdgcn_fdot2_f32_bf16(__builtin_bit_cast(bf16x2_t, w), __builtin_bit_cast(bf16x2_t, x), acc, false); }

constexpr int D = 1024, NB = 8, T = 4096, TC = 256;
constexpr int ML = NB * T, MC = NB * TC, M = ML + MC;
constexpr int NE = 16, CAPL = 512, CAPC = 32, SLOTS = NB * CAPL + NB * CAPC;
constexpr int NTHREADS = 512, NWAVES = 8;
constexpr float EPS = 1e-6f;
constexpr float C2 = 0.125f * 1.4426950408889634f;
constexpr int LRU_CH = 136;
constexpr int RET_CH = 34;

constexpr size_t MiB = 1u << 20;
constexpr size_t WS_CTL = 0;
constexpr size_t WS_MOD = 1 * MiB;
constexpr size_t WS_LRUW = 1 * MiB + 512 * 1024;
constexpr size_t WS_PROBL = 2 * MiB;
constexpr size_t WS_PROBC = 4 * MiB;
constexpr size_t WS_IDX = 5 * MiB;
constexpr size_t WS_AFF = 5 * MiB + 512 * 1024;
constexpr size_t WS_SEL = 6 * MiB;
constexpr size_t WS_LAGG = 9 * MiB;
constexpr size_t WS_LCAR = 14 * MiB;
constexpr size_t WS_XC = 17 * MiB;
constexpr size_t WS_RETS = 26 * MiB;
constexpr size_t WS_WT = 60 * MiB;
constexpr size_t WT_IN = 0, WT_OUT = 6 * MiB, WT_GU = 8 * MiB, WT_DN = 72 * MiB;
constexpr size_t WS_XN = 164 * MiB;
constexpr size_t WS_Y = 232 * MiB;
constexpr size_t WS_MIX = 436 * MiB;
constexpr size_t WS_XG = 232 * MiB;
constexpr size_t WS_HID = 368 * MiB;
constexpr size_t WS_Y2 = 232 * MiB;
constexpr size_t WS_VT = 504 * MiB;
constexpr size_t WS_RVT = 540 * MiB;
constexpr size_t WS_END = 557 * MiB;
constexpr size_t YARR = (size_t)M * 256;

constexpr int LDS_BYTES = 147456;

struct Args { const float* in[26]; float* out; unsigned char* ws; int ph_lo, ph_hi; };


__device__ __forceinline__ int ltid() { int t = __builtin_amdgcn_workitem_id_x(); asm volatile("" : "+v"(t)); return t; }
namespace pg8 {
#define PG8_LAS __attribute__((address_space(3)))
typedef unsigned short bf16_t;
typedef short bf16x8 __attribute__((ext_vector_type(8)));
typedef float f32x4 __attribute__((ext_vector_type(4)));
typedef unsigned u32x4 __attribute__((ext_vector_type(4)));
typedef int i32x4 __attribute__((ext_vector_type(4)));
typedef int i32x8 __attribute__((ext_vector_type(8)));
constexpr int BM = 256, BK = 64, HALF = 128, HTB = HALF * BK * 2  , STAGE_BYTES = 8 * HTB, NXCD = 8, WGM = 8;

__host__ __device__ __forceinline__ int lds_byte(int r, int c) { const int st = (r >> 4) * 2 + (c >> 5), rr = r & 15, cc = c & 31, ob = rr * 64 + cc * 2; return st * 1024 + (ob ^ (((ob >> 9) & 1) << 5)); }
__host__ __device__ __forceinline__ void stage_rc(int b, int& R, int& C) { const int st = b / 1024, sb = b % 1024, swz = sb ^ (((sb >> 9) & 1) << 5); R = (st >> 1) * 16 + swz / 64; C = (st & 1) * 32 + (swz % 64) / 2; }
__host__ __device__ __forceinline__ int perm32(int rho) { const int n = rho >> 4, i = rho & 15; return 8 * (i >> 2) + 4 * n + (i & 3); }

struct Unit { int pm, pn; };
struct Gemm { const bf16_t* A; const bf16_t* Bt; int M, N, K; };

struct StaticOrder {
    int nM, nN, nwg, G, c;
    __host__ __device__ void init(int M, int N, int G_, int c_) { nM = M / BM; nN = N / BM; nwg = nM * nN; G = G_; c = c_; }
    __host__ __device__ bool next(int i, Unit& u) const {
        const long L = (long)i * G + c; if (L >= nwg) return false;
        int wgid = (int)L; { const int q = nwg / NXCD, r = nwg % NXCD, xcd = wgid % NXCD, off = wgid / NXCD; wgid = (xcd < r ? xcd * (q + 1) : r * (q + 1) + (xcd - r) * q) + off; }
        const int nig = WGM * nN, gid = wgid / nig, fm = gid * WGM, gsz = (nM - fm) < WGM ? (nM - fm) : WGM;
        u.pm = fm + ((wgid % nig) % gsz); u.pn = (wgid % nig) / gsz; return true;
    }
    __device__ __forceinline__ void a_ready(const Unit&) const {}
    __device__ __forceinline__ void done(const Unit&) const {}
};

__device__ __forceinline__ unsigned cvt_pk_bf16(float lo, float hi) { unsigned r; asm volatile("v_cvt_pk_bf16_f32 %0, %1, %2" : "=v"(r) : "v"(lo), "v"(hi)); return r; }
typedef float f32x2 __attribute__((ext_vector_type(2)));
__device__ __forceinline__ f32x2 gelu_pk(f32x2 v) {
    const f32x2 av = __builtin_elementwise_abs(v), d = av * 0.2316418882f + 1.0f;
    f32x2 t; t.x = __builtin_amdgcn_rcpf(d.x); t.y = __builtin_amdgcn_rcpf(d.y);
    f32x2 q = t * 0.5307027145f + (-0.7265760135f); q = q * t + 0.7107068705f; q = q * t + (-0.142248368f); q = q * t + 0.127414796f; q = q * t;
    const f32x2 s = (v * v) * (-0.72134752044f);
    f32x2 e; e.x = __builtin_amdgcn_exp2f(s.x); e.y = __builtin_amdgcn_exp2f(s.y);
    const f32x2 m = v * (q * e), r = v - m;
    f32x2 o; o.x = v.x < 0.f ? m.x : r.x; o.y = v.y < 0.f ? m.y : r.y; return o;
}

template <int ACT  > struct EpiBf16 {
    static constexpr bool PERM = true, AFTER_DRAIN = false; static_assert(ACT == 0 || ACT == 1, "EpiBf16: ACT is 0 (none) or 1 (gelu_pk)");
    bf16_t* O; int ldc; const float* bias; int split_cols; size_t split_stride; float scale0;
    __device__ __forceinline__ void operator()(const f32x4 (&acc)[2][2][4][2], const Unit& u, int wr, int wc, int fr, int fq) const {
        const int row0 = u.pm * BM + wr * 64 + fr; int colt = u.pn * BM; bf16_t* base = O;
        float sc = 1.f; if (split_cols) { const int t = colt / split_cols; base += (size_t)t * split_stride; colt -= t * split_cols; if (t == 0) sc = scale0; }
        const int col0 = colt + wc * 32 + 8 * fq, bcol0 = u.pn * BM + wc * 32 + 8 * fq;
        f32x4 bv[2][2];
#pragma unroll
        for (int bj = 0; bj < 2; ++bj)
#pragma unroll
            for (int n = 0; n < 2; ++n) bv[bj][n] = bias ? *(const f32x4*)(bias + bcol0 + bj * HALF + 4 * n) : (f32x4){0.f, 0.f, 0.f, 0.f};
#pragma unroll
        for (int ai = 0; ai < 2; ++ai)
#pragma unroll
            for (int m = 0; m < 4; ++m) { bf16_t* rowp = base + (size_t)(row0 + ai * HALF + m * 16) * ldc + col0;
#pragma unroll
                for (int bj = 0; bj < 2; ++bj) { f32x4 v0 = acc[ai][bj][m][0] + bv[bj][0], v1 = acc[ai][bj][m][1] + bv[bj][1];
                    if (ACT == 1) { f32x2 a = gelu_pk((f32x2){v0[0], v0[1]}), b = gelu_pk((f32x2){v0[2], v0[3]}), c = gelu_pk((f32x2){v1[0], v1[1]}), d = gelu_pk((f32x2){v1[2], v1[3]});
                        v0 = (f32x4){a.x, a.y, b.x, b.y}; v1 = (f32x4){c.x, c.y, d.x, d.y}; }
                    v0 = v0 * sc; v1 = v1 * sc; u32x4 w; w.x = cvt_pk_bf16(v0[0], v0[1]); w.y = cvt_pk_bf16(v0[2], v0[3]); w.z = cvt_pk_bf16(v1[0], v1[1]); w.w = cvt_pk_bf16(v1[2], v1[3]);
                    *(u32x4*)(rowp + bj * HALF) = w; } }
    }
};
template <class Epi, class Sched, bool ALIGN_EPI = false, bool SP2 = false>
__device__ __forceinline__ void gemm_phase(PG8_LAS unsigned char* lds, const Gemm g, const Sched& S, const Epi& E) {
    const int tid = ltid(), wid = __builtin_amdgcn_readfirstlane(tid >> 6), lane = tid & 63, wr = wid >> 2, wc = wid & 3, fr = lane & 15, fq = lane >> 4;
    const int K = g.K, nt = K / BK;
    unsigned voffA[2], voffB[2];
#pragma unroll
    for (int i = 0; i < 2; ++i) { int R, C; stage_rc(tid * 16 + i * 8192, R, C); const int Rb = Epi::PERM ? ((R & ~31) + perm32(R & 31)) : R;
        voffA[i] = (unsigned)(R * K + C) * 2u; voffB[i] = (unsigned)(Rb * K + C) * 2u; }
    const size_t kstep = (size_t)(BK * 2);
    const size_t hstep = (size_t)HALF * K * 2;
    const size_t tstep = 2 * hstep;
    const unsigned ldsw = (unsigned)wid * 1024u;
    const int aoff = lds_byte(wr * 64 + fr, fq * 8), boff = lds_byte(wc * 32 + fr, fq * 8);
#define PG8_SA(b, h) (((b) * 2 + (h)) * HTB)
#define PG8_SB(b, h) ((4 + (b) * 2 + (h)) * HTB)
#define PG8_STAGE(bufoff, gbase, voff) do { _Pragma("unroll") for (int _i = 0; _i < 2; ++_i) \
        __builtin_amdgcn_global_load_lds((const unsigned*)((const char*)(gbase) + (voff)[_i]), (PG8_LAS unsigned*)(lds + (bufoff) + ldsw + _i * 8192), 16, 0, 0); } while (0)
#define PG8_LDA(dst, b, h) do { _Pragma("unroll") for (int m = 0; m < 4; ++m) _Pragma("unroll") for (int k = 0; k < 2; ++k) dst[m][k] = *(const PG8_LAS bf16x8*)(lds + PG8_SA(b, h) + aoff + m * 2048 + k * 1024); } while (0)
#define PG8_LDB(dst, b, h) do { _Pragma("unroll") for (int n = 0; n < 2; ++n) _Pragma("unroll") for (int k = 0; k < 2; ++k) dst[n][k] = *(const PG8_LAS bf16x8*)(lds + PG8_SB(b, h) + boff + n * 2048 + k * 1024); } while (0)
#define PG8_MMA(ai, bj, At, Bt) do { __builtin_amdgcn_s_setprio(1); _Pragma("unroll") for (int m = 0; m < 4; ++m) _Pragma("unroll") for (int n = 0; n < 2; ++n) _Pragma("unroll") for (int k = 0; k < 2; ++k) \
        acc[ai][bj][m][n] = __builtin_amdgcn_mfma_f32_16x16x32_bf16(Bt[n][k], At[m][k], acc[ai][bj][m][n], 0, 0, 0); __builtin_amdgcn_s_setprio(0); } while (0)
#define PG8_WAIT_V(n) asm volatile("s_waitcnt vmcnt(" #n ")" ::: "memory")
#define PG8_WAIT_L(n) asm volatile("s_waitcnt lgkmcnt(" #n ")" ::: "memory")
#define PG8_BAR __builtin_amdgcn_s_barrier()
#define PG8_SCHED __builtin_amdgcn_sched_barrier(0)
    Unit cur, nxt; int ui = 0;
    if (!S.next(0, cur)) return;
    f32x4 acc[2][2][4][2];
#pragma unroll
    for (int a = 0; a < 2; ++a)
#pragma unroll
        for (int b = 0; b < 2; ++b)
#pragma unroll
            for (int m = 0; m < 4; ++m)
#pragma unroll
                for (int n = 0; n < 2; ++n) acc[a][b][m][n] = (f32x4){0.f, 0.f, 0.f, 0.f};
    bf16x8 At[4][2], B0[2][2], B1[2][2];
    const char* cA = (const char*)g.A + (size_t)cur.pm * tstep; const char* cB = (const char*)g.Bt + (size_t)cur.pn * tstep;
    S.a_ready(cur);
    if constexpr (SP2) {
        PG8_STAGE(PG8_SB(0, 0), cB, voffB); PG8_STAGE(PG8_SB(0, 1), cB + hstep, voffB); PG8_STAGE(PG8_SA(0, 0), cA, voffA); PG8_STAGE(PG8_SA(0, 1), cA + hstep, voffA);
        if (wr == 1) PG8_BAR;
        PG8_WAIT_V(2); PG8_BAR;
        PG8_STAGE(PG8_SB(1, 0), cB + kstep, voffB); PG8_STAGE(PG8_SA(1, 0), cA + kstep, voffA); PG8_STAGE(PG8_SB(1, 1), cB + hstep + kstep, voffB);
        PG8_WAIT_V(6); PG8_BAR;
    } else {
        PG8_STAGE(PG8_SB(0, 0), cB, voffB); PG8_STAGE(PG8_SA(0, 0), cA, voffA); PG8_STAGE(PG8_SB(0, 1), cB + hstep, voffB); PG8_STAGE(PG8_SA(0, 1), cA + hstep, voffA);
        if (wr == 1) PG8_BAR;
        PG8_WAIT_V(4); PG8_BAR;
        PG8_STAGE(PG8_SB(1, 0), cB + kstep, voffB); PG8_STAGE(PG8_SA(1, 0), cA + kstep, voffA); PG8_STAGE(PG8_SB(1, 1), cB + hstep + kstep, voffB);
        PG8_WAIT_V(6); PG8_BAR;
    }
    for (;;) {
        const bool has_next = S.next(ui + 1, nxt);
        const char* nA = has_next ? (const char*)g.A + (size_t)nxt.pm * tstep : cA; const char* nB = has_next ? (const char*)g.Bt + (size_t)nxt.pn * tstep : cB;
        for (int t = 0; t < nt; t += 2) {
            const bool last = (t == nt - 2);
            const char* a1 = cA + (size_t)(t + 1) * kstep;
            const char* a2 = last ? nA : cA + (size_t)(t + 2) * kstep; const char* b2 = last ? nB : cB + (size_t)(t + 2) * kstep;
            const char* a3 = a2 + kstep; const char* b3 = b2 + kstep;
            if (last && has_next) S.a_ready(nxt);
            if constexpr (SP2) {
            PG8_LDB(B0, 0, 0); PG8_LDB(B1, 0, 1); PG8_SCHED; PG8_LDA(At, 0, 0); PG8_STAGE(PG8_SA(1, 1), a1 + hstep, voffA);
            PG8_WAIT_V(8); PG8_WAIT_L(0); PG8_BAR; PG8_MMA(0, 0, At, B0); PG8_MMA(0, 1, At, B1); PG8_BAR; PG8_SCHED;
            PG8_LDA(At, 0, 1); PG8_STAGE(PG8_SB(0, 0), b2, voffB); PG8_STAGE(PG8_SB(0, 1), b2 + hstep, voffB); PG8_STAGE(PG8_SA(0, 0), a2, voffA);
            PG8_WAIT_V(8); PG8_WAIT_L(0); PG8_BAR; PG8_MMA(1, 0, At, B0); PG8_MMA(1, 1, At, B1); PG8_BAR; PG8_SCHED;
            PG8_LDB(B0, 1, 0); PG8_LDB(B1, 1, 1); PG8_SCHED; PG8_LDA(At, 1, 0); PG8_STAGE(PG8_SA(0, 1), a2 + hstep, voffA);
            PG8_WAIT_V(8); PG8_WAIT_L(0); PG8_BAR; PG8_MMA(0, 0, At, B0); PG8_MMA(0, 1, At, B1); PG8_BAR; PG8_SCHED;
            PG8_LDA(At, 1, 1); PG8_STAGE(PG8_SB(1, 0), b3, voffB); PG8_STAGE(PG8_SB(1, 1), b3 + hstep, voffB); PG8_STAGE(PG8_SA(1, 0), a3, voffA);
            PG8_WAIT_V(8); PG8_WAIT_L(0); PG8_BAR; PG8_MMA(1, 0, At, B0); PG8_MMA(1, 1, At, B1); PG8_BAR; PG8_SCHED;
            } else {
            PG8_LDB(B0, 0, 0); PG8_SCHED; PG8_LDA(At, 0, 0); PG8_STAGE(PG8_SA(1, 1), a1 + hstep, voffA);
            PG8_WAIT_L(8); PG8_BAR; PG8_WAIT_L(0); PG8_MMA(0, 0, At, B0); PG8_BAR; PG8_SCHED;
            PG8_LDB(B1, 0, 1); PG8_STAGE(PG8_SB(0, 0), b2, voffB);
            PG8_BAR; PG8_WAIT_L(0); PG8_MMA(0, 1, At, B1); PG8_BAR;
            PG8_LDA(At, 0, 1); PG8_STAGE(PG8_SA(0, 0), a2, voffA);
            PG8_BAR; PG8_WAIT_L(0); PG8_MMA(1, 0, At, B0); PG8_BAR; PG8_SCHED;
            PG8_STAGE(PG8_SB(0, 1), b2 + hstep, voffB);
            PG8_WAIT_V(6); PG8_BAR; PG8_MMA(1, 1, At, B1); PG8_BAR;
            PG8_LDB(B0, 1, 0); PG8_SCHED; PG8_LDA(At, 1, 0); PG8_STAGE(PG8_SA(0, 1), a2 + hstep, voffA);
            PG8_WAIT_L(8); PG8_BAR; PG8_WAIT_L(0); PG8_MMA(0, 0, At, B0); PG8_BAR; PG8_SCHED;
            PG8_LDB(B1, 1, 1); PG8_STAGE(PG8_SB(1, 0), b3, voffB);
            PG8_BAR; PG8_WAIT_L(0); PG8_MMA(0, 1, At, B1); PG8_BAR;
            PG8_LDA(At, 1, 1); PG8_STAGE(PG8_SA(1, 0), a3, voffA);
            PG8_BAR; PG8_WAIT_L(0); PG8_MMA(1, 0, At, B0); PG8_BAR; PG8_SCHED;
            PG8_STAGE(PG8_SB(1, 1), b3 + hstep, voffB);
            PG8_WAIT_V(6); PG8_BAR; PG8_MMA(1, 1, At, B1); PG8_BAR;
            }
        }
        if constexpr (ALIGN_EPI) { if (wr == 0) PG8_BAR; }
        if constexpr (!Epi::AFTER_DRAIN) { E(acc, cur, wr, wc, fr, fq); S.done(cur); }
        if (!has_next) break;
#pragma unroll
        for (int a = 0; a < 2; ++a)
#pragma unroll
            for (int b = 0; b < 2; ++b)
#pragma unroll
                for (int m = 0; m < 4; ++m)
#pragma unroll
                    for (int n = 0; n < 2; ++n) acc[a][b][m][n] = (f32x4){0.f, 0.f, 0.f, 0.f};
        cur = nxt; cA = nA; cB = nB; ++ui;
        if constexpr (ALIGN_EPI) { if (wr == 1) PG8_BAR; }
    }
    PG8_WAIT_V(0);
    if constexpr (!ALIGN_EPI) { if (wr == 0) PG8_BAR; }
    PG8_BAR;
    if constexpr (Epi::AFTER_DRAIN) { E.fused(acc, cur, wr, wc, fr, fq, lds, wid, lane); S.done(cur); }
#undef PG8_SA
#undef PG8_SB
#undef PG8_STAGE
#undef PG8_LDA
#undef PG8_LDB
#undef PG8_MMA
#undef PG8_WAIT_V
#undef PG8_WAIT_L
#undef PG8_BAR
#undef PG8_SCHED
}
template <class Epi, class Sched, bool ALIGN_EPI = false>
__device__ __forceinline__ void gemm_phase_fp8(PG8_LAS unsigned char* lds, const Gemm g, const Sched& S, const Epi& E, int scale_w, int scale_x) {
    constexpr bool SP2 = true;
    const int tid = ltid(), wid = __builtin_amdgcn_readfirstlane(tid >> 6), lane = tid & 63, wr = wid >> 2, wc = wid & 3, fr = lane & 15, fq = lane >> 4;
    const int K = g.K, nt = K / BK;
    unsigned voffA[2], voffB[2];
#pragma unroll
    for (int i = 0; i < 2; ++i) { int R, C; stage_rc(tid * 16 + i * 8192, R, C); const int Rb = Epi::PERM ? ((R & ~31) + perm32(R & 31)) : R;
        voffA[i] = (unsigned)(R * K + C) * 2u; voffB[i] = (unsigned)(Rb * K + C) * 2u; }
    const size_t kstep = (size_t)(BK * 2);
    const size_t hstep = (size_t)HALF * K * 2;
    const size_t tstep = 2 * hstep;
    const unsigned ldsw = (unsigned)wid * 1024u;
    const int aoff = lds_byte(wr * 64 + fr, fq * 8), boff = lds_byte(wc * 32 + fr, fq * 8);
#define PG8_SA(b, h) (((b) * 2 + (h)) * HTB)
#define PG8_SB(b, h) ((4 + (b) * 2 + (h)) * HTB)
#define PG8_STAGE(bufoff, gbase, voff) do { _Pragma("unroll") for (int _i = 0; _i < 2; ++_i) \
        __builtin_amdgcn_global_load_lds((const unsigned*)((const char*)(gbase) + (voff)[_i]), (PG8_LAS unsigned*)(lds + (bufoff) + ldsw + _i * 8192), 16, 0, 0); } while (0)
#define PG8_LDA(dst, b, h) do { _Pragma("unroll") for (int m = 0; m < 4; ++m) { dst[m].lo = *(const PG8_LAS i32x4*)(lds + PG8_SA(b, h) + aoff + m * 2048); dst[m].hi = *(const PG8_LAS i32x4*)(lds + PG8_SA(b, h) + aoff + m * 2048 + 1024); } } while (0)
#define PG8_LDB(dst, b, h) do { _Pragma("unroll") for (int n = 0; n < 2; ++n) { dst[n].lo = *(const PG8_LAS i32x4*)(lds + PG8_SB(b, h) + boff + n * 2048); dst[n].hi = *(const PG8_LAS i32x4*)(lds + PG8_SB(b, h) + boff + n * 2048 + 1024); } } while (0)
#define PG8_MMA(ai, bj, At, Bt) do { __builtin_amdgcn_s_setprio(1); _Pragma("unroll") for (int m = 0; m < 4; ++m) _Pragma("unroll") for (int n = 0; n < 2; ++n) \
        asm volatile("v_mfma_scale_f32_16x16x128_f8f6f4 %0, %1, %2, %0, %3, %4 op_sel_hi:[0,0,0]" : "+v"(acc[ai][bj][m][n]) : "v"(Bt[n]), "v"(At[m]), "v"(sclB), "v"(sclA));     \
        __builtin_amdgcn_s_setprio(0); } while (0)
#define PG8_WAIT_V(n) asm volatile("s_waitcnt vmcnt(" #n ")" ::: "memory")
#define PG8_WAIT_L(n) asm volatile("s_waitcnt lgkmcnt(" #n ")" ::: "memory")
#define PG8_BAR __builtin_amdgcn_s_barrier()
#define PG8_SCHED __builtin_amdgcn_sched_barrier(0)
    Unit cur, nxt; int ui = 0;
    if (!S.next(0, cur)) return;
    f32x4 acc[2][2][4][2];
#pragma unroll
    for (int a = 0; a < 2; ++a)
#pragma unroll
        for (int b = 0; b < 2; ++b)
#pragma unroll
            for (int m = 0; m < 4; ++m)
#pragma unroll
                for (int n = 0; n < 2; ++n) acc[a][b][m][n] = (f32x4){0.f, 0.f, 0.f, 0.f};
    i32x8 At[4], B0[2], B1[2];
    int sclB = scale_w, sclA = scale_x; asm volatile("" : "+v"(sclB), "+v"(sclA));
    const char* cA = (const char*)g.A + (size_t)cur.pm * tstep; const char* cB = (const char*)g.Bt + (size_t)cur.pn * tstep;
    S.a_ready(cur);
    if constexpr (SP2) {
        PG8_STAGE(PG8_SB(0, 0), cB, voffB); PG8_STAGE(PG8_SB(0, 1), cB + hstep, voffB); PG8_STAGE(PG8_SA(0, 0), cA, voffA); PG8_STAGE(PG8_SA(0, 1), cA + hstep, voffA);
        if (wr == 1) PG8_BAR;
        PG8_WAIT_V(2); PG8_BAR;
        PG8_STAGE(PG8_SB(1, 0), cB + kstep, voffB); PG8_STAGE(PG8_SA(1, 0), cA + kstep, voffA); PG8_STAGE(PG8_SB(1, 1), cB + hstep + kstep, voffB);
        PG8_WAIT_V(6); PG8_BAR;
    } else {
        PG8_STAGE(PG8_SB(0, 0), cB, voffB); PG8_STAGE(PG8_SA(0, 0), cA, voffA); PG8_STAGE(PG8_SB(0, 1), cB + hstep, voffB); PG8_STAGE(PG8_SA(0, 1), cA + hstep, voffA);
        if (wr == 1) PG8_BAR;
        PG8_WAIT_V(4); PG8_BAR;
        PG8_STAGE(PG8_SB(1, 0), cB + kstep, voffB); PG8_STAGE(PG8_SA(1, 0), cA + kstep, voffA); PG8_STAGE(PG8_SB(1, 1), cB + hstep + kstep, voffB);
        PG8_WAIT_V(6); PG8_BAR;
    }
    for (;;) {
        const bool has_next = S.next(ui + 1, nxt);
        const char* nA = has_next ? (const char*)g.A + (size_t)nxt.pm * tstep : cA; const char* nB = has_next ? (const char*)g.Bt + (size_t)nxt.pn * tstep : cB;
#pragma unroll 1
        for (int t = 0; t < nt; t += 2) {
            const bool last = (t == nt - 2);
            const char* a1 = cA + (size_t)(t + 1) * kstep;
            const char* a2 = last ? nA : cA + (size_t)(t + 2) * kstep; const char* b2 = last ? nB : cB + (size_t)(t + 2) * kstep;
            const char* a3 = a2 + kstep; const char* b3 = b2 + kstep;
            if (last && has_next) S.a_ready(nxt);
            if constexpr (SP2) {
            PG8_LDB(B0, 0, 0); PG8_LDB(B1, 0, 1); PG8_SCHED; PG8_LDA(At, 0, 0); PG8_STAGE(PG8_SA(1, 1), a1 + hstep, voffA);
            PG8_WAIT_V(8); PG8_WAIT_L(0); PG8_BAR; PG8_MMA(0, 0, At, B0); PG8_MMA(0, 1, At, B1); PG8_BAR; PG8_SCHED;
            PG8_LDA(At, 0, 1); PG8_STAGE(PG8_SB(0, 0), b2, voffB); PG8_STAGE(PG8_SB(0, 1), b2 + hstep, voffB); PG8_STAGE(PG8_SA(0, 0), a2, voffA);
            PG8_WAIT_V(8); PG8_WAIT_L(0); PG8_BAR; PG8_MMA(1, 0, At, B0); PG8_MMA(1, 1, At, B1); PG8_BAR; PG8_SCHED;
            PG8_LDB(B0, 1, 0); PG8_LDB(B1, 1, 1); PG8_SCHED; PG8_LDA(At, 1, 0); PG8_STAGE(PG8_SA(0, 1), a2 + hstep, voffA);
            PG8_WAIT_V(8); PG8_WAIT_L(0); PG8_BAR; PG8_MMA(0, 0, At, B0); PG8_MMA(0, 1, At, B1); PG8_BAR; PG8_SCHED;
            PG8_LDA(At, 1, 1); PG8_STAGE(PG8_SB(1, 0), b3, voffB); PG8_STAGE(PG8_SB(1, 1), b3 + hstep, voffB); PG8_STAGE(PG8_SA(1, 0), a3, voffA);
            PG8_WAIT_V(8); PG8_WAIT_L(0); PG8_BAR; PG8_MMA(1, 0, At, B0); PG8_MMA(1, 1, At, B1); PG8_BAR; PG8_SCHED;
            } else {
            PG8_LDB(B0, 0, 0); PG8_SCHED; PG8_LDA(At, 0, 0); PG8_STAGE(PG8_SA(1, 1), a1 + hstep, voffA);
            PG8_WAIT_L(8); PG8_BAR; PG8_WAIT_L(0); PG8_MMA(0, 0, At, B0); PG8_BAR; PG8_SCHED;
            PG8_LDB(B1, 0, 1); PG8_STAGE(PG8_SB(0, 0), b2, voffB);
            PG8_BAR; PG8_WAIT_L(0); PG8_MMA(0, 1, At, B1); PG8_BAR;
            PG8_LDA(At, 0, 1); PG8_STAGE(PG8_SA(0, 0), a2, voffA);
            PG8_BAR; PG8_WAIT_L(0); PG8_MMA(1, 0, At, B0); PG8_BAR; PG8_SCHED;
            PG8_STAGE(PG8_SB(0, 1), b2 + hstep, voffB);
            PG8_WAIT_V(6); PG8_BAR; PG8_MMA(1, 1, At, B1); PG8_BAR;
            PG8_LDB(B0, 1, 0); PG8_SCHED; PG8_LDA(At, 1, 0); PG8_STAGE(PG8_SA(0, 1), a2 + hstep, voffA);
            PG8_WAIT_L(8); PG8_BAR; PG8_WAIT_L(0); PG8_MMA(0, 0, At, B0); PG8_BAR; PG8_SCHED;
            PG8_LDB(B1, 1, 1); PG8_STAGE(PG8_SB(1, 0), b3, voffB);
            PG8_BAR; PG8_WAIT_L(0); PG8_MMA(0, 1, At, B1); PG8_BAR;
            PG8_LDA(At, 1, 1); PG8_STAGE(PG8_SA(1, 0), a3, voffA);
            PG8_BAR; PG8_WAIT_L(0); PG8_MMA(1, 0, At, B0); PG8_BAR; PG8_SCHED;
            PG8_STAGE(PG8_SB(1, 1), b3 + hstep, voffB);
            PG8_WAIT_V(6); PG8_BAR; PG8_MMA(1, 1, At, B1); PG8_BAR;
            }
        }
        asm volatile("s_nop 15\n\ts_nop 15" ::: "memory");
        if constexpr (ALIGN_EPI) { if (wr == 0) PG8_BAR; }
        if constexpr (!Epi::AFTER_DRAIN) { E(acc, cur, wr, wc, fr, fq); S.done(cur); }
        if (!has_next) break;
#pragma unroll
        for (int a = 0; a < 2; ++a)
#pragma unroll
            for (int b = 0; b < 2; ++b)
#pragma unroll
                for (int m = 0; m < 4; ++m)
#pragma unroll
                    for (int n = 0; n < 2; ++n) acc[a][b][m][n] = (f32x4){0.f, 0.f, 0.f, 0.f};
        cur = nxt; cA = nA; cB = nB; ++ui;
        if constexpr (ALIGN_EPI) { if (wr == 1) PG8_BAR; }
    }
    PG8_WAIT_V(0);
    if constexpr (!ALIGN_EPI) { if (wr == 0) PG8_BAR; }
    PG8_BAR;
    if constexpr (Epi::AFTER_DRAIN) { E.fused(acc, cur, wr, wc, fr, fq, lds, wid, lane); S.done(cur); }
#undef PG8_SA
#undef PG8_SB
#undef PG8_STAGE
#undef PG8_LDA
#undef PG8_LDB
#undef PG8_MMA
#undef PG8_WAIT_V
#undef PG8_WAIT_L
#undef PG8_BAR
#undef PG8_SCHED
}
template <class Epi, class Sched, bool ALIGN_EPI = false, bool FP8 = false>
__device__ __forceinline__ void gemm_phase_gather(PG8_LAS unsigned char* lds, const Gemm g, const int* idx, const Sched& S, const Epi& E) {
    constexpr bool SP2 = true;
    const int tid = ltid(), wid = __builtin_amdgcn_readfirstlane(tid >> 6), lane = tid & 63, wr = wid >> 2, wc = wid & 3, fr = lane & 15, fq = lane >> 4;
    const int K = g.K, nt = K / BK;
    unsigned voffB[2], vC[2][2], vN[2][2];
#pragma unroll
    for (int i = 0; i < 2; ++i) { int R, C; stage_rc(tid * 16 + i * 8192, R, C); const int Rb = Epi::PERM ? ((R & ~31) + perm32(R & 31)) : R;
        voffB[i] = (unsigned)(Rb * K + C) * 2u; }
#define PG8_GOFF(dst, unit) do { const int t_ = ltid(); _Pragma("unroll") for (int i_ = 0; i_ < 2; ++i_) { int R_, C_; stage_rc(t_ * 16 + i_ * 8192, R_, C_); \
        _Pragma("unroll") for (int h_ = 0; h_ < 2; ++h_) dst[h_][i_] = (unsigned)idx[(unit).pm * 256 + h_ * 128 + R_] * (unsigned)(K * 2) + (unsigned)(C_ * 2); } } while (0)
    const size_t kstep = (size_t)(BK * 2);
    const size_t hstep = (size_t)HALF * K * 2;
    const size_t tstep = 2 * hstep;
    const unsigned ldsw = (unsigned)wid * 1024u;
    const int aoff = lds_byte(wr * 64 + fr, fq * 8), boff = lds_byte(wc * 32 + fr, fq * 8);
#define PG8_SA(b, h) (((b) * 2 + (h)) * HTB)
#define PG8_SB(b, h) ((4 + (b) * 2 + (h)) * HTB)
#define PG8_STAGE(bufoff, gbase, voff) do { _Pragma("unroll") for (int _i = 0; _i < 2; ++_i) \
        __builtin_amdgcn_global_load_lds((const unsigned*)((const char*)(gbase) + (voff)[_i]), (PG8_LAS unsigned*)(lds + (bufoff) + ldsw + _i * 8192), 16, 0, 0); } while (0)
#define PG8_LDA(dst, b, h) do { _Pragma("unroll") for (int m = 0; m < 4; ++m) { dst[m].lo = *(const PG8_LAS i32x4*)(lds + PG8_SA(b, h) + aoff + m * 2048); dst[m].hi = *(const PG8_LAS i32x4*)(lds + PG8_SA(b, h) + aoff + m * 2048 + 1024); } } while (0)
#define PG8_LDB(dst, b, h) do { _Pragma("unroll") for (int n = 0; n < 2; ++n) { dst[n].lo = *(const PG8_LAS i32x4*)(lds + PG8_SB(b, h) + boff + n * 2048); dst[n].hi = *(const PG8_LAS i32x4*)(lds + PG8_SB(b, h) + boff + n * 2048 + 1024); } } while (0)
#define PG8_MMA(ai, bj, At, Bt) do { __builtin_amdgcn_s_setprio(1); _Pragma("unroll") for (int m = 0; m < 4; ++m) _Pragma("unroll") for (int n = 0; n < 2; ++n) \
        asm volatile("v_mfma_scale_f32_16x16x128_f8f6f4 %0, %1, %2, %0, %3, %4 op_sel_hi:[0,0,0]" : "+v"(acc[ai][bj][m][n]) : "v"(Bt[n]), "v"(At[m]), "v"(sclB), "v"(sclA));     \
        __builtin_amdgcn_s_setprio(0); } while (0)
#define PG8_WAIT_V(n) asm volatile("s_waitcnt vmcnt(" #n ")" ::: "memory")
#define PG8_WAIT_L(n) asm volatile("s_waitcnt lgkmcnt(" #n ")" ::: "memory")
#define PG8_BAR __builtin_amdgcn_s_barrier()
#define PG8_SCHED __builtin_amdgcn_sched_barrier(0)
    Unit cur, nxt; int ui = 0;
    if (!S.next(0, cur)) return;
    f32x4 acc[2][2][4][2];
#pragma unroll
    for (int a = 0; a < 2; ++a)
#pragma unroll
        for (int b = 0; b < 2; ++b)
#pragma unroll
            for (int m = 0; m < 4; ++m)
#pragma unroll
                for (int n = 0; n < 2; ++n) acc[a][b][m][n] = (f32x4){0.f, 0.f, 0.f, 0.f};
    i32x8 At[4], B0[2], B1[2];
    int sclB = 122, sclA = 127; asm volatile("" : "+v"(sclB), "+v"(sclA));
    const char* cA = (const char*)g.A; const char* cB = (const char*)g.Bt + (size_t)cur.pn * tstep;
    PG8_GOFF(vC, cur);
    S.a_ready(cur);
    if constexpr (SP2) {
        PG8_STAGE(PG8_SB(0, 0), cB, voffB); PG8_STAGE(PG8_SB(0, 1), cB + hstep, voffB); PG8_STAGE(PG8_SA(0, 0), cA, vC[0]); PG8_STAGE(PG8_SA(0, 1), cA, vC[1]);
        if (wr == 1) PG8_BAR;
        PG8_WAIT_V(2); PG8_BAR;
        PG8_STAGE(PG8_SB(1, 0), cB + kstep, voffB); PG8_STAGE(PG8_SA(1, 0), cA + kstep, vC[0]); PG8_STAGE(PG8_SB(1, 1), cB + hstep + kstep, voffB);
        PG8_WAIT_V(6); PG8_BAR;
    } else {
        PG8_STAGE(PG8_SB(0, 0), cB, voffB); PG8_STAGE(PG8_SA(0, 0), cA, vC[0]); PG8_STAGE(PG8_SB(0, 1), cB + hstep, voffB); PG8_STAGE(PG8_SA(0, 1), cA, vC[1]);
        if (wr == 1) PG8_BAR;
        PG8_WAIT_V(4); PG8_BAR;
        PG8_STAGE(PG8_SB(1, 0), cB + kstep, voffB); PG8_STAGE(PG8_SA(1, 0), cA + kstep, vC[0]); PG8_STAGE(PG8_SB(1, 1), cB + hstep + kstep, voffB);
        PG8_WAIT_V(6); PG8_BAR;
    }
    for (;;) {
        const bool has_next = S.next(ui + 1, nxt);
        const char* nA = cA; const char* nB = has_next ? (const char*)g.Bt + (size_t)nxt.pn * tstep : cB;
        if (has_next) PG8_GOFF(vN, nxt); else { _Pragma("unroll") for (int h_ = 0; h_ < 2; ++h_) _Pragma("unroll") for (int i_ = 0; i_ < 2; ++i_) vN[h_][i_] = vC[h_][i_]; }
#pragma unroll 1
        for (int t = 0; t < nt; t += 2) {
            const bool last = (t == nt - 2);
            const char* a1 = cA + (size_t)(t + 1) * kstep;
            const char* a2 = last ? nA : cA + (size_t)(t + 2) * kstep; const char* b2 = last ? nB : cB + (size_t)(t + 2) * kstep;
            const char* a3 = a2 + kstep; const char* b3 = b2 + kstep;
#define PG8_VSEL(h_) unsigned vsel_[2] = {last ? vN[h_][0] : vC[h_][0], last ? vN[h_][1] : vC[h_][1]}
            if (last && has_next) S.a_ready(nxt);
            if constexpr (SP2) {
            PG8_LDB(B0, 0, 0); PG8_LDB(B1, 0, 1); PG8_SCHED; PG8_LDA(At, 0, 0); PG8_STAGE(PG8_SA(1, 1), a1, vC[1]);
            PG8_WAIT_V(8); PG8_WAIT_L(0); PG8_BAR; PG8_MMA(0, 0, At, B0); PG8_MMA(0, 1, At, B1); PG8_BAR; PG8_SCHED;
            PG8_LDA(At, 0, 1); PG8_STAGE(PG8_SB(0, 0), b2, voffB); PG8_STAGE(PG8_SB(0, 1), b2 + hstep, voffB); { PG8_VSEL(0); PG8_STAGE(PG8_SA(0, 0), a2, vsel_); }
            PG8_WAIT_V(8); PG8_WAIT_L(0); PG8_BAR; PG8_MMA(1, 0, At, B0); PG8_MMA(1, 1, At, B1); PG8_BAR; PG8_SCHED;
            PG8_LDB(B0, 1, 0); PG8_LDB(B1, 1, 1); PG8_SCHED; PG8_LDA(At, 1, 0); { PG8_VSEL(1); PG8_STAGE(PG8_SA(0, 1), a2, vsel_); }
            PG8_WAIT_V(8); PG8_WAIT_L(0); PG8_BAR; PG8_MMA(0, 0, At, B0); PG8_MMA(0, 1, At, B1); PG8_BAR; PG8_SCHED;
            PG8_LDA(At, 1, 1); PG8_STAGE(PG8_SB(1, 0), b3, voffB); PG8_STAGE(PG8_SB(1, 1), b3 + hstep, voffB); { PG8_VSEL(0); PG8_STAGE(PG8_SA(1, 0), a3, vsel_); }
            PG8_WAIT_V(8); PG8_WAIT_L(0); PG8_BAR; PG8_MMA(1, 0, At, B0); PG8_MMA(1, 1, At, B1); PG8_BAR; PG8_SCHED;
            } else {
            PG8_LDB(B0, 0, 0); PG8_SCHED; PG8_LDA(At, 0, 0); PG8_STAGE(PG8_SA(1, 1), a1, vC[1]);
            PG8_WAIT_L(8); PG8_BAR; PG8_WAIT_L(0); PG8_MMA(0, 0, At, B0); PG8_BAR; PG8_SCHED;
            PG8_LDB(B1, 0, 1); PG8_STAGE(PG8_SB(0, 0), b2, voffB);
            PG8_BAR; PG8_WAIT_L(0); PG8_MMA(0, 1, At, B1); PG8_BAR;
            PG8_LDA(At, 0, 1); { PG8_VSEL(0); PG8_STAGE(PG8_SA(0, 0), a2, vsel_); }
            PG8_BAR; PG8_WAIT_L(0); PG8_MMA(1, 0, At, B0); PG8_BAR; PG8_SCHED;
            PG8_STAGE(PG8_SB(0, 1), b2 + hstep, voffB);
            PG8_WAIT_V(6); PG8_BAR; PG8_MMA(1, 1, At, B1); PG8_BAR;
            PG8_LDB(B0, 1, 0); PG8_SCHED; PG8_LDA(At, 1, 0); { PG8_VSEL(1); PG8_STAGE(PG8_SA(0, 1), a2, vsel_); }
            PG8_WAIT_L(8); PG8_BAR; PG8_WAIT_L(0); PG8_MMA(0, 0, At, B0); PG8_BAR; PG8_SCHED;
            PG8_LDB(B1, 1, 1); PG8_STAGE(PG8_SB(1, 0), b3, voffB);
            PG8_BAR; PG8_WAIT_L(0); PG8_MMA(0, 1, At, B1); PG8_BAR;
            PG8_LDA(At, 1, 1); { PG8_VSEL(0); PG8_STAGE(PG8_SA(1, 0), a3, vsel_); }
            PG8_BAR; PG8_WAIT_L(0); PG8_MMA(1, 0, At, B0); PG8_BAR; PG8_SCHED;
            PG8_STAGE(PG8_SB(1, 1), b3 + hstep, voffB);
            PG8_WAIT_V(6); PG8_BAR; PG8_MMA(1, 1, At, B1); PG8_BAR;
            }
        }
        asm volatile("s_nop 15\n\ts_nop 15" ::: "memory");
        if constexpr (ALIGN_EPI) { if (wr == 0) PG8_BAR; }
        if constexpr (!Epi::AFTER_DRAIN) { E(acc, cur, wr, wc, fr, fq); S.done(cur); }
        if (!has_next) break;
#pragma unroll
        for (int a = 0; a < 2; ++a)
#pragma unroll
            for (int b = 0; b < 2; ++b)
#pragma unroll
                for (int m = 0; m < 4; ++m)
#pragma unroll
                    for (int n = 0; n < 2; ++n) acc[a][b][m][n] = (f32x4){0.f, 0.f, 0.f, 0.f};
        cur = nxt; cA = nA; cB = nB; ++ui;
#pragma unroll
        for (int h_ = 0; h_ < 2; ++h_)
#pragma unroll
            for (int i_ = 0; i_ < 2; ++i_) vC[h_][i_] = vN[h_][i_];
        if constexpr (ALIGN_EPI) { if (wr == 1) PG8_BAR; }
    }
    PG8_WAIT_V(0);
    if constexpr (!ALIGN_EPI) { if (wr == 0) PG8_BAR; }
    PG8_BAR;
    if constexpr (Epi::AFTER_DRAIN) { E.fused(acc, cur, wr, wc, fr, fq, lds, wid, lane); S.done(cur); }
#undef PG8_GOFF
#undef PG8_SA
#undef PG8_SB
#undef PG8_STAGE
#undef PG8_LDA
#undef PG8_LDB
#undef PG8_MMA
#undef PG8_WAIT_V
#undef PG8_WAIT_L
#undef PG8_BAR
#undef PG8_SCHED
}
}

namespace pg8 {
struct EpiInproj {
    static constexpr bool PERM = true, AFTER_DRAIN = false;
    EpiBf16<0> plain; const float* gq; const float* gk; float c2, eps; PG8_LAS unsigned char* scratch;
    static __device__ __forceinline__ float sum_fq(float x) {
        auto s = __builtin_amdgcn_permlane16_swap(__float_as_uint(x), __float_as_uint(x), false, false); x = __uint_as_float(s[0]) + __uint_as_float(s[1]);
        auto t = __builtin_amdgcn_permlane32_swap(__float_as_uint(x), __float_as_uint(x), false, false); return __uint_as_float(t[0]) + __uint_as_float(t[1]); }
    __device__ __forceinline__ void operator()(const f32x4 (&acc_)[2][2][4][2], const Unit& u, int wr, int wc, int fr, int fq) const {
        if (u.pn < 4) {
            f32x4 (&acc)[2][2][4][2] = const_cast<f32x4 (&)[2][2][4][2]>(acc_);
            const PG8_LAS unsigned* TAB = (const PG8_LAS unsigned*)scratch; PG8_LAS float* EXQ = (PG8_LAS float*)(scratch + 4096);
            const int rl = wr * 64 + fr;
            float ss[2][2][4];
#pragma unroll
            for (int ai = 0; ai < 2; ++ai)
#pragma unroll
                for (int bj = 0; bj < 2; ++bj)
#pragma unroll
                    for (int m = 0; m < 4; ++m) { const f32x4 a = acc[ai][bj][m][0], b = acc[ai][bj][m][1];
                        ss[ai][bj][m] = sum_fq((a[0] * a[0] + a[1] * a[1]) + (a[2] * a[2] + a[3] * a[3]) + (b[0] * b[0] + b[1] * b[1]) + (b[2] * b[2] + b[3] * b[3]));
                        if (fq == 0) EXQ[(rl + ai * HALF + m * 16) * 8 + bj * 4 + wc] = ss[ai][bj][m]; }
            asm volatile("s_waitcnt lgkmcnt(0)" ::: "memory"); __builtin_amdgcn_s_barrier();
#pragma unroll
            for (int ai = 0; ai < 2; ++ai)
#pragma unroll
                for (int bj = 0; bj < 2; ++bj)
#pragma unroll
                    for (int m = 0; m < 4; ++m) ss[ai][bj][m] += EXQ[(rl + ai * HALF + m * 16) * 8 + bj * 4 + (wc ^ 1)];
            const float* gp = (u.pn < 2 ? gq : gk) + (wc & 1) * 32 + 8 * fq; const f32x4 g0 = *(const f32x4*)gp, g1 = *(const f32x4*)(gp + 4);
            const float scl = u.pn < 2 ? c2 : 1.f;
            const bool lat = u.pm < 128, upper = fq >= 2;
#pragma unroll
            for (int ai = 0; ai < 2; ++ai)
#pragma unroll
                for (int m = 0; m < 4; ++m) {
                    const int t = (u.pm * BM + rl + ai * HALF + m * 16) & 4095, pos = (wc & 1) ? (t & 63) : (t >> 6);
                    const u32x4 t0 = *(const PG8_LAS u32x4*)(TAB + pos * 16 + 8 * (fq & 1)), t1 = *(const PG8_LAS u32x4*)(TAB + pos * 16 + 8 * (fq & 1) + 4);
                    float ca0[4], cb0[4], ca1[4], cb1[4];
#pragma unroll
                    for (int j = 0; j < 4; ++j) { const float c0 = __uint_as_float(t0[j] << 16), s0 = __uint_as_float(t0[j] & 0xffff0000u), c1 = __uint_as_float(t1[j] << 16), s1 = __uint_as_float(t1[j] & 0xffff0000u);
                        ca0[j] = upper ? s0 : c0; cb0[j] = upper ? c0 : -s0; ca1[j] = upper ? s1 : c1; cb1[j] = upper ? c1 : -s1; }
#pragma unroll
                    for (int bj = 0; bj < 2; ++bj) {
                        const float rstd = scl * __builtin_amdgcn_rsqf(ss[ai][bj][m] * (1.f / 64.f) + eps);
                        f32x4 v0 = acc[ai][bj][m][0] * rstd * g0, v1 = acc[ai][bj][m][1] * rstd * g1;
                        if (lat) {
#pragma unroll
                            for (int j = 0; j < 4; ++j) {
                                { auto sw = __builtin_amdgcn_permlane32_swap(__float_as_uint(v0[j]), __float_as_uint(v0[j]), false, false); v0[j] = __builtin_fmaf(ca0[j], __uint_as_float(sw[0]), cb0[j] * __uint_as_float(sw[1])); }
                                { auto sw = __builtin_amdgcn_permlane32_swap(__float_as_uint(v1[j]), __float_as_uint(v1[j]), false, false); v1[j] = __builtin_fmaf(ca1[j], __uint_as_float(sw[0]), cb1[j] * __uint_as_float(sw[1])); } } }
                        acc[ai][bj][m][0] = v0; acc[ai][bj][m][1] = v1; } }
        }
        plain(acc_, u, wr, wc, fr, fq);
    }
};
}

namespace pg8 {
struct EpiRes {
    static constexpr bool PERM = true, AFTER_DRAIN = false;
    const float* x_in; float* out; const float* ctx_in; float* xc; const float* modl; int layer;
    __device__ __forceinline__ void operator()(const f32x4 (&acc)[2][2][4][2], const Unit& u, int wr, int wc, int fr, int fq) const {
        const bool lat = u.pm < 128; const int rowt = lat ? u.pm * BM : (u.pm - 128) * BM;
        const int col0 = u.pn * BM + wc * 32 + 8 * fq;
        const float* g = modl + (size_t)(lat ? (u.pm >> 4) : 8) * 6144 + 2048 + col0;
        f32x4 gv[2][2];
#pragma unroll
        for (int bj = 0; bj < 2; ++bj)
#pragma unroll
            for (int n = 0; n < 2; ++n) gv[bj][n] = *(const f32x4*)(g + bj * HALF + n * 4);
#pragma unroll
        for (int ai = 0; ai < 2; ++ai)
#pragma unroll
            for (int m = 0; m < 4; ++m) { const int row = rowt + ai * HALF + wr * 64 + m * 16 + fr;
#pragma unroll
                for (int bj = 0; bj < 2; ++bj) { const int c = col0 + bj * HALF; f32x4 b0, b1;
                    if (!lat) { const float* bp = ctx_in + (size_t)row * 1024 + c; b0 = *(const f32x4*)bp; b1 = *(const f32x4*)(bp + 4); }
                    else if (layer == 0) { const float* bp = x_in + (size_t)row * 1024 + c; b0 = *(const f32x4*)bp; b1 = *(const f32x4*)(bp + 4); }
                    else { const u32x4 w = *(const u32x4*)((const bf16_t*)(out + (size_t)row * 1024) + c);
                        b0 = (f32x4){__uint_as_float(w.x << 16), __uint_as_float(w.x & 0xffff0000u), __uint_as_float(w.y << 16), __uint_as_float(w.y & 0xffff0000u)};
                        b1 = (f32x4){__uint_as_float(w.z << 16), __uint_as_float(w.z & 0xffff0000u), __uint_as_float(w.w << 16), __uint_as_float(w.w & 0xffff0000u)}; }
                    const f32x4 o0 = b0 + gv[bj][0] * acc[ai][bj][m][0], o1 = b1 + gv[bj][1] * acc[ai][bj][m][1];
                    if (lat) { u32x4 w; w.x = cvt_pk_bf16(o0[0], o0[1]); w.y = cvt_pk_bf16(o0[2], o0[3]); w.z = cvt_pk_bf16(o1[0], o1[1]); w.w = cvt_pk_bf16(o1[2], o1[3]); *(u32x4*)((bf16_t*)(out + (size_t)row * 1024) + c) = w; }
                    else { float* op = xc + (size_t)row * 1024 + c; *(f32x4*)op = o0; *(f32x4*)(op + 4) = o1; } } }
    }
};
__device__ __forceinline__ float silu_f(float x) { return x * __builtin_amdgcn_rcpf(1.f + __builtin_amdgcn_exp2f(-1.4426950408889634f * x)); }
struct EpiSwiglu {
    static constexpr bool PERM = true, AFTER_DRAIN = false, FP8OUT = USE_FP8_MOE2 != 0;
    bf16_t* HID;
    __device__ __forceinline__ void operator()(const f32x4 (&acc)[2][2][4][2], const Unit& u, int wr, int wc, int fr, int fq) const {
        const int row0 = u.pm * BM + wr * 64 + fr, hcol0 = (u.pn & 7) * 128 + wc * 32 + 8 * fq;
#pragma unroll
        for (int ai = 0; ai < 2; ++ai)
#pragma unroll
            for (int m = 0; m < 4; ++m) { bf16_t* rowp = HID + (size_t)(row0 + ai * HALF + m * 16) * 1024 + hcol0;
                const f32x4 g0 = acc[ai][0][m][0], g1 = acc[ai][0][m][1], u0 = acc[ai][1][m][0], u1 = acc[ai][1][m][1];
#define H8(gv, uv) __builtin_amdgcn_fmed3f(8.f * silu_f(gv) * (uv), -448.f, 448.f)
                if (FP8OUT) { int p0 = __builtin_amdgcn_cvt_pk_fp8_f32(H8(g0[0], u0[0]), H8(g0[1], u0[1]), 0, false); p0 = __builtin_amdgcn_cvt_pk_fp8_f32(H8(g0[2], u0[2]), H8(g0[3], u0[3]), p0, true);
                    int p1 = __builtin_amdgcn_cvt_pk_fp8_f32(H8(g1[0], u1[0]), H8(g1[1], u1[1]), 0, false); p1 = __builtin_amdgcn_cvt_pk_fp8_f32(H8(g1[2], u1[2]), H8(g1[3], u1[3]), p1, true);
                    typedef unsigned u32x2_ __attribute__((ext_vector_type(2))); *(u32x2_*)((unsigned char*)HID + (size_t)(row0 + ai * HALF + m * 16) * 1024 + hcol0) = (u32x2_){(unsigned)p0, (unsigned)p1}; }
                else { u32x4 w; w.x = cvt_pk_bf16(silu_f(g0[0]) * u0[0], silu_f(g0[1]) * u0[1]); w.y = cvt_pk_bf16(silu_f(g0[2]) * u0[2], silu_f(g0[3]) * u0[3]);
                w.z = cvt_pk_bf16(silu_f(g1[0]) * u1[0], silu_f(g1[1]) * u1[1]); w.w = cvt_pk_bf16(silu_f(g1[2]) * u1[2], silu_f(g1[3]) * u1[3]);
                *(u32x4*)rowp = w; } }
    }
};
struct EpiBf16Grp {
    static constexpr bool PERM = true, AFTER_DRAIN = false;
    bf16_t* O; int ldc, ncolt;
    __device__ __forceinline__ void operator()(const f32x4 (&acc)[2][2][4][2], const Unit& u, int wr, int wc, int fr, int fq) const {
        const int row0 = u.pm * BM + wr * 64 + fr, col0 = (u.pn % ncolt) * BM + wc * 32 + 8 * fq;
#pragma unroll
        for (int ai = 0; ai < 2; ++ai)
#pragma unroll
            for (int m = 0; m < 4; ++m) { bf16_t* rowp = O + (size_t)(row0 + ai * HALF + m * 16) * ldc + col0;
#pragma unroll
                for (int bj = 0; bj < 2; ++bj) { const f32x4 v0 = acc[ai][bj][m][0], v1 = acc[ai][bj][m][1];
                    u32x4 w; w.x = cvt_pk_bf16(v0[0], v0[1]); w.y = cvt_pk_bf16(v0[2], v0[3]); w.z = cvt_pk_bf16(v1[0], v1[1]); w.w = cvt_pk_bf16(v1[2], v1[3]);
                    *(u32x4*)(rowp + bj * HALF) = w; } }
    }
};
struct GroupOrder {
    int nMe, nNe, G, c;
    __device__ bool next(int i, Unit& u) const {
        const int vc = (G % 8 == 0) ? (c % 8) * (G / 8) + c / 8 : c;
        const int L = i * G + vc, per = nMe * nNe; if (L >= 16 * per) return false;
        const int e = L / per, rem = L % per; u.pm = e * 17 + rem % nMe; u.pn = e * nNe + rem / nMe; return true;
    }
    __device__ __forceinline__ void a_ready(const Unit&) const {}
    __device__ __forceinline__ void done(const Unit&) const {}
};
}

DEV float bf2f(unsigned u) { return __uint_as_float(u << 16); }
DEV unsigned f2bf(float f) { unsigned u = __float_as_uint(f); return (u + 0x7fffu + ((u >> 16) & 1u)) >> 16; }
typedef float f32x2_t __attribute__((ext_vector_type(2)));
DEV unsigned pk2(float lo, float hi) { f32x2_t v = {lo, hi}; bf16x2_t b = __builtin_convertvector(v, bf16x2_t); return __builtin_bit_cast(unsigned, b); }
DEV float clamp8(float x) { return __builtin_amdgcn_fmed3f(x, -448.f, 448.f); }
DEV unsigned pk_fp8x4(float a0, float a1, float a2, float a3) { int p = __builtin_amdgcn_cvt_pk_fp8_f32(clamp8(a0), clamp8(a1), 0, false); p = __builtin_amdgcn_cvt_pk_fp8_f32(clamp8(a2), clamp8(a3), p, true); return (unsigned)p; }
template <int CTRL> DEV float dppf(float x) { return __builtin_bit_cast(float, __builtin_amdgcn_mov_dpp(__builtin_bit_cast(int, x), CTRL, 0xf, 0xf, true)); }
constexpr int DPP_X1 = 0xB1, DPP_X2 = 0x4E, DPP_X3 = 0x1B, DPP_X7 = 0x141, DPP_X8 = 0x128;
DEV float swap16_sum(float x, float y) { auto s = __builtin_amdgcn_permlane16_swap(__float_as_uint(x), __float_as_uint(y), false, false); return __uint_as_float(s[0]) + __uint_as_float(s[1]); }
DEV float swap32_sum(float x, float y) { auto s = __builtin_amdgcn_permlane32_swap(__float_as_uint(x), __float_as_uint(y), false, false); return __uint_as_float(s[0]) + __uint_as_float(s[1]); }
DEV float swap16_max(float x) { auto s = __builtin_amdgcn_permlane16_swap(__float_as_uint(x), __float_as_uint(x), false, false); return fmaxf(__uint_as_float(s[0]), __uint_as_float(s[1])); }
DEV float swap32_max(float x) { auto s = __builtin_amdgcn_permlane32_swap(__float_as_uint(x), __float_as_uint(x), false, false); return fmaxf(__uint_as_float(s[0]), __uint_as_float(s[1])); }
DEV float xor32_get(float x, bool upper) { auto s = __builtin_amdgcn_permlane32_swap(__float_as_uint(x), __float_as_uint(x), false, false); return __uint_as_float(upper ? s[0] : s[1]); }
DEV float row_sum4(float v) { v += dppf<DPP_X1>(v); v += dppf<DPP_X2>(v); return v; }
DEV float row_sum16(float v) { v = row_sum4(v); v += dppf<DPP_X7>(v); v += dppf<DPP_X8>(v); return v; }
DEV float wave_sum(float v) { v = row_sum16(v); v = swap16_sum(v, v); return swap32_sum(v, v); }
DEV void lds_barrier() { asm volatile("s_waitcnt lgkmcnt(0)\n\ts_barrier" ::: "memory"); }
DEV float sigm(float x) { return 1.f / (1.f + expf(-x)); }
DEV float fsigm(float x) { return __builtin_amdgcn_rcpf(1.f + __builtin_amdgcn_exp2f(-1.4426950408889634f * x)); }
DEV float gelu_tanh(float x) { const float u = 0.7978845608028654f * (x + 0.044715f * x * x * x); return x * fsigm(2.f * u); }
DEV float siluf(float x) { return x / (1.f + expf(-x)); }
DEV float fsiluf(float x) { return x * fsigm(x); }

DEV void ld4bf(const bf16_t* p, float* v) { const u32x2 w = *(const u32x2*)p; v[0] = bf2f(w.x & 0xffffu); v[1] = bf2f(w.x >> 16); v[2] = bf2f(w.y & 0xffffu); v[3] = bf2f(w.y >> 16); }
DEV void st4bf(bf16_t* p, const float* v) { u32x2 w; w.x = pk2(v[0], v[1]); w.y = pk2(v[2], v[3]); *(u32x2*)p = w; }
DEV bf16_t* resrow(const Args& a, int r) { return (bf16_t*)(a.out + (size_t)r * D); }
DEV const float* modp(const Args& a, int l, int rowsel, int chunk) { return (const float*)(a.ws + WS_MOD) + ((size_t)(l * 9 + rowsel) * 6 + chunk) * 1024; }
DEV int modrow(int r) { return r < ML ? (r >> 12) : 8; }
DEV float lam_init(int l) { return l == 0 ? 0.2f : (0.8f - 0.6f * 0.7408182206817179f); }

DEV void p0_mod(const Args& a, float* lds) {
    const int tid = ltid(), lane = tid & 63, wave = tid >> 6;
    const float* c = a.in[1]; const float* cc = a.in[3];
    for (int i = tid; i < 9 * 1024; i += NTHREADS) { const float v = i < 8192 ? c[i] : cc[i - 8192]; lds[i] = siluf(v); }
    __syncthreads();
    float* red = lds + 9 * 1024;
    float* MOD = (float*)(a.ws + WS_MOD);
    for (int item = blockIdx.x; item < 192; item += gridDim.x) {
        const int l = item / 96, cgp = item % 96, col = cgp * 64 + lane;
        const float* w = a.in[4] + (size_t)l * 1024 * 6144 + col;
        float acc[9];
#pragma unroll
        for (int r = 0; r < 9; ++r) acc[r] = 0.f;
#pragma unroll 16
        for (int k = wave * 128; k < wave * 128 + 128; ++k) {
            const float wv = w[(size_t)k * 6144];
#pragma unroll
            for (int r = 0; r < 9; ++r) acc[r] += lds[r * 1024 + k] * wv;
        }
#pragma unroll
        for (int r = 0; r < 9; ++r) red[(wave * 9 + r) * 64 + lane] = acc[r];
        __syncthreads();
        for (int o = tid; o < 576; o += NTHREADS) {
            const int r = o >> 6, cl = o & 63; float s = 0.f;
#pragma unroll
            for (int w8 = 0; w8 < 8; ++w8) s += red[(w8 * 9 + r) * 64 + cl];
            MOD[(size_t)(l * 9 + r) * 6144 + cgp * 64 + cl] = s + a.in[5][l * 6144 + cgp * 64 + cl];
        }
        __syncthreads();
    }
}

template <int MODE, bool COMB = true> DEV void p1_norm(const Args& a) {
    const int tid = ltid(), lane = tid & 63, wave = tid >> 6;
    const int gw = blockIdx.x * NWAVES + wave, NGW = gridDim.x * NWAVES;
    const int l = MODE == 0 ? 0 : 1;
    const int lp = MODE == 2 ? 1 : 0;
    bf16_t* XN = (bf16_t*)(a.ws + WS_XN);
    const int* SEL = (const int*)(a.ws + WS_SEL); const float* AFF = (const float*)(a.ws + WS_AFF); const bf16_t* Y2 = (const bf16_t*)(a.ws + WS_Y2);
    float* XC = (float*)(a.ws + WS_XC);
    const int nrows = MODE == 2 ? ML : M;
    constexpr bool CMB = (MODE != 0) && COMB;
    f32x4 v[4], vn[4]; int mysel = -1, nsel = -1;
#define P1_SRC(rr) (MODE == 0 ? ((rr) < ML ? a.in[0] + (size_t)(rr) * D : a.in[2] + (size_t)((rr) - ML) * D) : ((rr) < ML ? (const float*)a.out + (size_t)(rr) * D : (const float*)XC + (size_t)((rr) - ML) * D))
#define P1_LOAD(dst, sel, rr) do { const int r_ = (rr); \
        if (MODE != 0 && r_ < ML) { const bf16_t* s_ = resrow(a, r_); _Pragma("unroll") for (int j = 0; j < 4; ++j) { float t_[4]; ld4bf(s_ + 256 * j + 4 * lane, t_); dst[j] = (f32x4){t_[0], t_[1], t_[2], t_[3]}; } } \
        else { const float* s_ = P1_SRC(r_); _Pragma("unroll") for (int j = 0; j < 4; ++j) dst[j] = *(const f32x4*)(s_ + 256 * j + 4 * lane); } \
        if (CMB) sel = SEL[(size_t)r_ * 16 + (lane & 15)]; } while (0)
    if (gw < nrows) P1_LOAD(v, mysel, gw);
    for (int r = gw; r < nrows; r += NGW) {
        if (r + NGW < nrows) P1_LOAD(vn, nsel, r + NGW);
        if (CMB) {
            float* dst = r < ML ? a.out + (size_t)r * D : XC + (size_t)(r - ML) * D;
            unsigned m = (unsigned)(__ballot(mysel >= 0) & 0xffffull);
            f32x4 acc[4];
#pragma unroll
            for (int j = 0; j < 4; ++j) acc[j] = (f32x4){0.f, 0.f, 0.f, 0.f};
            while (m) {
                int ee[4]; u32x2 w[4][4]; float af[4];
#pragma unroll
                for (int i = 0; i < 4; ++i) { if (m) { ee[i] = __builtin_ctz(m); m &= m - 1u; } else ee[i] = -1; }
#pragma unroll
                for (int i = 0; i < 4; ++i) if (ee[i] >= 0) { const int s = __builtin_amdgcn_readlane(mysel, ee[i]); af[i] = AFF[ee[i] * SLOTS + s]; const bf16_t* yr = Y2 + ((size_t)ee[i] * SLOTS + s) * D;
#pragma unroll
                    for (int j = 0; j < 4; ++j) w[i][j] = *(const u32x2*)(yr + 256 * j + 4 * lane); }
#pragma unroll
                for (int i = 0; i < 4; ++i) if (ee[i] >= 0) {
#pragma unroll
                    for (int j = 0; j < 4; ++j) { acc[j].x += af[i] * bf2f(w[i][j].x & 0xffffu); acc[j].y += af[i] * bf2f(w[i][j].x >> 16); acc[j].z += af[i] * bf2f(w[i][j].y & 0xffffu); acc[j].w += af[i] * bf2f(w[i][j].y >> 16); } }
            }
            const float* g2 = modp(a, lp, modrow(r), 5);
#pragma unroll
            for (int j = 0; j < 4; ++j) { const f32x4 g = *(const f32x4*)(g2 + 256 * j + 4 * lane); v[j] += g * acc[j];
                if (MODE == 1 && r < ML) { float t_[4] = {v[j].x, v[j].y, v[j].z, v[j].w}; st4bf(resrow(a, r) + 256 * j + 4 * lane, t_); }
                else *(f32x4*)(dst + 256 * j + 4 * lane) = v[j]; }
        }
        if (MODE != 2) {
            float ss = 0.f;
#pragma unroll
            for (int j = 0; j < 4; ++j) ss += (v[j].x * v[j].x + v[j].y * v[j].y) + (v[j].z * v[j].z + v[j].w * v[j].w);
            const float rstd = __builtin_amdgcn_rsqf(wave_sum(ss) * (1.f / D) + EPS);
            const float* g = a.in[6] + l * D; const float* sh = modp(a, l, modrow(r), 0); const float* sc = modp(a, l, modrow(r), 1);
#pragma unroll
            for (int j = 0; j < 4; ++j) {
                const int c0 = 256 * j + 4 * lane; const f32x4 gg = *(const f32x4*)(g + c0), s1 = *(const f32x4*)(sc + c0), s0 = *(const f32x4*)(sh + c0);
                const f32x4 y = v[j] * rstd * gg * (1.f + s1) + s0; float t[4] = {y.x, y.y, y.z, y.w}; st4bf(XN + (size_t)r * D + c0, t);
            }
        }
#pragma unroll
        for (int j = 0; j < 4; ++j) v[j] = vn[j];
        mysel = nsel;
    }
#undef P1_SRC
#undef P1_LOAD
}

DEV void transpose_item(const float* W, int N, int K, bf16_t* WT, int k0, int n0, int drow0, float* scr, int lane) {
    float t32[32];
#pragma unroll
    for (int i = 0; i < 32; ++i) t32[i] = W[(size_t)(k0 + 2 * i + (lane >> 5)) * N + n0 + (lane & 31)];
#pragma unroll
    for (int i = 0; i < 32; ++i) scr[(2 * i + (lane >> 5)) * 33 + (lane & 31)] = t32[i];
    const int c = lane & 7;
#pragma unroll
    for (int j = 0; j < 4; ++j) { const int n = (lane >> 3) + 8 * j; const float* s = scr + (8 * c) * 33 + n;
        u32x4 o; o.x = pk2(s[0 * 33], s[1 * 33]); o.y = pk2(s[2 * 33], s[3 * 33]); o.z = pk2(s[4 * 33], s[5 * 33]); o.w = pk2(s[6 * 33], s[7 * 33]);
        *(u32x4*)(WT + (size_t)(drow0 + n) * K + k0 + 8 * c) = o; }
}
DEV void transpose_item8(const float* W, int N, unsigned char* WT8, int k0, int n0, int drow0, float* scr, int lane) {
    float t32[32];
#pragma unroll
    for (int i = 0; i < 32; ++i) t32[i] = W[(size_t)(k0 + 2 * i + (lane >> 5)) * N + n0 + (lane & 31)];
#pragma unroll
    for (int i = 0; i < 32; ++i) scr[(2 * i + (lane >> 5)) * 33 + (lane & 31)] = t32[i];
    const int c = lane & 7;
#pragma unroll
    for (int j = 0; j < 4; ++j) { const int n = (lane >> 3) + 8 * j; const float* s = scr + (8 * c) * 33 + n;
        u32x2 o; o.x = pk_fp8x4(s[0 * 33] * 32.f, s[1 * 33] * 32.f, s[2 * 33] * 32.f, s[3 * 33] * 32.f); o.y = pk_fp8x4(s[4 * 33] * 32.f, s[5 * 33] * 32.f, s[6 * 33] * 32.f, s[7 * 33] * 32.f);
        *(u32x2*)(WT8 + (size_t)(drow0 + n) * 1024 + k0 + 8 * c) = o; }
}
DEV void p1_weights(const Args& a, int l, float* lds) {
    const int tid = ltid(), lane = tid & 63, wave = tid >> 6;
    float* scr = lds + wave * (64 * 33);
    const int gw = blockIdx.x * NWAVES + wave, NGW = gridDim.x * NWAVES;
    bf16_t* WT = (bf16_t*)(a.ws + WS_WT);
    for (int i = blockIdx.x * NTHREADS + tid; i < 8192; i += gridDim.x * NTHREADS) {
        const int ln = i & 63, ks = (i >> 6) & 3, nt = (i >> 8) & 1, mat = i >> 9;
        const float* p = a.in[18] + ((size_t)(l * 16 + mat) * 64 + 16 * ks + 8 * (ln >> 5)) * 64 + nt * 32 + (ln & 31);
        u32x4 x; x.x = pk2(p[0], p[64]); x.y = pk2(p[128], p[192]); x.z = pk2(p[256], p[320]); x.w = pk2(p[384], p[448]);
        *(u32x4*)(a.ws + WS_LRUW + (size_t)i * 16) = x; }
    constexpr int I_IN = 16 * 96, I_OUT = 16 * 32, I_E = 16 * 32;
    constexpr int NITEMS = I_IN + I_OUT + 16 * 3 * I_E;
    for (int it = gw; it < NITEMS; it += NGW) {
        int r = it;
        if (r < I_IN) { const int kb = r / 96, nb = r % 96; transpose_item(a.in[8] + (size_t)l * 1024 * 3072, 3072, 1024, WT + WT_IN / 2, 64 * kb, 32 * nb, 32 * nb, scr, lane); continue; } r -= I_IN;
        if (r < I_OUT) { const int kb = r / 32, nb = r % 32; transpose_item(a.in[9] + (size_t)l * 1024 * 1024, 1024, 1024, WT + WT_OUT / 2, 64 * kb, 32 * nb, 32 * nb, scr, lane); continue; } r -= I_OUT;
        const int e = r / (3 * I_E), q = (r / I_E) % 3, rr = r % I_E, kb = rr / 32, nb = rr % 32, n0 = 32 * nb;
        const size_t eoff = ((size_t)l * 16 + e) * 1024 * 1024;
        if (q < 2 && USE_FP8_MOE1) transpose_item8((q == 0 ? a.in[23] : a.in[24]) + eoff, 1024, (unsigned char*)(WT + WT_GU / 2) + (size_t)e * 2048 * 1024, 64 * kb, n0, (n0 >> 7) * 256 + q * 128 + (n0 & 127), scr, lane);
        else if (q == 0) transpose_item(a.in[23] + eoff, 1024, 1024, WT + WT_GU / 2 + (size_t)e * 2048 * 1024, 64 * kb, n0, (n0 >> 7) * 256 + (n0 & 127), scr, lane);
        else if (q == 1) transpose_item(a.in[24] + eoff, 1024, 1024, WT + WT_GU / 2 + (size_t)e * 2048 * 1024, 64 * kb, n0, (n0 >> 7) * 256 + 128 + (n0 & 127), scr, lane);
        else if (USE_FP8_MOE2) transpose_item8(a.in[25] + eoff, 1024, (unsigned char*)(WT + WT_DN / 2) + (size_t)e * 1024 * 1024, 64 * kb, n0, n0, scr, lane);
        else transpose_item(a.in[25] + eoff, 1024, 1024, WT + WT_DN / 2 + (size_t)e * 1024 * 1024, 64 * kb, n0, n0, scr, lane);
    }
}

template <bool DUAL, class EPI> DEV void sgemm_tile(const bf16_t* A, const float* B, const float* B2, int ldb, float* lds, EPI epi) {
    const int tid = ltid(), tx = tid & 15, ty = tid >> 4;
    float* As = lds;
    float* Bs = lds + 16 * 132;
    float* Bs2 = Bs + 16 * 64;
    float acc[4][4], acc2[4][4];
#pragma unroll
    for (int i = 0; i < 4; ++i)
#pragma unroll
        for (int j = 0; j < 4; ++j) { acc[i][j] = 0.f; acc2[i][j] = 0.f; }
    for (int k0 = 0; k0 < 1024; k0 += 16) {
        { const int r = tid >> 2, kq = (tid & 3) * 4; float t[4]; ld4bf(A + (size_t)r * 1024 + k0 + kq, t);
#pragma unroll
            for (int j = 0; j < 4; ++j) As[(kq + j) * 132 + r] = t[j]; }
        if (tid < 256) { const int kk = tid >> 4, c4 = (tid & 15) * 4; *(f32x4*)(Bs + kk * 64 + c4) = *(const f32x4*)(B + (size_t)(k0 + kk) * ldb + c4); }
        else if (DUAL) { const int t2 = tid - 256, kk = t2 >> 4, c4 = (t2 & 15) * 4; *(f32x4*)(Bs2 + kk * 64 + c4) = *(const f32x4*)(B2 + (size_t)(k0 + kk) * ldb + c4); }
        __syncthreads();
#pragma unroll
        for (int kk = 0; kk < 16; ++kk) {
            const f32x4 av = *(const f32x4*)(As + kk * 132 + ty * 4), bv = *(const f32x4*)(Bs + kk * 64 + tx * 4);
            const float aa[4] = {av.x, av.y, av.z, av.w}, bb[4] = {bv.x, bv.y, bv.z, bv.w};
#pragma unroll
            for (int i = 0; i < 4; ++i)
#pragma unroll
                for (int j = 0; j < 4; ++j) acc[i][j] += aa[i] * bb[j];
            if (DUAL) { const f32x4 b2 = *(const f32x4*)(Bs2 + kk * 64 + tx * 4); const float b2b[4] = {b2.x, b2.y, b2.z, b2.w};
#pragma unroll
                for (int i = 0; i < 4; ++i)
#pragma unroll
                    for (int j = 0; j < 4; ++j) acc2[i][j] += aa[i] * b2b[j]; }
        }
        __syncthreads();
    }
#pragma unroll
    for (int i = 0; i < 4; ++i)
#pragma unroll
        for (int j = 0; j < 4; ++j) epi(ty * 4 + i, tx * 4 + j, acc[i][j], acc2[i][j]);
}

DEV void p2_inproj_simple(const Args& a, int l, float* lds) {
    const bf16_t* XN = (const bf16_t*)(a.ws + WS_XN); bf16_t* Y = (bf16_t*)(a.ws + WS_Y);
    const float* W = a.in[8] + (size_t)l * 1024 * 3072;
    const int ntm = M / 128, ntn = 3072 / 64;
    for (int it = blockIdx.x; it < ntm * ntn; it += gridDim.x) {
        const int tm = it / ntn, tn = it % ntn, row0 = tm * 128, col0 = tn * 64;
        sgemm_tile<false>(XN + (size_t)row0 * 1024, W + col0, nullptr, 3072, lds, [&](int i, int j, float v, float) {
            const int col = col0 + j; Y[(size_t)(col >> 8) * YARR + (size_t)(row0 + i) * 256 + (col & 255)] = (bf16_t)f2bf(v); });
    }
}

DEV void p6_outproj_simple(const Args& a, int l, float* lds) {
    const bf16_t* MIX = (const bf16_t*)(a.ws + WS_MIX); const float* W = a.in[9] + (size_t)l * 1024 * 1024;
    const int nrows = l == 0 ? M : ML, ntm = nrows / 128, ntn = 1024 / 64;
    for (int it = blockIdx.x; it < ntm * ntn; it += gridDim.x) {
        const int tm = it / ntn, tn = it % ntn, row0 = tm * 128, col0 = tn * 64;
        const float* g1 = modp(a, l, modrow(row0), 2);
        const float* base; float* dst;
        if (row0 < ML) { base = (l == 0 ? a.in[0] : a.out) + (size_t)row0 * D; dst = a.out + (size_t)row0 * D; }
        else { base = a.in[2] + (size_t)(row0 - ML) * D; dst = (float*)(a.ws + WS_XC) + (size_t)(row0 - ML) * D; }
        sgemm_tile<false>(MIX + (size_t)row0 * 1024, W + col0, nullptr, 1024, lds, [&](int i, int j, float v, float) {
            const int col = col0 + j; dst[(size_t)i * D + col] = base[(size_t)i * D + col] + g1[col] * v; });
    }
}

DEV void p9_moe1_simple(const Args& a, int l, float* lds) {
    const bf16_t* XG = (const bf16_t*)(a.ws + WS_XG); bf16_t* HID = (bf16_t*)(a.ws + WS_HID);
    const int rows_e = l == 0 ? SLOTS : NB * CAPL, ntm = rows_e / 128, ntn = 1024 / 64;
    for (int it = blockIdx.x; it < 16 * ntm * ntn; it += gridDim.x) {
        const int e = it / (ntm * ntn), rem = it % (ntm * ntn), tm = rem / ntn, tn = rem % ntn, row0 = tm * 128, col0 = tn * 64;
        const size_t eoff = ((size_t)l * 16 + e) * 1024 * 1024;
        bf16_t* hp = HID + ((size_t)e * SLOTS + row0) * 1024;
        sgemm_tile<true>(XG + ((size_t)e * SLOTS + row0) * 1024, a.in[23] + eoff + col0, a.in[24] + eoff + col0, 1024, lds, [&](int i, int j, float g, float u) {
            hp[(size_t)i * 1024 + col0 + j] = (bf16_t)f2bf(siluf(g) * u); });
    }
}

DEV void p10_moe2_simple(const Args& a, int l, float* lds) {
    const bf16_t* HID = (const bf16_t*)(a.ws + WS_HID); bf16_t* Y2 = (bf16_t*)(a.ws + WS_Y2);
    const int rows_e = l == 0 ? SLOTS : NB * CAPL, ntm = rows_e / 128, ntn = 1024 / 64;
    for (int it = blockIdx.x; it < 16 * ntm * ntn; it += gridDim.x) {
        const int e = it / (ntm * ntn), rem = it % (ntm * ntn), tm = rem / ntn, tn = rem % ntn, row0 = tm * 128, col0 = tn * 64;
        const size_t eoff = ((size_t)l * 16 + e) * 1024 * 1024;
        bf16_t* yp = Y2 + ((size_t)e * SLOTS + row0) * 1024;
        sgemm_tile<false>(HID + ((size_t)e * SLOTS + row0) * 1024, a.in[25] + eoff + col0, nullptr, 1024, lds, [&](int i, int j, float v, float) {
            yp[(size_t)i * 1024 + col0 + j] = (bf16_t)f2bf(v); });
    }
}


#define LDS3(p) ((__attribute__((address_space(3))) unsigned char*)(p))
DEV void p2_inproj_mfma(const Args& a, int l, unsigned char* lds_raw) {
    { unsigned* TAB = (unsigned*)(lds_raw + pg8::STAGE_BYTES);
      for (int i = ltid(); i < 1024; i += NTHREADS) { const float inv = exp2f(-(float)(i & 15) * (13.287712379549449f / 16.f)); float sn, cs; sincosf((float)(i >> 4) * inv, &sn, &cs); TAB[i] = f2bf(cs) | (f2bf(sn) << 16); }
      __syncthreads(); }
    pg8::Gemm g{(const bf16_t*)(a.ws + WS_XN), (const bf16_t*)(a.ws + WS_WT + WT_IN), M, 3072, 1024}; pg8::StaticOrder S; S.init(M, 3072, gridDim.x, blockIdx.x);
    pg8::EpiInproj E{{(bf16_t*)(a.ws + WS_Y), 256, nullptr, 256, YARR, 1.f}, a.in[10] + l * 64, a.in[11] + l * 64, C2, EPS, LDS3(lds_raw) + pg8::STAGE_BYTES};
    pg8::gemm_phase<pg8::EpiInproj, pg8::StaticOrder, true, true>(LDS3(lds_raw), g, S, E);
}
DEV void p6_outproj_mfma(const Args& a, int l, unsigned char* lds_raw) {
    const int nrows = l == 0 ? M : ML;
    pg8::Gemm g{(const bf16_t*)(a.ws + WS_MIX), (const bf16_t*)(a.ws + WS_WT + WT_OUT), nrows, 1024, 1024}; pg8::StaticOrder S; S.init(nrows, 1024, gridDim.x, blockIdx.x);
    pg8::EpiRes E{a.in[0], a.out, a.in[2], (float*)(a.ws + WS_XC), (const float*)(a.ws + WS_MOD) + (size_t)l * 9 * 6144, l};
    pg8::gemm_phase<pg8::EpiRes, pg8::StaticOrder, true, true>(LDS3(lds_raw), g, S, E);
}
DEV void p9_moe1_mfma(const Args& a, int l, unsigned char* lds_raw) {
    pg8::Gemm g{(const bf16_t*)(a.ws + WS_XN), (const bf16_t*)(a.ws + WS_WT + WT_GU), 16 * SLOTS, 16 * 2048, 512};
    pg8::GroupOrder S{l == 0 ? 17 : 16, 8, (int)gridDim.x, (int)blockIdx.x};
    pg8::EpiSwiglu E{(bf16_t*)(a.ws + WS_HID)};
    pg8::gemm_phase_gather<pg8::EpiSwiglu, pg8::GroupOrder, true, true>(LDS3(lds_raw), g, (const int*)(a.ws + WS_IDX), S, E);
}
DEV void p10_moe2_mfma(const Args& a, int l, unsigned char* lds_raw) {
    pg8::Gemm g{(const bf16_t*)(a.ws + WS_HID), (const bf16_t*)(a.ws + WS_WT + WT_DN), 16 * SLOTS, 16 * 1024, USE_FP8_MOE2 ? 512 : 1024};
    pg8::GroupOrder S{l == 0 ? 17 : 16, 4, (int)gridDim.x, (int)blockIdx.x};
    pg8::EpiBf16Grp E{(bf16_t*)(a.ws + WS_Y2), 1024, 4};
    if (USE_FP8_MOE2) pg8::gemm_phase_fp8<pg8::EpiBf16Grp, pg8::GroupOrder, true>(LDS3(lds_raw), g, S, E, 122, 124);
    else pg8::gemm_phase<pg8::EpiBf16Grp, pg8::GroupOrder, true, true>(LDS3(lds_raw), g, S, E);
}
DEV void p3_qknorm(const Args& a, int l, float* ldsf) {
    const int tid = ltid(), lane = tid & 63, wave = tid >> 6;
    const int gw = blockIdx.x * NWAVES + wave, NGW = gridDim.x * NWAVES;
    bf16_t* Y = (bf16_t*)(a.ws + WS_Y);
    const int d0 = (lane & 15) * 4;
    float* TC = ldsf; float* TS = ldsf + 1024;
    for (int i = tid; i < 1024; i += NTHREADS) { const float inv = exp2f(-(float)(i & 15) * (13.287712379549449f / 16.f)); float sn, cs; sincosf((float)(i >> 4) * inv, &sn, &cs); TC[i] = cs; TS[i] = sn; }
    __syncthreads();
    u32x2 w[4], wn[4];
#define QK_LOAD(dst, rr) do { _Pragma("unroll") for (int arr = 0; arr < 4; ++arr) dst[arr] = *(const u32x2*)(Y + (size_t)arr * YARR + (size_t)(rr) * 256 + lane * 4); } while (0)
    if (gw < M) QK_LOAD(w, gw);
    float gq[4], gk[4];
#pragma unroll
    for (int j = 0; j < 4; ++j) { gq[j] = a.in[10][l * 64 + d0 + j]; gk[j] = a.in[11][l * 64 + d0 + j]; }
    for (int r = gw; r < M; r += NGW) {
        if (r + NGW < M) QK_LOAD(wn, r + NGW);
        f32x4 c4 = (f32x4){1.f, 1.f, 1.f, 1.f}, s4 = (f32x4){0.f, 0.f, 0.f, 0.f};
        if (r < ML) { const int t = r & 4095, pos = ((lane & 15) < 8) ? (t >> 6) : (t & 63); c4 = *(const f32x4*)(TC + pos * 16 + (d0 & 15)); s4 = *(const f32x4*)(TS + pos * 16 + (d0 & 15)); }
        const float cs[4] = {c4.x, c4.y, c4.z, c4.w}, sn[4] = {s4.x, s4.y, s4.z, s4.w};
        const bool first = (lane & 4) == 0;
#pragma unroll
        for (int arr = 0; arr < 4; ++arr) {
            float v[4] = {bf2f(w[arr].x & 0xffffu), bf2f(w[arr].x >> 16), bf2f(w[arr].y & 0xffffu), bf2f(w[arr].y >> 16)};
            float ss = v[0] * v[0] + v[1] * v[1] + v[2] * v[2] + v[3] * v[3];
            ss = row_sum16(ss);
            const float rstd = 1.0f / sqrtf(ss * (1.f / 64.f) + EPS) * (arr < 2 ? C2 : 1.f);
#pragma unroll
            for (int j = 0; j < 4; ++j) v[j] *= rstd * (arr < 2 ? gq[j] : gk[j]);
            if (r < ML) {
#pragma unroll
                for (int j = 0; j < 4; ++j) { const float pv = dppf<DPP_X3>(dppf<DPP_X7>(v[j])); v[j] = first ? (v[j] * cs[j] - pv * sn[j]) : (pv * sn[j] + v[j] * cs[j]); }
            }
            st4bf(Y + (size_t)arr * YARR + (size_t)r * 256 + lane * 4, v);
        }
#pragma unroll
        for (int arr = 0; arr < 4; ++arr) w[arr] = wn[arr];
    }
#undef QK_LOAD
}

DEV int ret_row0(int b, int c) { return c < 2 ? ML + b * 256 + c * 128 : b * 4096 + (c - 2) * 128; }
DEV void p3_retU(const Args& a, int l, float* lds) {
    const int tid = ltid();
    float* Ks = lds; float* Vs = lds + 128 * 64;
    const bf16_t* Y = (const bf16_t*)(a.ws + WS_Y); float* RS = (float*)(a.ws + WS_RETS);
    for (int it = blockIdx.x; it < NB * 4 * RET_CH; it += gridDim.x) {
        const int c = it % RET_CH, bh = it / RET_CH, h = bh & 3, b = bh >> 2, row0 = ret_row0(b, c);
        for (int i = tid; i < 128 * 16; i += NTHREADS) { const int m = i >> 4, q4 = (i & 15) * 4;
            ld4bf(Y + 7 * YARR + (size_t)(row0 + m) * 256 + h * 64 + q4, Ks + m * 64 + q4); ld4bf(Y + 8 * YARR + (size_t)(row0 + m) * 256 + h * 64 + q4, Vs + m * 64 + q4); }
        __syncthreads();
        const float lgf = a.in[14][l * 8 + h], lgb = a.in[14][l * 8 + 4 + h];
        const int d = tid >> 3, v0 = (tid & 7) * 8;
        float af[8], ab[8];
#pragma unroll
        for (int j = 0; j < 8; ++j) { af[j] = 0.f; ab[j] = 0.f; }
        for (int m = 0; m < 128; ++m) {
            const float kk = Ks[m * 64 + d] * 0.125f, wf = kk * expf(lgf * (float)(127 - m)), wb = kk * expf(lgb * (float)m);
#pragma unroll
            for (int j = 0; j < 8; ++j) { const float vv = Vs[m * 64 + v0 + j]; af[j] += wf * vv; ab[j] += wb * vv; }
        }
        float* o = RS + ((size_t)(bh * RET_CH + c) * 2) * 4096 + d * 64 + v0;
#pragma unroll
        for (int j = 0; j < 8; ++j) { o[j] = af[j]; o[4096 + j] = ab[j]; }
        __syncthreads();
    }
}

constexpr int UBP_ = 132;
constexpr float LOG2E_F = 1.4426950408889634f;
DEV void lru_fetch(const Args& a, int b, int c, int tid, u32x2 (&pre)[5]) {
    const bf16_t* YX = (const bf16_t*)(a.ws + WS_Y) + 10 * YARR;
    const int seqlen = c < 8 ? 256 : 4096, t0 = c < 8 ? c * 32 : (c - 8) * 32, rowbase = c < 8 ? ML + b * 256 : b * 4096;
#pragma unroll
    for (int q = 0; q < 5; ++q) { const int i = tid + q * NTHREADS, ri = i >> 6, c4 = (i & 63) * 4, ts = t0 - 2 + ri; pre[q] = (u32x2){0u, 0u};
        if (i < 35 * 64 && ts >= 0 && ts < seqlen) pre[q] = *(const u32x2*)(YX + (size_t)(rowbase + ts) * 256 + c4); }
}
constexpr int LRU_CW = 30000;
DEV void lru_conv_init(const Args& a, int l, int tid, float* lds) {
    for (int i = tid; i < 1280; i += NTHREADS) lds[LRU_CW + i] = i < 1024 ? a.in[16][l * 1024 + i] : a.in[17][l * 256 + i - 1024];
}
DEV void lru_load_u(const u32x2 (&pre)[5], float* Xs, float* Us, unsigned* UB) {
    const int tid = ltid();
#pragma unroll
    for (int q = 0; q < 5; ++q) { const int i = tid + q * NTHREADS, ri = i >> 6, c4 = (i & 63) * 4;
        if (i < 35 * 64) *(f32x4*)(Xs + ri * 256 + c4) = (f32x4){bf2f(pre[q].x & 0xffffu), bf2f(pre[q].x >> 16), bf2f(pre[q].y & 0xffffu), bf2f(pre[q].y >> 16)}; }
    lds_barrier();
    const int cp = tid & 127, q = tid >> 7;
    f32x2_t cw[5];
#pragma unroll
    for (int k = 0; k < 5; ++k) cw[k] = *(const f32x2_t*)(Xs + LRU_CW + k * 256 + 2 * cp);
#pragma unroll
    for (int hf = 0; hf < 2; ++hf) { f32x2_t xr[7];
#pragma unroll
        for (int i = 0; i < 7; ++i) xr[i] = *(const f32x2_t*)(Xs + (q * 8 + hf * 4 + i) * 256 + 2 * cp);
#pragma unroll
        for (int t = 0; t < 4; ++t) { const int tt = q * 8 + hf * 4 + t;
            const float u0 = cw[4].x + cw[0].x * xr[t].x + cw[1].x * xr[t + 1].x + cw[2].x * xr[t + 2].x + cw[3].x * xr[t + 3].x;
            const float u1 = cw[4].y + cw[0].y * xr[t].y + cw[1].y * xr[t + 1].y + cw[2].y * xr[t + 2].y + cw[3].y * xr[t + 3].y;
            *(f32x2_t*)(Us + tt * 256 + 2 * cp) = (f32x2_t){u0, u1}; UB[tt * UBP_ + cp] = pk2(u0, u1); } }
    lds_barrier();
}
struct LruGate { unsigned wr[32], wi[32]; float br, bi, cl; };
DEV void lru_gate_init(const Args& a, int l, int dir, int ch, LruGate& G) {
    const int blk = ch >> 6, cc = ch & 63;
    const float* w = a.in[18] + ((size_t)(((l * 2 + dir) * 2 + 0) * 4 + blk) * 64) * 64 + cc;
    const float* w2 = a.in[18] + ((size_t)(((l * 2 + dir) * 2 + 1) * 4 + blk) * 64) * 64 + cc;
#pragma unroll
    for (int c = 0; c < 32; ++c) { G.wr[c] = pk2(w[(2 * c) * 64], w[(2 * c + 1) * 64]); G.wi[c] = pk2(w2[(2 * c) * 64], w2[(2 * c + 1) * 64]); }
    G.br = a.in[19][((l * 2 + dir) * 2 + 0) * 256 + ch]; G.bi = a.in[19][((l * 2 + dir) * 2 + 1) * 256 + ch];
    G.cl = -8.f * log1pf(expf(-a.in[20][(l * 2 + dir) * 256 + ch]));
}
DEV void lru_ab(const LruGate& G, const float* Us, const unsigned* UB, int tt, int ch, float& aa, float& bb) {
    const unsigned* u = UB + tt * UBP_ + ((ch >> 6) << 5);
    float ur = G.br, ui = G.bi, ur2 = 0.f, ui2 = 0.f;
#pragma unroll
    for (int c4 = 0; c4 < 8; ++c4) { const u32x4 x = *(const u32x4*)(u + c4 * 4);
        ur = dot2bf(G.wr[4 * c4], x.x, ur); ur2 = dot2bf(G.wr[4 * c4 + 1], x.y, ur2); ur = dot2bf(G.wr[4 * c4 + 2], x.z, ur); ur2 = dot2bf(G.wr[4 * c4 + 3], x.w, ur2);
        ui = dot2bf(G.wi[4 * c4], x.x, ui); ui2 = dot2bf(G.wi[4 * c4 + 1], x.y, ui2); ui = dot2bf(G.wi[4 * c4 + 2], x.z, ui); ui2 = dot2bf(G.wi[4 * c4 + 3], x.w, ui2); }

    const float la = G.cl * fsigm(ur + ur2); aa = __builtin_amdgcn_exp2f(1.4426950408889634f * la); bb = __builtin_amdgcn_sqrtf(fmaxf(1.f - aa * aa, 0.f)) * fsigm(ui + ui2) * Us[tt * 256 + ch];

}

DEV void p3_lru_agg(const Args& a, int l, float* lds) {
    const int tid = ltid(), ch = tid & 255, dir = tid >> 8;
    float* Xs = lds; float* Us = lds + 35 * 256; unsigned* UB = (unsigned*)(Us + 32 * 256);
    float* AGG = (float*)(a.ws + WS_LAGG);
    LruGate G; lru_gate_init(a, l, dir, ch, G);
    for (int it = blockIdx.x; it < NB * LRU_CH; it += gridDim.x) {
        const int b = it / LRU_CH, c = it % LRU_CH;
        { u32x2 pre_[5]; lru_conv_init(a, l, tid, lds); lru_fetch(a, b, c, tid, pre_); lru_load_u(pre_, Xs, Us, UB); }
        float P = 1.f, H = 0.f;
#pragma unroll 4
        for (int tt = 0; tt < 32; ++tt) { float aa, bb; lru_ab(G, Us, UB, tt, ch, aa, bb); H = dir == 0 ? aa * H + bb : H + P * bb; P *= aa; }
        float* o = AGG + ((size_t)(b * LRU_CH + c) * 2 + dir) * 512 + ch; o[0] = P; o[256] = H;
        __syncthreads();
    }
}


constexpr int UBP = 132;
struct LruW { bf16x8_t w[2][2][4]; float br[2], bi[2], cl[2]; };
DEV void lru_w_init(const Args& a, int l, int dir, int blk, int r32, int hi, LruW& W) {
#pragma unroll
    for (int g = 0; g < 2; ++g)
#pragma unroll
        for (int nt = 0; nt < 2; ++nt) {
#pragma unroll
            for (int ks = 0; ks < 4; ++ks) W.w[g][nt][ks] = *(const bf16x8_t*)(a.ws + WS_LRUW + ((size_t)(((((dir * 2 + g) * 4 + blk) * 2 + nt) * 4 + ks) * 64) + hi * 32 + r32) * 16); }
#pragma unroll
    for (int nt = 0; nt < 2; ++nt) { const int ch = blk * 64 + nt * 32 + r32;
        W.br[nt] = a.in[19][((l * 2 + dir) * 2 + 0) * 256 + ch]; W.bi[nt] = a.in[19][((l * 2 + dir) * 2 + 1) * 256 + ch];
        W.cl[nt] = -8.f * LOG2E_F * log1pf(expf(-a.in[20][(l * 2 + dir) * 256 + ch])); }
}
DEV void lru_ufrags(const unsigned* UB, int blk, int r32, int hi, bf16x8_t (&uf)[4]) {
#pragma unroll
    for (int ks = 0; ks < 4; ++ks) uf[ks] = *(const bf16x8_t*)((const unsigned char*)UB + r32 * (UBP * 4) + (blk * 64 + 16 * ks + 8 * hi) * 2);
}
DEV void lru_ab_nt(const LruW& W, const bf16x8_t (&uf)[4], const float* Us, int blk, int r32, int hi, int nt, f32x16& A, f32x16& B) {
    f32x16 gr, gi;
#pragma unroll
    for (int r = 0; r < 16; ++r) { gr[r] = W.br[nt]; gi[r] = W.bi[nt]; }
#pragma unroll
    for (int ks = 0; ks < 4; ++ks) { gr = __builtin_amdgcn_mfma_f32_32x32x16_bf16(uf[ks], W.w[0][nt][ks], gr, 0, 0, 0); gi = __builtin_amdgcn_mfma_f32_32x32x16_bf16(uf[ks], W.w[1][nt][ks], gi, 0, 0, 0); }
#pragma unroll
    for (int r = 0; r < 16; ++r) { const float aa = __builtin_amdgcn_exp2f(W.cl[nt] * fsigm(gr[r]));
        A[r] = aa; B[r] = __builtin_amdgcn_sqrtf(fmaxf(1.f - aa * aa, 0.f)) * fsigm(gi[r]) * Us[crow16(r, hi) * 256 + blk * 64 + nt * 32 + r32]; }
}
template <bool FWD> DEV void lru_segs(const f32x16& A, const f32x16& B, float (&Am)[4], float (&Bm)[4]) {
#pragma unroll
    for (int s = 0; s < 4; ++s) { float pa = 1.f, pb = 0.f;
#pragma unroll
        for (int i = 0; i < 4; ++i) { const int r = 4 * s + (FWD ? i : 3 - i); pb = A[r] * pb + B[r]; pa *= A[r]; }
        Am[s] = pa; Bm[s] = pb; }
}
template <bool FWD> DEV float lru_walk(const float (&Am)[4], const float (&Bm)[4], int hi, float h, float (&start)[4]) {
#pragma unroll
    for (int q = 0; q < 4; ++q) { const int s = FWD ? q : 3 - q;
        const auto sa = __builtin_amdgcn_permlane32_swap(__float_as_uint(Am[s]), __float_as_uint(Am[s]), false, false), sb = __builtin_amdgcn_permlane32_swap(__float_as_uint(Bm[s]), __float_as_uint(Bm[s]), false, false);
        const float Ae = __uint_as_float(sa[0]), Be = __uint_as_float(sb[0]), Ao = __uint_as_float(sa[1]), Bo = __uint_as_float(sb[1]);
        if (FWD) { const float h1 = Ae * h + Be; start[s] = hi ? h1 : h; h = Ao * h1 + Bo; }
        else { const float h1 = Ao * h + Bo; start[s] = hi ? h : h1; h = Ae * h1 + Be; } }
    return h;
}
DEV void p3_lru_agg_mfma(const Args& a, int l, float* lds) {
    const int tid = ltid(), lane = tid & 63, wave = __builtin_amdgcn_readfirstlane(tid >> 6), r32 = lane & 31, hi = lane >> 5, dir = wave >> 2, blk = wave & 3;
    float* Xs = lds; float* Us = lds + 35 * 256; unsigned* UB = (unsigned*)(Us + 32 * 256);
    float* AGG = (float*)(a.ws + WS_LAGG);
    LruW W; lru_w_init(a, l, dir, blk, r32, hi, W);
    lru_conv_init(a, l, tid, lds);
    u32x2 pre[5];
    const int vb = (blockIdx.x + 64) % gridDim.x;
    if (vb < NB * LRU_CH) lru_fetch(a, vb / LRU_CH, vb % LRU_CH, tid, pre);
    for (int it = vb; it < NB * LRU_CH; it += gridDim.x) {
        const int b = it / LRU_CH, c = it % LRU_CH;
        lru_load_u(pre, Xs, Us, UB);
        if (it + (int)gridDim.x < NB * LRU_CH) lru_fetch(a, (it + gridDim.x) / LRU_CH, (it + gridDim.x) % LRU_CH, tid, pre);
        bf16x8_t uf[4]; lru_ufrags(UB, blk, r32, hi, uf);
#pragma unroll
        for (int nt = 0; nt < 2; ++nt) { float Am[4], Bm[4], st[4]; float h, P; f32x16 A, B; lru_ab_nt(W, uf, Us, blk, r32, hi, nt, A, B);
            if (dir == 0) { lru_segs<true>(A, B, Am, Bm); h = lru_walk<true>(Am, Bm, hi, 0.f, st); } else { lru_segs<false>(A, B, Am, Bm); h = lru_walk<false>(Am, Bm, hi, 0.f, st); }
            P = Am[0] * Am[1] * Am[2] * Am[3]; { const auto sp = __builtin_amdgcn_permlane32_swap(__float_as_uint(P), __float_as_uint(P), false, false); P = __uint_as_float(sp[0]) * __uint_as_float(sp[1]); }
            if (hi == 0) { float* o = AGG + ((size_t)(b * LRU_CH + c) * 2 + dir) * 512 + blk * 64 + nt * 32 + r32; o[0] = P; o[256] = h; } }
        lds_barrier();
    }
}
DEV void p5_lru_out_mfma(const Args& a, int l, float* lds) {
    const int tid = ltid(), lane = tid & 63, wave = __builtin_amdgcn_readfirstlane(tid >> 6), r32 = lane & 31, hi = lane >> 5, dir = wave >> 2, blk = wave & 3;
    float* Xs = lds; float* Us = lds + 35 * 256; float* HF = Us + 32 * 256; float* HB = Xs; unsigned* UB = (unsigned*)(HF + 32 * 256);
    const float* CAR = (const float*)(a.ws + WS_LCAR); bf16_t* MIX = (bf16_t*)(a.ws + WS_MIX); const bf16_t* YG = (const bf16_t*)(a.ws + WS_Y) + 11 * YARR;
    LruW W; lru_w_init(a, l, dir, blk, r32, hi, W);
    lru_conv_init(a, l, tid, lds);
    const f32x4 ng = *(const f32x4*)(a.in[21] + l * 256 + lane * 4);
    const int c_lo = l == 0 ? 0 : 8;
    u32x2 pre[5];
    const int vb = (blockIdx.x + 192) % gridDim.x;
    if (vb < NB * (LRU_CH - c_lo)) lru_fetch(a, vb / (LRU_CH - c_lo), c_lo + vb % (LRU_CH - c_lo), tid, pre);
    for (int it = vb; it < NB * (LRU_CH - c_lo); it += gridDim.x) {
        const int b = it / (LRU_CH - c_lo), c = c_lo + it % (LRU_CH - c_lo);
        const int rowbase = c < 8 ? ML + b * 256 + c * 32 : b * 4096 + (c - 8) * 32;
        u32x2 gq[4]; float h0v[2];
#pragma unroll
        for (int q = 0; q < 4; ++q) gq[q] = *(const u32x2*)(YG + (size_t)(rowbase + (tid >> 6) * 4 + q) * 256 + lane * 4);
#pragma unroll
        for (int nt = 0; nt < 2; ++nt) h0v[nt] = CAR[((size_t)(b * LRU_CH + c) * 2 + dir) * 256 + blk * 64 + nt * 32 + r32];
        lru_load_u(pre, Xs, Us, UB);
        { const int itn = it + gridDim.x; if (itn < NB * (LRU_CH - c_lo)) lru_fetch(a, itn / (LRU_CH - c_lo), c_lo + itn % (LRU_CH - c_lo), tid, pre); }
        bf16x8_t uf[4]; lru_ufrags(UB, blk, r32, hi, uf);
        float* H = dir == 0 ? HF : HB;
#pragma unroll
        for (int nt = 0; nt < 2; ++nt) { const int ch = blk * 64 + nt * 32 + r32; float Am[4], Bm[4], st[4]; f32x16 An, Bn; lru_ab_nt(W, uf, Us, blk, r32, hi, nt, An, Bn);
            const float h0 = h0v[nt];
            if (dir == 0) { lru_segs<true>(An, Bn, Am, Bm); lru_walk<true>(Am, Bm, hi, h0, st);
#pragma unroll
                for (int s = 0; s < 4; ++s) { float h = st[s];
#pragma unroll
                    for (int i = 0; i < 4; ++i) { const int r = 4 * s + i; h = An[r] * h + Bn[r]; H[crow16(r, hi) * 256 + ch] = h; } } }
            else { lru_segs<false>(An, Bn, Am, Bm); lru_walk<false>(Am, Bm, hi, h0, st);
#pragma unroll
                for (int s = 0; s < 4; ++s) { float h = st[s];
#pragma unroll
                    for (int i = 3; i >= 0; --i) { const int r = 4 * s + i; h = An[r] * h + Bn[r]; H[crow16(r, hi) * 256 + ch] = h; } } } }
        lds_barrier();
#pragma unroll
        for (int q = 0; q < 4; ++q) {
            const int tt = (tid >> 6) * 4 + q, row = rowbase + tt;
            const float g[4] = {bf2f(gq[q].x & 0xffffu), bf2f(gq[q].x >> 16), bf2f(gq[q].y & 0xffffu), bf2f(gq[q].y >> 16)};
            const f32x4 hf = *(const f32x4*)(HF + tt * 256 + lane * 4), hb = *(const f32x4*)(HB + tt * 256 + lane * 4);
            float y[4] = {(hf.x + hb.x) * gelu_tanh(g[0]), (hf.y + hb.y) * gelu_tanh(g[1]), (hf.z + hb.z) * gelu_tanh(g[2]), (hf.w + hb.w) * gelu_tanh(g[3])};
            const float rstd = __builtin_amdgcn_rsqf(wave_sum(y[0] * y[0] + y[1] * y[1] + y[2] * y[2] + y[3] * y[3]) * (1.f / 256.f) + EPS);
            y[0] *= rstd * ng.x; y[1] *= rstd * ng.y; y[2] *= rstd * ng.z; y[3] *= rstd * ng.w;
            st4bf(MIX + (size_t)row * D + 768 + lane * 4, y);
        }
        lds_barrier();
    }
}
DEV void p4_lru_carry(const Args& a, float* lds) {
    const int tid = ltid(), j = tid & 15, part = tid >> 4;
    float* SA = lds; float* SH = lds + 272; float* SC = lds + 544;
    for (int g = blockIdx.x; g < NB * 2 * 256 / 16; g += gridDim.x) {
        const int cid = g * 16 + j, ch = cid & 255, dir = (cid >> 8) & 1, b = cid >> 9;
        const float* AGG = (const float*)(a.ws + WS_LAGG) + ((size_t)b * LRU_CH * 2 + dir) * 512 + ch;
        float* CAR = (float*)(a.ws + WS_LCAR) + ((size_t)b * LRU_CH * 2 + dir) * 256 + ch;
        float A8[8], H8[8]; int cc[8];
        if (part < 17) {
#pragma unroll
            for (int i = 0; i < 8; ++i) { const int k = part * 8 + i; cc[i] = dir == 0 ? k : (k < 8 ? 7 - k : LRU_CH - 1 - (k - 8)); A8[i] = AGG[(size_t)cc[i] * 1024]; H8[i] = AGG[(size_t)cc[i] * 1024 + 256]; }
            float Ac = 1.f, Hc = 0.f;
#pragma unroll
            for (int i = 0; i < 8; ++i) { Hc = A8[i] * Hc + H8[i]; Ac *= A8[i]; }
            SA[part * 16 + j] = Ac; SH[part * 16 + j] = Hc;
        }
        __syncthreads();
        if (tid < 16) { float carry = 0.f;
#pragma unroll
            for (int p = 0; p < 17; ++p) { SC[p * 16 + tid] = carry; carry = SA[p * 16 + tid] * carry + SH[p * 16 + tid]; } }
        __syncthreads();
        if (part < 17) { float carry = SC[part * 16 + j];
#pragma unroll
            for (int i = 0; i < 8; ++i) { CAR[(size_t)cc[i] * 512] = carry; carry = A8[i] * carry + H8[i]; } }
        __syncthreads();
    }
}

DEV void p5_lru_out(const Args& a, int l, float* lds) {
    const int tid = ltid(), ch = tid & 255, dir = tid >> 8, lane = tid & 63, wave = tid >> 6;
    float* Xs = lds; float* Us = lds + 35 * 256; float* HF = Us + 32 * 256; float* HB = Xs ; unsigned* UB = (unsigned*)(HF + 32 * 256);
    const float* CAR = (const float*)(a.ws + WS_LCAR); bf16_t* MIX = (bf16_t*)(a.ws + WS_MIX); const bf16_t* YG = (const bf16_t*)(a.ws + WS_Y) + 11 * YARR;
    LruGate G; lru_gate_init(a, l, dir, ch, G);
    const int c_lo = l == 0 ? 0 : 8;
    for (int it = blockIdx.x; it < NB * (LRU_CH - c_lo); it += gridDim.x) {
        const int b = it / (LRU_CH - c_lo), c = c_lo + it % (LRU_CH - c_lo);
        { u32x2 pre_[5]; lru_conv_init(a, l, tid, lds); lru_fetch(a, b, c, tid, pre_); lru_load_u(pre_, Xs, Us, UB); }

        float h = CAR[((size_t)(b * LRU_CH + c) * 2 + dir) * 256 + ch];

        if (dir == 0) {
#pragma unroll 4
            for (int tt = 0; tt < 32; ++tt) { float aa, bb; lru_ab(G, Us, UB, tt, ch, aa, bb); h = aa * h + bb; HF[tt * 256 + ch] = h; } }
        else {
#pragma unroll 4
            for (int tt = 31; tt >= 0; --tt) { float aa, bb; lru_ab(G, Us, UB, tt, ch, aa, bb); h = aa * h + bb; HB[tt * 256 + ch] = h; } }

        __syncthreads();
        const int rowbase = c < 8 ? ML + b * 256 + c * 32 : b * 4096 + (c - 8) * 32;

        const f32x4 ng = *(const f32x4*)(a.in[21] + l * 256 + lane * 4);

#pragma unroll
        for (int q = 0; q < 4; ++q) {
            const int tt = wave * 4 + q, row = rowbase + tt;
            float g[4]; ld4bf(YG + (size_t)row * 256 + lane * 4, g);
            const f32x4 hf = *(const f32x4*)(HF + tt * 256 + lane * 4), hb = *(const f32x4*)(HB + tt * 256 + lane * 4);
            float y[4] = {(hf.x + hb.x) * gelu_tanh(g[0]), (hf.y + hb.y) * gelu_tanh(g[1]), (hf.z + hb.z) * gelu_tanh(g[2]), (hf.w + hb.w) * gelu_tanh(g[3])};
            const float rstd = __builtin_amdgcn_rsqf(wave_sum(y[0] * y[0] + y[1] * y[1] + y[2] * y[2] + y[3] * y[3]) * (1.f / 256.f) + EPS);
            y[0] *= rstd * ng.x; y[1] *= rstd * ng.y; y[2] *= rstd * ng.z; y[3] *= rstd * ng.w;
            st4bf(MIX + (size_t)row * D + 768 + lane * 4, y);
        }
        __syncthreads();
    }
}


constexpr float LOG2E = 1.4426950408889634f;
DEV void p3_ret_prep(const Args& a, int l, unsigned char* lds) {
    const int tid = ltid(), lane = tid & 63, wave = __builtin_amdgcn_readfirstlane(tid >> 6), r32 = lane & 31, hi = lane >> 5, dir = wave >> 2, vt = (wave >> 1) & 1, dt = wave & 1;
    const bf16_t* Y = (const bf16_t*)(a.ws + WS_Y); bf16_t* RVT = (bf16_t*)(a.ws + WS_RVT); float* RS = (float*)(a.ws + WS_RETS);
    constexpr int ROWB = 272, TILE = 64 * ROWB, STG = 3 * TILE;
    bf16_t* Lk = (bf16_t*)(lds + STG); bf16_t* Lv = Lk + 128 * 72;
    u32x4 pre[4];
#define RP_FETCH(itx) do { const int c_ = (itx) % RET_CH, bh_ = (itx) / RET_CH, h_ = bh_ & 3, b_ = bh_ >> 2, row0_ = ret_row0(b_, c_); \
        _Pragma("unroll") for (int q = 0; q < 4; ++q) { const int i = tid + q * NTHREADS, arr = i >> 10, kr = (i >> 3) & 127, c8 = (i & 7) * 8; \
            pre[q] = *(const u32x4*)(Y + (size_t)(7 + arr) * YARR + (size_t)(row0_ + kr) * 256 + h_ * 64 + c8); } } while (0)
    const int vb = (blockIdx.x + 128) % gridDim.x;
    if (vb < NB * 4 * RET_CH) RP_FETCH(vb);
    for (int it = vb; it < NB * 4 * RET_CH; it += gridDim.x) {
        const int c = it % RET_CH, bh = it / RET_CH, h = bh & 3;
#pragma unroll
        for (int q = 0; q < 4; ++q) { const int i = tid + q * NTHREADS, arr = i >> 10, kr = (i >> 3) & 127, c8 = (i & 7) * 8; *(u32x4*)((arr ? Lv : Lk) + kr * 72 + c8) = pre[q]; }
        __syncthreads();
        if (it + (int)gridDim.x < NB * 4 * RET_CH) RP_FETCH(it + gridDim.x);
        { const int dd = tid >> 2, col = dd & 63; const bool isk = dd >= 64;
            const float lgf = a.in[14][l * 8 + h] * LOG2E, lgb = a.in[14][l * 8 + 4 + h] * LOG2E;
            const bf16_t* L = isk ? Lk : Lv;
#pragma unroll
            for (int gg = 0; gg < 2; ++gg) { const int g = (tid & 3) + 4 * gg; unsigned w[8], wb[8];
#pragma unroll
                for (int p2 = 0; p2 < 8; ++p2) { const int p = 2 * p2, ml = g * 16 + 8 * ((p & 7) >> 2) + 4 * (p >> 3) + (p & 3);
                    const unsigned x0 = L[ml * 72 + col], x1 = L[(ml + 1) * 72 + col];
                    if (isk) { const float f0 = bf2f(x0) * 0.125f, f1 = bf2f(x1) * 0.125f;
                        w[p2] = pk2(f0 * __builtin_amdgcn_exp2f(lgf * (float)(127 - ml)), f1 * __builtin_amdgcn_exp2f(lgf * (float)(126 - ml)));
                        wb[p2] = pk2(f0 * __builtin_amdgcn_exp2f(lgb * (float)ml), f1 * __builtin_amdgcn_exp2f(lgb * (float)(ml + 1))); }
                    else { w[p2] = x0 | (x1 << 16); wb[p2] = 0u; } }
                unsigned char* i0 = lds + (isk ? TILE : 0) + col * ROWB + g * 32;
                *(u32x4*)i0 = (u32x4){w[0], w[1], w[2], w[3]}; *(u32x4*)(i0 + 16) = (u32x4){w[4], w[5], w[6], w[7]};
                if (isk) { *(u32x4*)(i0 + TILE) = (u32x4){wb[0], wb[1], wb[2], wb[3]}; *(u32x4*)(i0 + TILE + 16) = (u32x4){wb[4], wb[5], wb[6], wb[7]}; }
                else { bf16_t* d0 = RVT + ((size_t)bh * 64 + col) * 4352 + c * 128 + g * 16; *(u32x4*)d0 = (u32x4){w[0], w[1], w[2], w[3]}; *(u32x4*)(d0 + 8) = (u32x4){w[4], w[5], w[6], w[7]}; } } }
        lds_barrier();
        f32x16 acc;
#pragma unroll
        for (int r = 0; r < 16; ++r) acc[r] = 0.f;
#pragma unroll
        for (int ks = 0; ks < 8; ++ks) {
            const bf16x8_t af = *(const bf16x8_t*)(lds + (vt * 32 + r32) * ROWB + ks * 32 + hi * 16);
            const bf16x8_t bf = *(const bf16x8_t*)(lds + (1 + dir) * TILE + (dt * 32 + r32) * ROWB + ks * 32 + hi * 16);
            acc = __builtin_amdgcn_mfma_f32_32x32x16_bf16(af, bf, acc, 0, 0, 0);
        }
        float* o = RS + ((size_t)(bh * RET_CH + c) * 2 + dir) * 4096 + dt * 32 + r32;
#pragma unroll
        for (int r = 0; r < 16; ++r) o[(vt * 32 + crow16(r, hi)) * 64] = acc[r];
        lds_barrier();
    }
}
DEV void p5_ret_out_mfma(const Args& a, int l, unsigned char* lds) {
    const int tid = ltid(), lane = tid & 63, wave = __builtin_amdgcn_readfirstlane(tid >> 6), r32 = lane & 31, hi = lane >> 5, nt = wave & 3, vt = wave >> 2;
    const bf16_t* Y = (const bf16_t*)(a.ws + WS_Y); const bf16_t* RVT = (const bf16_t*)(a.ws + WS_RVT); const float* RS = (const float*)(a.ws + WS_RETS); bf16_t* MIX = (bf16_t*)(a.ws + WS_MIX);
    constexpr int QROW = 144, QT = 128 * QROW, VROW = 272, VT_ = 64 * VROW;
    const int c_lo = l == 0 ? 0 : 2, ncs = RET_CH - c_lo;
    u32x4 pre[6];
#define RO_FETCH(itx) do { const int c_ = c_lo + (itx) % ncs, bh_ = (itx) / ncs, h_ = bh_ & 3, b_ = bh_ >> 2, row0_ = ret_row0(b_, c_); \
        _Pragma("unroll") for (int q = 0; q < 4; ++q) { const int i = tid + q * NTHREADS, arr = i >> 10, row = (i >> 3) & 127, c16 = i & 7; \
            pre[q] = *(const u32x4*)(Y + (size_t)(6 + arr) * YARR + (size_t)(row0_ + row) * 256 + h_ * 64 + c16 * 8); } \
        _Pragma("unroll") for (int q = 0; q < 2; ++q) { const int i = tid + q * NTHREADS, row = i >> 4, c16 = i & 15; \
            pre[4 + q] = *(const u32x4*)(RVT + ((size_t)bh_ * 64 + row) * 4352 + c_ * 128 + c16 * 8); } } while (0)
    if ((int)blockIdx.x < NB * 4 * ncs) RO_FETCH(blockIdx.x);
    for (int it = blockIdx.x; it < NB * 4 * ncs; it += gridDim.x) {
        const int c = c_lo + it % ncs, bh = it / ncs, h = bh & 3, b = bh >> 2, row0 = ret_row0(b, c);
#pragma unroll
        for (int q = 0; q < 4; ++q) { const int i = tid + q * NTHREADS, arr = i >> 10, row = (i >> 3) & 127, c16 = i & 7; *(u32x4*)(lds + arr * QT + row * QROW + c16 * 16) = pre[q]; }
#pragma unroll
        for (int q = 0; q < 2; ++q) { const int i = tid + q * NTHREADS, row = i >> 4, c16 = i & 15; *(u32x4*)(lds + 2 * QT + row * VROW + c16 * 16) = pre[4 + q]; }
        bf16x8_t sfr[4], sbr[4]; u32x4 gq[2];
        { const bf16_t* Sf = (const bf16_t*)(a.ws + WS_XN) + ((size_t)(bh * RET_CH + c) * 2) * 4096 + (vt * 32 + r32) * 64 + hi * 8;
#pragma unroll
            for (int ks = 0; ks < 4; ++ks) { sfr[ks] = *(const bf16x8_t*)(Sf + ks * 16); sbr[ks] = *(const bf16x8_t*)(Sf + 4096 + ks * 16); }
            const bf16_t* gp = Y + 9 * YARR + (size_t)(row0 + (tid >> 2)) * 256 + h * 64 + (tid & 3) * 16; gq[0] = *(const u32x4*)gp; gq[1] = *(const u32x4*)(gp + 8); }
        __syncthreads();
        if (it + (int)gridDim.x < NB * 4 * ncs) RO_FETCH(it + gridDim.x);
        const float lgf = a.in[14][l * 8 + h] * LOG2E, lgb = a.in[14][l * 8 + 4 + h] * LOG2E;
        bf16x8_t qf[4];
#pragma unroll
        for (int ks = 0; ks < 4; ++ks) qf[ks] = *(const bf16x8_t*)(lds + (nt * 32 + r32) * QROW + ks * 32 + hi * 16);
        f32x16 o;
#pragma unroll
        for (int r = 0; r < 16; ++r) o[r] = 0.f;
        const int n_l = nt * 32 + r32;
#pragma unroll 1
        for (int mt = 0; mt < 4; ++mt) {
            f32x16 x;
#pragma unroll
            for (int r = 0; r < 16; ++r) x[r] = 0.f;
#pragma unroll
            for (int ks = 0; ks < 4; ++ks) { const bf16x8_t kf = *(const bf16x8_t*)(lds + QT + (mt * 32 + r32) * QROW + ks * 32 + hi * 16); x = __builtin_amdgcn_mfma_f32_32x32x16_bf16(kf, qf[ks], x, 0, 0, 0); }
#pragma unroll
            for (int r = 0; r < 16; ++r) { const int m = mt * 32 + crow16(r, hi), df = n_l - m;
                x[r] *= 0.125f * __builtin_amdgcn_exp2f(df >= 0 ? lgf * (float)df : lgb * (float)(-df)); }
#pragma unroll
            for (int sp = 0; sp < 2; ++sp) { u32x4 w; w.x = pk2(x[8 * sp], x[8 * sp + 1]); w.y = pk2(x[8 * sp + 2], x[8 * sp + 3]); w.z = pk2(x[8 * sp + 4], x[8 * sp + 5]); w.w = pk2(x[8 * sp + 6], x[8 * sp + 7]);
                const bf16x8_t vf = *(const bf16x8_t*)(lds + 2 * QT + (vt * 32 + r32) * VROW + (mt * 2 + sp) * 32 + hi * 16);
                o = __builtin_amdgcn_mfma_f32_32x32x16_bf16(__builtin_bit_cast(bf16x8_t, w), vf, o, 0, 0, 0); }
        }
        f32x16 of, ob;
#pragma unroll
        for (int r = 0; r < 16; ++r) { of[r] = 0.f; ob[r] = 0.f; }
#pragma unroll
        for (int ks = 0; ks < 4; ++ks) {
            of = __builtin_amdgcn_mfma_f32_32x32x16_bf16(qf[ks], sfr[ks], of, 0, 0, 0);
            ob = __builtin_amdgcn_mfma_f32_32x32x16_bf16(qf[ks], sbr[ks], ob, 0, 0, 0);
        }
        __syncthreads();
        float* OT = (float*)lds;
#pragma unroll
        for (int r = 0; r < 16; ++r) { const int n = nt * 32 + crow16(r, hi);
            OT[n * 64 + vt * 32 + r32] = o[r] + __builtin_amdgcn_exp2f(lgf * (float)(n + 1)) * of[r] + __builtin_amdgcn_exp2f(lgb * (float)(128 - n)) * ob[r]; }
        __syncthreads();
        { const int n = tid >> 2, v0 = (tid & 3) * 16; float ov[16]; float ss = 0.f;
#pragma unroll
            for (int j4 = 0; j4 < 4; ++j4) { const f32x4 x = *(const f32x4*)(OT + n * 64 + v0 + j4 * 4); ov[j4 * 4] = x.x; ov[j4 * 4 + 1] = x.y; ov[j4 * 4 + 2] = x.z; ov[j4 * 4 + 3] = x.w; ss += (x.x * x.x + x.y * x.y) + (x.z * x.z + x.w * x.w); }
            ss = row_sum4(ss);
            const float rstd = __builtin_amdgcn_rsqf(ss * (1.f / 64.f) + EPS);
            const size_t row = (size_t)(row0 + n); const float* ng = a.in[15] + l * 64 + v0;
            bf16_t* mp = MIX + row * D + 512 + h * 64 + v0;
#pragma unroll
            for (int j4 = 0; j4 < 4; ++j4) { const unsigned g0 = gq[j4 >> 1][(j4 & 1) * 2], g1 = gq[j4 >> 1][(j4 & 1) * 2 + 1]; const float g[4] = {bf2f(g0 & 0xffffu), bf2f(g0 >> 16), bf2f(g1 & 0xffffu), bf2f(g1 >> 16)}; float y[4];
#pragma unroll
                for (int j = 0; j < 4; ++j) y[j] = ov[j4 * 4 + j] * rstd * ng[j4 * 4 + j] * fsiluf(g[j]);
                st4bf(mp + j4 * 4, y); } }
        __syncthreads();
    }
}
DEV void p5_ret_out_dma(const Args& a, int l, unsigned char* lds_) {
    typedef __attribute__((address_space(3))) unsigned char* lptr;
    lptr lds = (lptr)lds_;
    const int tid = ltid(), lane = tid & 63, wave = __builtin_amdgcn_readfirstlane(tid >> 6), r32 = lane & 31, hi = lane >> 5, nt = wave & 3, vt = wave >> 2;
    const bf16_t* Y = (const bf16_t*)(a.ws + WS_Y); const bf16_t* RVT = (const bf16_t*)(a.ws + WS_RVT); bf16_t* MIX = (bf16_t*)(a.ws + WS_MIX);
    constexpr int RB = 65536, KOFF = 16384, VOFF = 32768, GOFF = 49152;
    const int c_lo = l == 0 ? 0 : 2, ncs = RET_CH - c_lo, nitems = NB * 4 * ncs;
#define RD_ISSUE(itx, bufb) do { const int c_ = c_lo + (itx) % ncs, bh_ = (itx) / ncs, h_ = bh_ & 3, b_ = bh_ >> 2, row0_ = ret_row0(b_, c_); \
        _Pragma("unroll") for (int i_ = 0; i_ < 2; ++i_) { const int P_ = (wave * 2 + i_) * 64 + lane; \
            { const int row_ = P_ >> 3, cs_ = (P_ & 7) ^ ((row_ >> 1) & 7); const bf16_t* src_ = Y + (size_t)6 * YARR + (size_t)(row0_ + row_) * 256 + h_ * 64 + cs_ * 8; \
              __builtin_amdgcn_global_load_lds((const unsigned*)src_, (__attribute__((address_space(3))) unsigned*)(lds + (bufb) + (wave * 2 + i_) * 1024), 16, 0, 0); \
              __builtin_amdgcn_global_load_lds((const unsigned*)(src_ + YARR), (__attribute__((address_space(3))) unsigned*)(lds + (bufb) + KOFF + (wave * 2 + i_) * 1024), 16, 0, 0); \
              __builtin_amdgcn_global_load_lds((const unsigned*)(Y + (size_t)9 * YARR + (size_t)(row0_ + row_) * 256 + h_ * 64 + (P_ & 7) * 8), (__attribute__((address_space(3))) unsigned*)(lds + (bufb) + GOFF + (wave * 2 + i_) * 1024), 16, 0, 0); } \
            { const int row_ = P_ >> 4, cs_ = (P_ & 15) ^ (row_ & 15); const bf16_t* src_ = RVT + ((size_t)bh_ * 64 + row_) * 4352 + c_ * 128 + cs_ * 8; \
              __builtin_amdgcn_global_load_lds((const unsigned*)src_, (__attribute__((address_space(3))) unsigned*)(lds + (bufb) + VOFF + (wave * 2 + i_) * 1024), 16, 0, 0); } } } while (0)
    __attribute__((address_space(3))) float* NG = (__attribute__((address_space(3))) float*)(lds + 2 * RB);
    if (tid < 64) NG[tid] = a.in[15][l * 64 + tid];
    bf16x8_t sfr[4], sbr[4];
#define RD_STATE(itx) do { const int c_ = c_lo + (itx) % ncs, bh_ = (itx) / ncs, h_ = bh_ & 3, b_ = bh_ >> 2, row0_ = ret_row0(b_, c_); \
        const bf16_t* Sf_ = (const bf16_t*)(a.ws + WS_XN) + ((size_t)(bh_ * RET_CH + c_) * 2) * 4096 + (vt * 32 + r32) * 64 + hi * 8; \
        _Pragma("unroll") for (int ks = 0; ks < 4; ++ks) { sfr[ks] = *(const bf16x8_t*)(Sf_ + ks * 16); sbr[ks] = *(const bf16x8_t*)(Sf_ + 4096 + ks * 16); } \
        } while (0)
    int it = blockIdx.x, par = 0;
    if (it < nitems) { RD_STATE(it); RD_ISSUE(it, 0); }
    for (; it < nitems; it += gridDim.x, par ^= 1) {
        const int buf = par * RB;
        const int c = c_lo + it % ncs, bh = it / ncs, h = bh & 3, b = bh >> 2, row0 = ret_row0(b, c);
        const float lgf = a.in[14][l * 8 + h] * LOG2E, lgb = a.in[14][l * 8 + 4 + h] * LOG2E;
        __builtin_amdgcn_s_waitcnt(0x0F70);
        __syncthreads();
        typedef const __attribute__((address_space(3))) bf16x8_t* fptr;
        bf16x8_t qf[4];
        { const int R = nt * 32 + r32, sw = (R >> 1) & 7;
#pragma unroll
            for (int ks = 0; ks < 4; ++ks) qf[ks] = *(fptr)(lds + buf + R * 128 + (((ks * 2 + hi) ^ sw) * 16)); }
        f32x16 of, ob;
#pragma unroll
        for (int r = 0; r < 16; ++r) { of[r] = 0.f; ob[r] = 0.f; }
#pragma unroll
        for (int ks = 0; ks < 4; ++ks) {
            of = __builtin_amdgcn_mfma_f32_32x32x16_bf16(qf[ks], sfr[ks], of, 0, 0, 0);
            ob = __builtin_amdgcn_mfma_f32_32x32x16_bf16(qf[ks], sbr[ks], ob, 0, 0, 0);
        }
        asm volatile("" : "+v"(of), "+v"(ob));
        __builtin_amdgcn_sched_barrier(0);
        { const int itn = it + (int)gridDim.x < nitems ? it + (int)gridDim.x : it;
          RD_STATE(itn); RD_ISSUE(itn, RB - buf); }
        __builtin_amdgcn_sched_barrier(0);
        f32x16 o;
#pragma unroll
        for (int r = 0; r < 16; ++r) o[r] = 0.f;
        const int n_l = nt * 32 + r32;
        const int Rv = vt * 32 + r32, swv = Rv & 15;
#pragma unroll 1
        for (int mt = 0; mt < 4; ++mt) {
            f32x16 x;
#pragma unroll
            for (int r = 0; r < 16; ++r) x[r] = 0.f;
            const int Rk = mt * 32 + r32, swk = (Rk >> 1) & 7;
#pragma unroll
            for (int ks = 0; ks < 4; ++ks) { const bf16x8_t kf = *(fptr)(lds + buf + KOFF + Rk * 128 + (((ks * 2 + hi) ^ swk) * 16)); x = __builtin_amdgcn_mfma_f32_32x32x16_bf16(kf, qf[ks], x, 0, 0, 0); }
#pragma unroll
            for (int r = 0; r < 16; ++r) { const int m = mt * 32 + crow16(r, hi), df = n_l - m;
                x[r] *= 0.125f * __builtin_amdgcn_exp2f(df >= 0 ? lgf * (float)df : lgb * (float)(-df)); }
#pragma unroll
            for (int sp = 0; sp < 2; ++sp) { u32x4 w; w.x = pk2(x[8 * sp], x[8 * sp + 1]); w.y = pk2(x[8 * sp + 2], x[8 * sp + 3]); w.z = pk2(x[8 * sp + 4], x[8 * sp + 5]); w.w = pk2(x[8 * sp + 6], x[8 * sp + 7]);
                const bf16x8_t vf = *(fptr)(lds + buf + VOFF + Rv * 256 + ((((mt * 2 + sp) * 2 + hi) ^ swv) * 16));
                o = __builtin_amdgcn_mfma_f32_32x32x16_bf16(__builtin_bit_cast(bf16x8_t, w), vf, o, 0, 0, 0); }
        }
        asm volatile("s_waitcnt lgkmcnt(0)\n\ts_barrier" ::: "memory");
        __attribute__((address_space(3))) float* OT = (__attribute__((address_space(3))) float*)(lds + buf);
#pragma unroll
        for (int r = 0; r < 16; ++r) { const int n = nt * 32 + crow16(r, hi);
            OT[n * 64 + vt * 32 + r32] = o[r] + __builtin_amdgcn_exp2f(lgf * (float)(n + 1)) * of[r] + __builtin_amdgcn_exp2f(lgb * (float)(128 - n)) * ob[r]; }
        asm volatile("s_waitcnt lgkmcnt(0)\n\ts_barrier" ::: "memory");
        { const int n = tid >> 2, v0 = (tid & 3) * 16; float ov[16]; float ss = 0.f;
#pragma unroll
            for (int j4 = 0; j4 < 4; ++j4) { const f32x4 x = *(const __attribute__((address_space(3))) f32x4*)(OT + n * 64 + v0 + j4 * 4); ov[j4 * 4] = x.x; ov[j4 * 4 + 1] = x.y; ov[j4 * 4 + 2] = x.z; ov[j4 * 4 + 3] = x.w; ss += (x.x * x.x + x.y * x.y) + (x.z * x.z + x.w * x.w); }
            ss = row_sum4(ss);
            const float rstd = __builtin_amdgcn_rsqf(ss * (1.f / 64.f) + EPS);
            const size_t row = (size_t)(row0 + n); const __attribute__((address_space(3))) float* ng = NG + v0;
            bf16_t* mp = MIX + row * D + 512 + h * 64 + v0;
            const u32x4 gq0 = *(const __attribute__((address_space(3))) u32x4*)(lds + buf + GOFF + n * 128 + v0 * 2), gq1 = *(const __attribute__((address_space(3))) u32x4*)(lds + buf + GOFF + n * 128 + v0 * 2 + 16);
#pragma unroll
            for (int j4 = 0; j4 < 4; ++j4) { const unsigned g0 = (j4 < 2 ? gq0 : gq1)[(j4 & 1) * 2], g1 = (j4 < 2 ? gq0 : gq1)[(j4 & 1) * 2 + 1]; const float g[4] = {bf2f(g0 & 0xffffu), bf2f(g0 >> 16), bf2f(g1 & 0xffffu), bf2f(g1 >> 16)}; float y[4];
#pragma unroll
                for (int j = 0; j < 4; ++j) y[j] = ov[j4 * 4 + j] * rstd * ng[j4 * 4 + j] * fsiluf(g[j]);
                st4bf(mp + j4 * 4, y); } }
    }
    asm volatile("s_waitcnt vmcnt(0)" ::: "memory");
    __syncthreads();
#undef RD_ISSUE
#undef RD_STATE
}
DEV void p4_ret_scan(const Args& a, int l) {
    const float* RS = (const float*)(a.ws + WS_RETS); bf16_t* RSB = (bf16_t*)(a.ws + WS_XN);
    for (int it = blockIdx.x; it < 512; it += gridDim.x) {
        const int gid = it * NTHREADS + ltid(), elem = gid & 4095, dir = (gid >> 12) & 1, bh = gid >> 13, h = bh & 3;
        const float gC = expf(a.in[14][l * 8 + dir * 4 + h] * 128.f);
        const float* p = RS + ((size_t)bh * RET_CH * 2 + dir) * 4096 + elem;
        bf16_t* q = RSB + ((size_t)bh * RET_CH * 2 + dir) * 4096 + elem;
        float u[RET_CH];
#pragma unroll
        for (int c = 0; c < RET_CH; ++c) u[c] = p[(size_t)c * 8192];
        float st = 0.f;
        if (dir == 0) {
#pragma unroll
            for (int c = 0; c < RET_CH; ++c) { q[(size_t)c * 8192] = (bf16_t)f2bf(st); st = gC * st + u[c]; } }
        else {
#pragma unroll
            for (int c = 1; c >= 0; --c) { q[(size_t)c * 8192] = (bf16_t)f2bf(st); st = gC * st + u[c]; }
#pragma unroll
            for (int c = RET_CH - 1; c >= 2; --c) { q[(size_t)c * 8192] = (bf16_t)f2bf(st); st = gC * st + u[c]; }
        }
    }
}
DEV void p5_ret_out(const Args& a, int l, float* lds) {
    const int tid = ltid();
    bf16_t* Qs = (bf16_t*)lds; bf16_t* Ks = Qs + 128 * 64; bf16_t* Vs = Ks + 128 * 64; float* S = lds + (3 * 128 * 64) / 2;
    const bf16_t* Y = (const bf16_t*)(a.ws + WS_Y); const float* RS = (const float*)(a.ws + WS_RETS); bf16_t* MIX = (bf16_t*)(a.ws + WS_MIX);
    const int c_lo = l == 0 ? 0 : 2, ncs = RET_CH - c_lo;
    for (int it = blockIdx.x; it < NB * 4 * ncs; it += gridDim.x) {
        const int c = c_lo + it % ncs, bh = it / ncs, h = bh & 3, b = bh >> 2, row0 = ret_row0(b, c);
        for (int i = tid; i < 128 * 16; i += NTHREADS) { const int m = i >> 4, q4 = (i & 15) * 4; const size_t go = (size_t)(row0 + m) * 256 + h * 64 + q4;
            *(u32x2*)(Qs + m * 64 + q4) = *(const u32x2*)(Y + 6 * YARR + go); *(u32x2*)(Ks + m * 64 + q4) = *(const u32x2*)(Y + 7 * YARR + go); *(u32x2*)(Vs + m * 64 + q4) = *(const u32x2*)(Y + 8 * YARR + go); }
        __syncthreads();
        const float lgf = a.in[14][l * 8 + h], lgb = a.in[14][l * 8 + 4 + h];
        { const int n0 = (tid >> 4) * 4, m0 = (tid & 15) * 8; float s[4][8];
#pragma unroll
            for (int i = 0; i < 4; ++i)
#pragma unroll
                for (int j = 0; j < 8; ++j) s[i][j] = 0.f;
            for (int d = 0; d < 64; ++d) { float q[4], k[8];
#pragma unroll
                for (int i = 0; i < 4; ++i) q[i] = bf2f(Qs[(n0 + i) * 64 + d]);
#pragma unroll
                for (int j = 0; j < 8; ++j) k[j] = bf2f(Ks[(m0 + j) * 64 + d]);
#pragma unroll
                for (int i = 0; i < 4; ++i)
#pragma unroll
                    for (int j = 0; j < 8; ++j) s[i][j] += q[i] * k[j]; }
#pragma unroll
            for (int i = 0; i < 4; ++i)
#pragma unroll
                for (int j = 0; j < 8; ++j) { const int n = n0 + i, m = m0 + j; const float dec = n >= m ? expf(lgf * (float)(n - m)) : expf(lgb * (float)(m - n)); S[n * 129 + m] = s[i][j] * 0.125f * dec; } }
        __syncthreads();
        { const int n = tid >> 2, v0 = (tid & 3) * 16; float o[16];
#pragma unroll
            for (int j = 0; j < 16; ++j) o[j] = 0.f;
            for (int m = 0; m < 128; ++m) { const float sv = S[n * 129 + m];
#pragma unroll
                for (int j = 0; j < 16; ++j) o[j] += sv * bf2f(Vs[m * 64 + v0 + j]); }
            const float cf = expf(lgf * (float)(n + 1)), cb = expf(lgb * (float)(128 - n));
            const float* Sf = RS + ((size_t)(bh * RET_CH + c) * 2) * 4096 + v0; const float* Sb = Sf + 4096;
            for (int d = 0; d < 64; ++d) { const float qv = bf2f(Qs[n * 64 + d]), qf = qv * cf, qb = qv * cb;
#pragma unroll
                for (int j4 = 0; j4 < 4; ++j4) { const f32x4 x = *(const f32x4*)(Sf + d * 64 + j4 * 4), y = *(const f32x4*)(Sb + d * 64 + j4 * 4);
                    o[j4 * 4] += qf * x.x + qb * y.x; o[j4 * 4 + 1] += qf * x.y + qb * y.y; o[j4 * 4 + 2] += qf * x.z + qb * y.z; o[j4 * 4 + 3] += qf * x.w + qb * y.w; } }
            float ss = 0.f;
#pragma unroll
            for (int j = 0; j < 16; ++j) ss += o[j] * o[j];
            ss = row_sum4(ss);
            const float rstd = 1.0f / sqrtf(ss * (1.f / 64.f) + EPS);
            const int row = row0 + n; const bf16_t* gp = Y + 9 * YARR + (size_t)row * 256 + h * 64 + v0; const float* ng = a.in[15] + l * 64 + v0;
            bf16_t* mp = MIX + (size_t)row * D + 512 + h * 64 + v0;
#pragma unroll
            for (int j4 = 0; j4 < 4; ++j4) { float g[4]; ld4bf(gp + j4 * 4, g); float y[4];
#pragma unroll
                for (int j = 0; j < 4; ++j) y[j] = o[j4 * 4 + j] * rstd * ng[j4 * 4 + j] * siluf(g[j]);
                st4bf(mp + j4 * 4, y); } }
        __syncthreads();
    }
}

DEV float att_lambda(const Args& a, int l) {
    const float* lp = a.in[12] + l * 256; float s1 = 0.f, s2 = 0.f;
    for (int i = 0; i < 64; ++i) { s1 += lp[i] * lp[64 + i]; s2 += lp[128 + i] * lp[192 + i]; }
    return expf(s1) - expf(s2) + lam_init(l);
}
DEV float att_bound2(const Args& a, int l) {
    float mq = 0.f, mk = 0.f;
    for (int i = 0; i < 64; ++i) { mq = fmaxf(mq, fabsf(a.in[10][l * 64 + i])); mk = fmaxf(mk, fabsf(a.in[11][l * 64 + i])); }
    return 8.f * 1.4426950408889634f * mq * mk * 1.01f;
}

DEV void attn_simple_item(const Args& a, int l, int b, int h, int qblk, bool ctx, float lam, float bound2, float* lds) {
    const int tid = ltid(), q = tid & 63, part = tid >> 6, map = part >> 2, vq = part & 3;
    float* Ks = lds; float* Vs = lds + 64 * 128; float* red = lds + 2 * 64 * 128;
    const bf16_t* Y = (const bf16_t*)(a.ws + WS_Y); bf16_t* MIX = (bf16_t*)(a.ws + WS_MIX);
    const int qrow = (ctx ? ML + b * 256 : b * 4096) + qblk * 64 + q;
    const int arrh = h >> 1, colh = (h & 1) * 128;
    float qv[64];
    { const bf16_t* qp = Y + (size_t)arrh * YARR + (size_t)qrow * 256 + colh + map * 64;
#pragma unroll
        for (int d4 = 0; d4 < 16; ++d4) ld4bf(qp + d4 * 4, qv + d4 * 4); }
    float o[32], lsum = 0.f;
#pragma unroll
    for (int j = 0; j < 32; ++j) o[j] = 0.f;
    const int ntiles = ctx ? 4 : 68;
    for (int tj = 0; tj < ntiles; ++tj) {
        const int krow0 = tj < 4 ? ML + b * 256 + tj * 64 : b * 4096 + (tj - 4) * 64;
        for (int i = tid; i < 64 * 32; i += NTHREADS) { const int kr = i >> 5, c4 = (i & 31) * 4; const size_t go = (size_t)(krow0 + kr) * 256 + colh + c4;
            ld4bf(Y + (size_t)(2 + arrh) * YARR + go, Ks + kr * 128 + c4); ld4bf(Y + (size_t)(4 + arrh) * YARR + go, Vs + kr * 128 + c4); }
        __syncthreads();
        for (int kr = 0; kr < 64; ++kr) {
            const float* kp = Ks + kr * 128 + map * 64; float s = 0.f;
#pragma unroll
            for (int d4 = 0; d4 < 16; ++d4) { const f32x4 kk = *(const f32x4*)(kp + d4 * 4); s += qv[d4 * 4] * kk.x + qv[d4 * 4 + 1] * kk.y + qv[d4 * 4 + 2] * kk.z + qv[d4 * 4 + 3] * kk.w; }
            const float p = exp2f(s - bound2); lsum += p;
            const float* vp = Vs + kr * 128 + vq * 32;
#pragma unroll
            for (int j4 = 0; j4 < 8; ++j4) { const f32x4 vv = *(const f32x4*)(vp + j4 * 4); o[j4 * 4] += p * vv.x; o[j4 * 4 + 1] += p * vv.y; o[j4 * 4 + 2] += p * vv.z; o[j4 * 4 + 3] += p * vv.w; }
        }
        __syncthreads();
    }
    float* Ob = Ks;
    const float il = 1.f / lsum;
    if (map == 0) {
#pragma unroll
        for (int j = 0; j < 32; ++j) Ob[q * 128 + vq * 32 + j] = o[j] * il; }
    __syncthreads();
    if (map == 1) {
#pragma unroll
        for (int j = 0; j < 32; ++j) Ob[q * 128 + vq * 32 + j] -= lam * o[j] * il; }
    __syncthreads();
    float ss = 0.f;
#pragma unroll
    for (int j = 0; j < 16; ++j) { const float x = Ob[q * 128 + part * 16 + j]; ss += x * x; }
    red[q * 8 + part] = ss;
    __syncthreads();
    float tot = 0.f;
#pragma unroll
    for (int p8 = 0; p8 < 8; ++p8) tot += red[q * 8 + p8];
    const float rstd = 1.0f / sqrtf(tot * (1.f / 128.f) + EPS), sc = rstd * (1.f - lam_init(l));
    const float* sg = a.in[13] + l * 128 + part * 16; bf16_t* mp = MIX + (size_t)qrow * D + h * 128 + part * 16;
#pragma unroll
    for (int j4 = 0; j4 < 4; ++j4) { float y[4];
#pragma unroll
        for (int j = 0; j < 4; ++j) y[j] = Ob[q * 128 + part * 16 + j4 * 4 + j] * sc * sg[j4 * 4 + j];
        st4bf(mp + j4 * 4, y); }
    __syncthreads();
}

constexpr int ATT_KROW = 128, ATT_KMAP = 64 * ATT_KROW, ATT_VOFF = 2 * ATT_KMAP, ATT_BUF = ATT_VOFF + 128 * ATT_KROW;
constexpr int ATT_EX = 0, ATT_LW = 2 * ATT_BUF, ATT_STG = ATT_LW + 1024, ATT_STGROW = 272;
DEV void p3_vt(const Args& a, float* ldsf) {
    const int tid = ltid();
    bf16_t* Ls = (bf16_t*)ldsf;
    const bf16_t* Y = (const bf16_t*)(a.ws + WS_Y); bf16_t* VT = (bf16_t*)(a.ws + WS_VT);
    u32x4 pre[2];
#define VT_FETCH(itx) do { const int t_ = (itx) % 68, bh_ = (itx) / 68, h_ = bh_ & 3, b_ = bh_ >> 2, kr0_ = t_ < 4 ? ML + b_ * 256 + t_ * 64 : b_ * 4096 + (t_ - 4) * 64; \
        _Pragma("unroll") for (int q = 0; q < 2; ++q) { const int i = tid + q * NTHREADS, kr = i >> 4, c8 = (i & 15) * 8; \
            pre[q] = *(const u32x4*)(Y + (size_t)(4 + (h_ >> 1)) * YARR + (size_t)(kr0_ + kr) * 256 + (h_ & 1) * 128 + c8); } } while (0)
    if ((int)blockIdx.x < NB * 4 * 68) VT_FETCH(blockIdx.x);
    for (int it = blockIdx.x; it < NB * 4 * 68; it += gridDim.x) {
        const int t = it % 68, bh = it / 68;
#pragma unroll
        for (int q = 0; q < 2; ++q) { const int i = tid + q * NTHREADS, kr = i >> 4, c8 = (i & 15) * 8; *(u32x4*)(Ls + kr * 136 + c8) = pre[q]; }
        __syncthreads();
        if (it + (int)gridDim.x < NB * 4 * 68) VT_FETCH(it + gridDim.x);
        { const int d = tid >> 2, g = tid & 3; unsigned w[8];
#pragma unroll
            for (int p2 = 0; p2 < 8; ++p2) { const int p = 2 * p2, kv0 = 8 * ((p & 7) >> 2) + 4 * (p >> 3) + (p & 3);
                w[p2] = (unsigned)Ls[(g * 16 + kv0) * 136 + d] | ((unsigned)Ls[(g * 16 + kv0 + 1) * 136 + d] << 16); }
            bf16_t* dst = VT + ((size_t)bh * 128 + d) * 4352 + t * 64 + g * 16;
            *(u32x4*)dst = (u32x4){w[0], w[1], w[2], w[3]}; *(u32x4*)(dst + 8) = (u32x4){w[4], w[5], w[6], w[7]}; }
        __syncthreads();
    }
#undef VT_FETCH
}
DEV void attn_unit(const Args& a, int l, int b, int h, int qb, bool ctx, float lam, float bound2, unsigned char* lds) {
    const int tid = ltid(), lane = tid & 63, wave = __builtin_amdgcn_readfirstlane(tid >> 6), r32 = lane & 31, hi = lane >> 5, qg = wave & 3, map = wave >> 2;
    const bf16_t* Y = (const bf16_t*)(a.ws + WS_Y); const bf16_t* VT = (const bf16_t*)(a.ws + WS_VT); bf16_t* MIX = (bf16_t*)(a.ws + WS_MIX);
    const int NT = ctx ? 4 : 68;
    const int qrow0 = (ctx ? ML + b * 256 : b * 4096) + qb * 128 + qg * 32;
    bf16x8_t qf[4];
    { const bf16_t* qp = Y + (size_t)(h >> 1) * YARR + (size_t)(qrow0 + r32) * 256 + (h & 1) * 128 + map * 64 + 8 * hi;
#pragma unroll
        for (int s = 0; s < 4; ++s) qf[s] = *(const bf16x8_t*)(qp + 16 * s); }
    const bf16_t* Kg = Y + (size_t)(2 + (h >> 1)) * YARR + (h & 1) * 128;
    const bf16_t* Vg = VT + (size_t)(b * 4 + h) * 128 * 4352;
    typedef __attribute__((address_space(3))) unsigned char* lptr;
    lptr ldsl = (lptr)lds;
    int dgo[4];
#pragma unroll
    for (int i = 0; i < 4; ++i) { const int P = (wave * 4 + i) * 64 + lane;
        if (wave < 4) { const int m = P >> 9, row = (P >> 3) & 63, c = (P & 7) ^ ((row >> 1) & 7); dgo[i] = row * 256 + m * 64 + c * 8; }
        else { const int P2 = P - 1024, d = P2 >> 3, c = (P2 & 7) ^ ((d >> 1) & 7); dgo[i] = d * 4352 + c * 8; } }
#define ATT_DMA(t, bufb) do { const int t_ = (t); const bf16_t* src_ = wave < 4 ? Kg + (size_t)(t_ < 4 ? ML + b * 256 + t_ * 64 : b * 4096 + (t_ - 4) * 64) * 256 : Vg + t_ * 64; \
        _Pragma("unroll") for (int i = 0; i < 4; ++i) __builtin_amdgcn_global_load_lds((const unsigned*)(src_ + dgo[i]), (__attribute__((address_space(3))) unsigned*)(ldsl + (bufb) + (wave * 4 + i) * 1024), 16, 0, 0); } while (0)
    f32x16 o[4];
#pragma unroll
    for (int dt = 0; dt < 4; ++dt)
#pragma unroll
        for (int r = 0; r < 16; ++r) o[dt][r] = 0.f;
    float lsum = 0.f;
    ATT_DMA(0, 0);
    __builtin_amdgcn_s_waitcnt(0x0F70);
    __syncthreads();
    const int sw = (r32 >> 1) & 7;
    int coff[4];
#pragma unroll
    for (int ks = 0; ks < 4; ++ks) coff[ks] = ((2 * ks + hi) ^ sw) * 16;
    const int kfo = map * ATT_KMAP + r32 * ATT_KROW, vfo = ATT_VOFF + r32 * ATT_KROW;
    typedef const __attribute__((address_space(3))) bf16x8_t* fptr;
    for (int t = 0; t < NT; ++t) {
        const int buf = (t & 1) * ATT_BUF;
        if (t + 1 < NT) ATT_DMA(t + 1, ATT_BUF - buf);
        bf16x8_t pf[4];
#pragma unroll
        for (int kt = 0; kt < 2; ++kt) {
            f32x16 s;
#pragma unroll
            for (int r = 0; r < 16; ++r) s[r] = -bound2;
#pragma unroll
            for (int ks = 0; ks < 4; ++ks) { const bf16x8_t kf = *(fptr)(ldsl + buf + kfo + kt * 32 * ATT_KROW + coff[ks]); s = __builtin_amdgcn_mfma_f32_32x32x16_bf16(kf, qf[ks], s, 0, 0, 0); }
#pragma unroll
            for (int r = 0; r < 16; ++r) { s[r] = __builtin_amdgcn_exp2f(s[r]); lsum += s[r]; }
#pragma unroll
            for (int sp = 0; sp < 2; ++sp) { u32x4 w; w.x = pk2(s[8 * sp], s[8 * sp + 1]); w.y = pk2(s[8 * sp + 2], s[8 * sp + 3]); w.z = pk2(s[8 * sp + 4], s[8 * sp + 5]); w.w = pk2(s[8 * sp + 6], s[8 * sp + 7]);
                pf[2 * kt + sp] = __builtin_bit_cast(bf16x8_t, w); }
        }
#pragma unroll
        for (int dt = 0; dt < 4; ++dt)
#pragma unroll
            for (int g = 0; g < 4; ++g) { const bf16x8_t vf = *(fptr)(ldsl + buf + vfo + dt * 32 * ATT_KROW + coff[g]); o[dt] = __builtin_amdgcn_mfma_f32_32x32x16_bf16(pf[g], vf, o[dt], 0, 0, 0); }
        __builtin_amdgcn_s_waitcnt(0x0F70);
        __syncthreads();
    }
#undef ATT_DMA
    lsum = swap32_sum(lsum, lsum);
    float* LW = (float*)(lds + ATT_LW) + wave * 32;
    if (hi == 0) LW[r32] = lsum;
    float* EX = (float*)(lds + ATT_EX);
    asm volatile("s_waitcnt lgkmcnt(0)" ::: "memory");
    float il[16];
#pragma unroll
    for (int r = 0; r < 16; ++r) il[r] = 1.f / LW[crow16(r, hi)];
    if (map == 1) {
#pragma unroll
        for (int dt = 0; dt < 4; ++dt)
#pragma unroll
            for (int r = 0; r < 16; ++r) EX[(qg * 32 + crow16(r, hi)) * 128 + dt * 32 + r32] = o[dt][r] * il[r] * lam;
    }
    __syncthreads();
    if (map == 0) {
        float ss[16];
#pragma unroll
        for (int r = 0; r < 16; ++r) ss[r] = 0.f;
#pragma unroll
        for (int dt = 0; dt < 4; ++dt)
#pragma unroll
            for (int r = 0; r < 16; ++r) { const float v = o[dt][r] * il[r] - EX[(qg * 32 + crow16(r, hi)) * 128 + dt * 32 + r32]; o[dt][r] = v; ss[r] += v * v; }
#pragma unroll
        for (int r = 0; r < 16; ++r) { float x = row_sum16(ss[r]); x = swap16_sum(x, x);
            ss[r] = (1.f - lam_init(l)) / sqrtf(x * (1.f / 128.f) + EPS); }
        bf16_t* stg = (bf16_t*)(lds + ATT_STG + qg * 32 * ATT_STGROW);
#pragma unroll
        for (int dt = 0; dt < 4; ++dt) { const float sg = a.in[13][l * 128 + dt * 32 + r32];
#pragma unroll
            for (int r = 0; r < 16; ++r) stg[crow16(r, hi) * (ATT_STGROW / 2) + dt * 32 + r32] = (bf16_t)f2bf(o[dt][r] * ss[r] * sg); }
        asm volatile("s_waitcnt lgkmcnt(0)" ::: "memory");
#pragma unroll
        for (int i = 0; i < 8; ++i) { const int id = lane + 64 * i, row = id >> 4, c = id & 15;
            *(u32x4*)(MIX + (size_t)(qrow0 + row) * D + h * 128 + c * 8) = *(const u32x4*)((const unsigned char*)stg + row * ATT_STGROW + c * 16); }
    }
    __syncthreads();
}
constexpr int AT2_LW = 2 * ATT_BUF, AT2_STG = AT2_LW + 2048;
template <bool SHIFT> DEV void attn_unit2(const Args& a, int l, int b, int h, int qb, bool ctx, float lam, float bound2, float oml, unsigned char* lds) {
    const int tid = ltid(), lane = tid & 63, wave = __builtin_amdgcn_readfirstlane(tid >> 6), r32 = lane & 31, hi = lane >> 5;
    const bf16_t* Y = (const bf16_t*)(a.ws + WS_Y); const bf16_t* VT = (const bf16_t*)(a.ws + WS_VT); bf16_t* MIX = (bf16_t*)(a.ws + WS_MIX);
    const int NT = ctx ? 4 : 68;
    const float shift = bound2 > 96.f ? bound2 - 96.f : 0.f;
    const int qrow0 = (ctx ? ML + b * 256 : b * 4096) + qb * 256 + wave * 32;
    bf16x8_t qf[2][4];
    { const bf16_t* qp = Y + (size_t)(h >> 1) * YARR + (size_t)(qrow0 + r32) * 256 + (h & 1) * 128 + 8 * hi;
#pragma unroll
        for (int m = 0; m < 2; ++m)
#pragma unroll
            for (int s = 0; s < 4; ++s) qf[m][s] = *(const bf16x8_t*)(qp + m * 64 + 16 * s); }
    const bf16_t* Kg = Y + (size_t)(2 + (h >> 1)) * YARR + (h & 1) * 128;
    const bf16_t* Vg = VT + (size_t)(b * 4 + h) * 128 * 4352;
    typedef __attribute__((address_space(3))) unsigned char* lptr;
    lptr ldsl = (lptr)lds;
#define ATT_DMA(t, bufb) do { const int t_ = (t); const int ln_ = ltid() & 63; const bool isk_ = wave < 4; \
        const bf16_t* src_ = isk_ ? Kg + (size_t)(t_ < 4 ? ML + b * 256 + t_ * 64 : b * 4096 + (t_ - 4) * 64) * 256 + (wave >> 1) * 64 + (wave & 1) * 32 * 256 : Vg + t_ * 64 + (size_t)(wave - 4) * 32 * 4352; \
        const int st_ = isk_ ? 256 : 4352, ca_ = (ln_ & 7) ^ (ln_ >> 4), g0_ = (ln_ >> 3) * st_ + ca_ * 8, g1_ = (ln_ >> 3) * st_ + (ca_ ^ 4) * 8; \
        _Pragma("unroll") for (int i = 0; i < 4; ++i) \
            __builtin_amdgcn_global_load_lds((const unsigned*)(src_ + (size_t)(i * 8 * st_) + ((i & 1) ? g1_ : g0_)), (__attribute__((address_space(3))) unsigned*)(ldsl + (bufb) + (wave * 4 + i) * 1024), 16, 0, 0); } while (0)
    f32x16 o0[4], o1[4];
#pragma unroll
    for (int dt = 0; dt < 4; ++dt)
#pragma unroll
        for (int r = 0; r < 16; ++r) { o0[dt][r] = 0.f; o1[dt][r] = 0.f; }
    float lsum0 = 0.f, lsum1 = 0.f;
    ATT_DMA(0, 0);
    __builtin_amdgcn_s_waitcnt(0x0F70);
    __syncthreads();
    typedef const __attribute__((address_space(3))) bf16x8_t* fptr;
#pragma unroll 1
    for (int t = 0; t < NT; ++t) {
        const int buf = (t & 1) * ATT_BUF;
        if (t + 1 < NT) ATT_DMA(t + 1, ATT_BUF - buf);
        const int ln = ltid() & 63;
        const int r32l = ln & 31, hil = ln >> 5, sw = (r32l >> 1) & 7, kfo = r32l * ATT_KROW, vfo = ATT_VOFF + r32l * ATT_KROW;
        int coff[4];
#pragma unroll
        for (int ks = 0; ks < 4; ++ks) coff[ks] = ((2 * ks + hil) ^ sw) * 16;
#pragma unroll
        for (int kt = 0; kt < 2; ++kt) {
            bf16x8_t pf0[2], pf1[2];
#pragma unroll
            for (int m = 0; m < 2; ++m) {
                f32x16 s;
#pragma unroll
                for (int r = 0; r < 16; ++r) s[r] = 0.f;
#pragma unroll
                for (int ks = 0; ks < 4; ++ks) { const bf16x8_t kf = *(fptr)(ldsl + buf + m * ATT_KMAP + kfo + kt * 32 * ATT_KROW + coff[ks]); s = __builtin_amdgcn_mfma_f32_32x32x16_bf16(kf, qf[m][ks], s, 0, 0, 0); }
                if (SHIFT) {
#pragma unroll
                    for (int r = 0; r < 16; ++r) s[r] -= shift; }
                float ls = 0.f;
#pragma unroll
                for (int r = 0; r < 16; ++r) { s[r] = __builtin_amdgcn_exp2f(s[r]); ls += s[r]; }
                if (m == 0) lsum0 += ls; else lsum1 += ls;
#pragma unroll
                for (int sp = 0; sp < 2; ++sp) { u32x4 w; w.x = pk2(s[8 * sp], s[8 * sp + 1]); w.y = pk2(s[8 * sp + 2], s[8 * sp + 3]); w.z = pk2(s[8 * sp + 4], s[8 * sp + 5]); w.w = pk2(s[8 * sp + 6], s[8 * sp + 7]);
                    if (m == 0) pf0[sp] = __builtin_bit_cast(bf16x8_t, w); else pf1[sp] = __builtin_bit_cast(bf16x8_t, w); }
            }
#pragma unroll
            for (int dt = 0; dt < 4; ++dt)
#pragma unroll
                for (int sp = 0; sp < 2; ++sp) { const bf16x8_t vf = *(fptr)(ldsl + buf + vfo + dt * 32 * ATT_KROW + coff[2 * kt + sp]);
                    o0[dt] = __builtin_amdgcn_mfma_f32_32x32x16_bf16(pf0[sp], vf, o0[dt], 0, 0, 0); o1[dt] = __builtin_amdgcn_mfma_f32_32x32x16_bf16(pf1[sp], vf, o1[dt], 0, 0, 0); }
        }
        __builtin_amdgcn_s_waitcnt(0x0F70);
        __syncthreads();
    }
#undef ATT_DMA
    lsum0 = swap32_sum(lsum0, lsum0); lsum1 = swap32_sum(lsum1, lsum1);
    const int lane_e = ltid() & 63, r32e = lane_e & 31, hie = lane_e >> 5;
    float* LW = (float*)(lds + AT2_LW) + wave * 64;
    if (hie == 0) { LW[r32e] = lsum0; LW[32 + r32e] = lsum1; }
    asm volatile("s_waitcnt lgkmcnt(0)" ::: "memory");
    float ss[16];
#pragma unroll
    for (int r = 0; r < 16; ++r) { const float il0 = 1.f / LW[crow16(r, hie)], il1 = lam / LW[32 + crow16(r, hie)]; float acc = 0.f;
#pragma unroll
        for (int dt = 0; dt < 4; ++dt) { const float v = o0[dt][r] * il0 - o1[dt][r] * il1; o0[dt][r] = v; acc += v * v; }
        ss[r] = acc; }
#pragma unroll
    for (int r = 0; r < 16; ++r) { float x = row_sum16(ss[r]); x = swap16_sum(x, x);
        ss[r] = oml / sqrtf(x * (1.f / 128.f) + EPS); }
    bf16_t* stg = (bf16_t*)(lds + AT2_STG + wave * 32 * ATT_STGROW);
#pragma unroll
    for (int dt = 0; dt < 4; ++dt) { const float sg = a.in[13][l * 128 + dt * 32 + r32e];
#pragma unroll
        for (int r = 0; r < 16; ++r) stg[crow16(r, hie) * (ATT_STGROW / 2) + dt * 32 + r32e] = (bf16_t)f2bf(o0[dt][r] * ss[r] * sg); }
    asm volatile("s_waitcnt lgkmcnt(0)" ::: "memory");
    const int lane_s = ltid() & 63;
#pragma unroll
    for (int i = 0; i < 8; ++i) { const int id = lane_s + 64 * i, row = id >> 4, c = id & 15;
        *(u32x4*)((bf16_t*)(a.ws + WS_MIX) + (size_t)((ctx ? ML + b * 256 : b * 4096) + qb * 256 + wave * 32 + row) * D + h * 128 + c * 8) = *(const u32x4*)((const unsigned char*)stg + row * ATT_STGROW + c * 16); }
    __syncthreads();
}
DEV void p4_attn_mfma(const Args& a, int l, unsigned char* lds) {
    const float lam = __uint_as_float(__builtin_amdgcn_readfirstlane(__float_as_uint(att_lambda(a, l)))), bound2 = __uint_as_float(__builtin_amdgcn_readfirstlane(__float_as_uint(att_bound2(a, l))));
    const float oml = __uint_as_float(__builtin_amdgcn_readfirstlane(__float_as_uint(1.f - lam_init(l))));
    const int nlat = NB * 4 * 16, nctx = l == 0 ? NB * 4 : 0;
    for (int it = blockIdx.x; it < nlat + nctx; it += gridDim.x) {
        const bool ctx = it >= nlat; const int i2 = it - nlat;
        const int qb = ctx ? 0 : (it & 15), h = ctx ? (i2 & 3) : ((it >> 4) & 3), b = ctx ? (i2 >> 2) : (it >> 6);
        if (bound2 > 96.f) attn_unit2<true>(a, l, b, h, qb, ctx, lam, bound2, oml, lds); else attn_unit2<false>(a, l, b, h, qb, ctx, lam, bound2, oml, lds);
    }
}
DEV void p4_attn_simple(const Args& a, int l, float* lds) {
    const float lam = att_lambda(a, l), bound2 = att_bound2(a, l);
    const int nlat = NB * 4 * 64, nctx = l == 0 ? NB * 4 * 4 : 0;
    for (int it = blockIdx.x; it < nlat + nctx; it += gridDim.x) {
        if (it < nlat) { const int qb = it & 63, h = (it >> 6) & 3, b = it >> 8; attn_simple_item(a, l, b, h, qb, false, lam, bound2, lds); }
        else { const int i2 = it - nlat, qb = i2 & 3, h = (i2 >> 2) & 3, b = i2 >> 4; attn_simple_item(a, l, b, h, qb, true, lam, bound2, lds); }
    }
}

template <int R, bool LAT> DEV void p7_rows(const Args& a, int l, const float* RW, int row_lo, int ngroups, int lane, int gw, int NGW) {
    unsigned char* XN8 = a.ws + WS_XN; bf16_t* XN = (bf16_t*)(a.ws + WS_XN); float* PL = (float*)(a.ws + WS_PROBL); float* PC = (float*)(a.ws + WS_PROBC);
    const int b3 = (lane >> 3) & 1, b2 = (lane >> 2) & 1, my_e = (lane >> 5) * 8 + ((lane >> 4) & 1) * 4 + b3 * 2 + b2;
    constexpr bool lat = LAT;
    u32x2 pre[LAT ? R : 1][4]; f32x4 prf[LAT ? 1 : R][4];
#define P7_LOAD(gg) do { const int r0_ = row_lo + (gg) * R; \
        if constexpr (LAT) { _Pragma("unroll") for (int q = 0; q < R; ++q) { const bf16_t* s_ = resrow(a, r0_ + q); _Pragma("unroll") for (int j = 0; j < 4; ++j) pre[q][j] = *(const u32x2*)(s_ + 256 * j + 4 * lane); } } \
        else { _Pragma("unroll") for (int q = 0; q < R; ++q) { const float* s_ = (const float*)(a.ws + WS_XC) + (size_t)(r0_ + q - ML) * D; _Pragma("unroll") for (int j = 0; j < 4; ++j) prf[q][j] = *(const f32x4*)(s_ + 256 * j + 4 * lane); } } } while (0)
    if (gw < ngroups) P7_LOAD(gw);
    for (int g = gw; g < ngroups; g += NGW) {
        const int r0 = row_lo + g * R;
        f32x4 v[R][4];
#pragma unroll
        for (int q = 0; q < R; ++q)
#pragma unroll
            for (int j = 0; j < 4; ++j) { if constexpr (LAT) v[q][j] = (f32x4){bf2f(pre[q][j].x & 0xffffu), bf2f(pre[q][j].x >> 16), bf2f(pre[q][j].y & 0xffffu), bf2f(pre[q][j].y >> 16)}; else v[q][j] = prf[q][j]; }
        if (g + NGW < ngroups) P7_LOAD(g + NGW);
        float rstd[R];
#pragma unroll
        for (int q = 0; q < R; ++q) { float ss = 0.f;
#pragma unroll
            for (int j = 0; j < 4; ++j) ss += (v[q][j].x * v[q][j].x + v[q][j].y * v[q][j].y) + (v[q][j].z * v[q][j].z + v[q][j].w * v[q][j].w);
            rstd[q] = __builtin_amdgcn_rsqf(wave_sum(ss) * (1.f / D) + EPS); }
        const float* gp = a.in[7] + l * D; const float* sh = modp(a, l, modrow(r0), 3); const float* sc = modp(a, l, modrow(r0), 4);
#pragma unroll
        for (int j = 0; j < 4; ++j) {
            const int c0 = 256 * j + 4 * lane; const f32x4 gm = *(const f32x4*)(gp + c0) * (1.f + *(const f32x4*)(sc + c0)), s0 = *(const f32x4*)(sh + c0);
#pragma unroll
            for (int q = 0; q < R; ++q) { const f32x4 y = v[q][j] * rstd[q] * gm + s0;
                if (USE_FP8_MOE1) *(unsigned*)(XN8 + (size_t)(r0 + q) * D + c0) = pk_fp8x4(y.x, y.y, y.z, y.w); else { float t[4] = {y.x, y.y, y.z, y.w}; st4bf(XN + (size_t)(r0 + q) * D + c0, t); }
                v[q][j] = y; }
        }
        f32x2_t lg2[R][8];
#pragma unroll
        for (int q = 0; q < R; ++q)
#pragma unroll
            for (int e = 0; e < 8; ++e) lg2[q][e] = (f32x2_t){0.f, 0.f};
        { f32x4 wc[4], wn[4];
#pragma unroll
            for (int e4 = 0; e4 < 4; ++e4) wc[e4] = *(const f32x4*)(RW + ((e4 * 64 + lane) * 4));
#pragma unroll
            for (int k = 0; k < 16; ++k) { const int j = k >> 2, i = k & 3;
                if (k + 1 < 16) {
#pragma unroll
                    for (int e4 = 0; e4 < 4; ++e4) wn[e4] = *(const f32x4*)(RW + ((((k + 1) * 4 + e4) * 64 + lane) * 4)); }
#pragma unroll
                for (int e4 = 0; e4 < 4; ++e4)
#pragma unroll
                    for (int q = 0; q < R; ++q) { const float t = i == 0 ? v[q][j].x : i == 1 ? v[q][j].y : i == 2 ? v[q][j].z : v[q][j].w;
                        const f32x2_t t2 = {t, t};
                        lg2[q][e4 * 2] = __builtin_elementwise_fma(t2, (f32x2_t){wc[e4].x, wc[e4].y}, lg2[q][e4 * 2]); lg2[q][e4 * 2 + 1] = __builtin_elementwise_fma(t2, (f32x2_t){wc[e4].z, wc[e4].w}, lg2[q][e4 * 2 + 1]); }
                __builtin_amdgcn_sched_barrier(0);
#pragma unroll
                for (int e4 = 0; e4 < 4; ++e4) wc[e4] = wn[e4]; } }
        float a1 = 0.f;
#pragma unroll
        for (int q = 0; q < R; ++q) { float a8[8], a4[4], a2[2], t1;
#pragma unroll
            for (int i = 0; i < 8; ++i) a8[i] = swap32_sum(lg2[q][i >> 1][i & 1], lg2[q][4 + (i >> 1)][i & 1]);
#pragma unroll
            for (int i = 0; i < 4; ++i) a4[i] = swap16_sum(a8[i], a8[4 + i]);
#pragma unroll
            for (int i = 0; i < 2; ++i) { const float snd = b3 ? a4[i] : a4[2 + i], kp = b3 ? a4[2 + i] : a4[i]; a2[i] = kp + dppf<DPP_X8>(snd); }
            { const float snd = b2 ? a2[0] : a2[1], kp = b2 ? a2[1] : a2[0]; t1 = kp + dppf<DPP_X7>(snd); }
            t1 = row_sum4(t1);
            if (R == 1 || (lane & 3) == q) a1 = t1; }
        float mx = a1;
        mx = fmaxf(mx, dppf<DPP_X7>(dppf<DPP_X3>(mx))); mx = fmaxf(mx, dppf<DPP_X8>(mx)); mx = swap16_max(mx); mx = swap32_max(mx);
        const float pe = __builtin_amdgcn_exp2f((a1 - mx) * 1.4426950408889634f); float den = pe;
        den += dppf<DPP_X7>(dppf<DPP_X3>(den)); den += dppf<DPP_X8>(den); den = swap16_sum(den, den); den = swap32_sum(den, den);
        if (R == 4 || (lane & 3) == 0) { const float p = pe * __builtin_amdgcn_rcpf(den); const int r = r0 + (R == 4 ? (lane & 3) : 0);
            if (r < ML) PL[((size_t)(r >> 12) * 16 + my_e) * 4096 + (r & 4095)] = p; else PC[((size_t)((r - ML) >> 8) * 16 + my_e) * 256 + ((r - ML) & 255)] = p; }
    }
#undef P7_LOAD
}
DEV void p7_norm2_router(const Args& a, int l, float* lds) {
    const int tid = ltid(), lane = tid & 63, wave = tid >> 6;
    const int gw = blockIdx.x * NWAVES + wave, NGW = gridDim.x * NWAVES;
    float* RW = lds;
    for (int i = tid; i < 1024 * 16 / 4; i += NTHREADS) {
        const int col = i >> 2, e4 = i & 3, jj = col >> 8, ln = (col & 255) >> 2, ii = col & 3;
        *(f32x4*)(RW + ((((jj * 4 + ii) * 4 + e4) * 64 + ln) * 4)) = *(const f32x4*)(a.in[22] + (size_t)l * 1024 * 16 + i * 4); }
    __syncthreads();
    p7_rows<4, true>(a, l, RW, 0, ML / 4, lane, gw, NGW);
    if (l == 0) p7_rows<1, false>(a, l, RW, ML, MC, lane, gw, NGW);
}
DEV void p8_topk(const Args& a, int l, float* ldsf) {
    const int tid = ltid(), lane = tid & 63, wave = tid >> 6;
    unsigned* hist = (unsigned*)ldsf;
    unsigned* res = hist + 320;
    unsigned* wtot = hist + 384;
    int* sidx = (int*)(hist + 512);
    const float* PL = (const float*)(a.ws + WS_PROBL); const float* PC = (const float*)(a.ws + WS_PROBC);
    int* IDX = (int*)(a.ws + WS_IDX); float* AFF = (float*)(a.ws + WS_AFF); int* SEL = (int*)(a.ws + WS_SEL);
    const bf16_t* XN = (const bf16_t*)(a.ws + WS_XN); bf16_t* XG = (bf16_t*)(a.ws + WS_XG);
    const int nitems = l == 0 ? 256 : 128;
    for (int it = blockIdx.x; it < nitems; it += gridDim.x) {
        const bool isctx = it >= 128; const int be = it & 127, b = be >> 4, e = be & 15;
        const int k = isctx ? CAPC : CAPL;
        const float* p = isctx ? PC + (size_t)(b * 16 + e) * 256 : PL + (size_t)(b * 16 + e) * 4096;
        const int rowbase = isctx ? ML + b * 256 : b * 4096, slotbase = isctx ? NB * CAPL + b * CAPC : b * CAPL;
        const int cnt = isctx ? (tid < 256 ? 1 : 0) : 8, i0 = isctx ? tid : tid * 8;
        unsigned key[8];
#pragma unroll
        for (int j = 0; j < 8; ++j) key[j] = j < cnt ? __float_as_uint(p[i0 + j]) : 0u;
        unsigned prefix = 0u, mask = 0u; int krem = k;
        for (int pass = 0; pass < 4; ++pass) {
            const int shift = 24 - 8 * pass;
            if (tid < 257) hist[tid] = 0u;
            __syncthreads();
#pragma unroll
            for (int j = 0; j < 8; ++j) if (j < cnt && (key[j] & mask) == prefix) atomicAdd(&hist[(key[j] >> shift) & 255u], 1u);
            __syncthreads();

            if (wave == 0) {
                const unsigned h0 = hist[4 * lane], h1 = hist[4 * lane + 1], h2 = hist[4 * lane + 2], h3 = hist[4 * lane + 3], tot = h0 + h1 + h2 + h3;
                unsigned sfx = tot;
#pragma unroll
                for (int o = 1; o < 64; o <<= 1) { const unsigned t = __shfl_down(sfx, o); if (lane + o < 64) sfx += t; }
                const unsigned above = sfx - tot, s3 = above + h3, s2 = s3 + h2, s1 = s2 + h1, s0 = s1 + h0, kr = (unsigned)krem;
                if (s3 >= kr && above < kr) { res[0] = 4 * lane + 3; res[1] = kr - above; }
                else if (s2 >= kr && s3 < kr) { res[0] = 4 * lane + 2; res[1] = kr - s3; }
                else if (s1 >= kr && s2 < kr) { res[0] = 4 * lane + 1; res[1] = kr - s2; }
                else if (s0 >= kr && s1 < kr) { res[0] = 4 * lane; res[1] = kr - s1; }
            }
            __syncthreads();
            prefix |= res[0] << shift; mask |= 255u << shift; krem = (int)res[1];
            __syncthreads();
        }
        const unsigned Tk = prefix;
        unsigned cntp = 0u;
#pragma unroll
        for (int j = 0; j < 8; ++j) if (j < cnt) cntp += (key[j] > Tk ? 1u : 0u) + (key[j] == Tk ? 65536u : 0u);
        unsigned sc = cntp;
#pragma unroll
        for (int o = 1; o < 64; o <<= 1) { const unsigned t = __shfl_up(sc, o); if (lane >= o) sc += t; }
        if (lane == 63) wtot[wave] = sc;
        __syncthreads();
        unsigned woff = 0u;
        for (int w = 0; w < wave; ++w) woff += wtot[w];
        unsigned ex = woff + sc - cntp;
        unsigned gtr = ex & 0xffffu, eqr = ex >> 16;
        const int total_gt = k - krem;
#pragma unroll
        for (int j = 0; j < 8; ++j) if (j < cnt) {
            int slot = -1;
            if (key[j] > Tk) { slot = (int)gtr; ++gtr; }
            else if (key[j] == Tk) { if ((int)eqr < krem) slot = total_gt + (int)eqr; ++eqr; }
            const int row = rowbase + i0 + j;
            SEL[(size_t)row * 16 + e] = slot >= 0 ? slotbase + slot : -1;
            if (slot >= 0) { IDX[e * SLOTS + slotbase + slot] = row; AFF[e * SLOTS + slotbase + slot] = __uint_as_float(key[j]); sidx[slot] = row; }
        }
        __syncthreads();
    }
}
DEV void p8_gather(const Args& a, int l) {
    const int tid = ltid(), lane = tid & 63, wave = tid >> 6;
    const int gw = blockIdx.x * NWAVES + wave, NGW = gridDim.x * NWAVES;
    const int* IDX = (const int*)(a.ws + WS_IDX); const unsigned char* XN8 = a.ws + WS_XN; unsigned char* XG8 = a.ws + WS_XG;
    const int per_e = l == 0 ? SLOTS : NB * CAPL, total = 16 * per_e;
    for (int base = gw * 8; base < total; base += NGW * 8) {
        u32x4 v[8]; size_t dsto[8];
#pragma unroll
        for (int i = 0; i < 8; ++i) { const int R = base + i, e = R / per_e, s = R - e * per_e; const int row = __builtin_amdgcn_readfirstlane(IDX[e * SLOTS + s]);
            dsto[i] = ((size_t)e * SLOTS + s) * 1024; v[i] = *(const u32x4*)(XN8 + (size_t)row * 1024 + lane * 16); }
#pragma unroll
        for (int i = 0; i < 8; ++i) *(u32x4*)(XG8 + dsto[i] + lane * 16) = v[i];
    }
}


#define LAS __attribute__((address_space(3)))
#define XB_TMO      128
#define XB_XCNT(j)  (256  + 64 * (j))
#define XB_XSUB(j)  (1280 + 64 * (j))
#define XB_XGEN(j)  (2304 + 64 * (j))
#define XB_TOP      3328
#define XB_TOPGEN   3392
#define XCD_BAR_WORDS 3456
#define XB_SPIN_CAP (1u << 18)

__device__ __forceinline__ unsigned xb_ld(unsigned* p)              { return __hip_atomic_load(p, __ATOMIC_RELAXED, __HIP_MEMORY_SCOPE_AGENT); }
__device__ __forceinline__ unsigned xb_add(unsigned* p, unsigned v) { return __hip_atomic_fetch_add(p, v, __ATOMIC_RELAXED, __HIP_MEMORY_SCOPE_AGENT); }
__device__ __forceinline__ unsigned xb_xcc_id() { return (unsigned)__builtin_amdgcn_s_getreg((3 << 11) | 20) & 0xFu; }
#define XB_SPIN(cond, bar) do { unsigned _sp = 0; while (cond) { __builtin_amdgcn_s_sleep(1); \
    if ((++_sp & 255u) == 0u) { if (xb_ld(&(bar)[XB_TMO])) break; if (_sp > XB_SPIN_CAP) { atomicAdd(&(bar)[XB_TMO], 1u); break; } } } } while (0)

struct XcdBarrier {
    unsigned* bar; unsigned x;
    volatile LAS unsigned* st;
};

__device__ __forceinline__ XcdBarrier xcd_barrier_post(unsigned* bar, volatile LAS unsigned* st) {
    XcdBarrier b; b.bar = bar; b.x = xb_xcc_id(); b.st = st;
    if (threadIdx.x == 0) (void)xb_add(&bar[XB_XCNT(b.x)], 1u);
    return b;
}
__device__ __forceinline__ void xcd_barrier_complete(unsigned* bar, unsigned x, unsigned& nloc, unsigned& nx) {
    const unsigned G = gridDim.x * gridDim.y * gridDim.z;
    unsigned sum, cnt, mine, sp = 0u;
    for (;;) {
        sum = 0u; cnt = 0u; mine = 0u;
#pragma unroll
        for (unsigned j = 0; j < 16; ++j) { const unsigned c = xb_ld(&bar[XB_XCNT(j)]); sum += c; cnt += (c > 0u) ? 1u : 0u; mine = (j == x) ? c : mine; }
        if (sum == G) break;
        __builtin_amdgcn_s_sleep(1);
        if ((++sp & 255u) == 0u) { if (xb_ld(&bar[XB_TMO])) break; if (sp > XB_SPIN_CAP) { atomicAdd(&bar[XB_TMO], 1u); break; } }
    }
    nloc = mine > 0u ? mine : 1u; nx = cnt > 0u ? cnt : 1u;
}

__device__ __forceinline__ void xcd_barrier(const XcdBarrier& b) {
    asm volatile("s_waitcnt vmcnt(0)" ::: "memory");
    __syncthreads();
    if (threadIdx.x == 0) {
        unsigned* bar = b.bar;
        __builtin_amdgcn_s_waitcnt(0);
        unsigned nloc = b.st[0], nx = b.st[1];
        if (nloc == 0u) { xcd_barrier_complete(bar, b.x, nloc, nx); b.st[0] = nloc; b.st[1] = nx; }
        const unsigned old = xb_add(&bar[XB_XSUB(b.x)], 1u);
        const unsigned gen = old / nloc;
        if (old + 1u == (gen + 1u) * nloc) {
            __builtin_amdgcn_fence(__ATOMIC_RELEASE, "agent");
            asm volatile("s_waitcnt vmcnt(0)" ::: "memory");
            const unsigned og = xb_add(&bar[XB_TOP], 1u);
            const unsigned tg = og / nx;
            if (og + 1u == (tg + 1u) * nx) xb_add(&bar[XB_TOPGEN], 1u);
            else XB_SPIN(xb_ld(&bar[XB_TOPGEN]) == tg, bar);
            __builtin_amdgcn_fence(__ATOMIC_ACQUIRE, "agent");
            xb_add(&bar[XB_XGEN(b.x)], 1u);
            asm volatile("s_waitcnt vmcnt(0)" ::: "memory");
        } else {
            XB_SPIN(xb_ld(&bar[XB_XGEN(b.x)]) == gen, bar);
            __builtin_amdgcn_fence(__ATOMIC_ACQUIRE, "agent");
            asm volatile("s_waitcnt vmcnt(0)" ::: "memory");
        }
    }
    __syncthreads();
}
constexpr int NPHASES = 22;
#ifndef DUP
#define DUP 0
#endif
#define REP(bit) for (int rep_ = 0; rep_ < (((DUP) & (bit)) ? 2 : 1); ++rep_)
template <int PH> DEV void run_phase(const Args& a, float* lds) {
    if constexpr (PH == 0) { if (PM & 1) p0_mod(a, lds); }
    else if constexpr (PH == NPHASES - 1) { if ((PM & 2) && (PM & 32768)) p1_norm<2>(a); }
    else {
        constexpr int l = (PH - 1) / 10, s = (PH - 1) % 10;
        if constexpr (s == 0) { if (PM & 4) { REP(2048) { p1_weights(a, l, lds); } if (l == 0) p1_norm<0>(a); else p1_norm<1, (PM & 32768) != 0>(a); } }
        if constexpr (s == 1) { if (PM & 8) REP(1) { if (USE_MFMA_GEMM) p2_inproj_mfma(a, l, (unsigned char*)lds); else p2_inproj_simple(a, l, lds); } }
        if constexpr (s == 2) { if (PM & 16) { if (USE_MFMA_ATTN) { REP(4096) { p3_vt(a, lds); __syncthreads(); } } } if (PM & 32) REP(2) { if (USE_MFMA_RET) p3_ret_prep(a, l, (unsigned char*)lds); else p3_retU(a, l, lds); } __syncthreads(); if (PM & 64) REP(4) { if (USE_MFMA_LRU) p3_lru_agg_mfma(a, l, lds); else p3_lru_agg(a, l, lds); } }
        if constexpr (s == 3) { if (PM & 128) { p4_lru_carry(a, lds); p4_ret_scan(a, l); } if (PM & 256) REP(8) { if (USE_MFMA_ATTN) p4_attn_mfma(a, l, (unsigned char*)lds); else p4_attn_simple(a, l, lds); } }
        if constexpr (s == 4) { if (PM & 512) REP(16) { if (USE_MFMA_RET) p5_ret_out_dma(a, l, (unsigned char*)lds); else p5_ret_out(a, l, lds); } __syncthreads(); if (PM & 1024) REP(32) { if (USE_MFMA_LRU) p5_lru_out_mfma(a, l, lds); else p5_lru_out(a, l, lds); } }
        if constexpr (s == 5) { if (PM & 2048) { if (USE_MFMA_GEMM) p6_outproj_mfma(a, l, (unsigned char*)lds); else p6_outproj_simple(a, l, lds); } }
        if constexpr (s == 6) { if (PM & 4096) REP(128) { p7_norm2_router(a, l, lds); __syncthreads(); } }
        if constexpr (s == 7) { if (PM & 8192) REP(256) { p8_topk(a, l, lds); } }
        if constexpr (s == 8) { if (PM & 16384) REP(512) { if (USE_MFMA_GEMM) p9_moe1_mfma(a, l, (unsigned char*)lds); else p9_moe1_simple(a, l, lds); } }
        if constexpr (s == 9) { if (PM & 32768) REP(1024) { if (USE_MFMA_GEMM) p10_moe2_mfma(a, l, (unsigned char*)lds); else p10_moe2_simple(a, l, lds); } }
    }
}
typedef const __attribute__((address_space(4))) Args* KArgP;
template <int PH> DEV void run_from(KArgP ap, float* lds, const XcdBarrier& bar) {
    asm volatile("" : "+s"(ap));
    run_phase<PH>(*(const Args*)ap, lds);
    if constexpr (PH + 1 < NPHASES) {
        if constexpr (PH == 0) { if (((const Args*)ap)->ph_lo < 0) cg::this_grid().sync(); }
        xcd_barrier(bar);
        run_from<PH + 1>(ap, lds, bar);
    }
}
template <int PH> DEV void run_one(const Args& a, float* lds, int ph) {
    if (ph == PH) { run_phase<PH>(a, lds); return; }
    if constexpr (PH + 1 < NPHASES) run_one<PH + 1>(a, lds, ph);
}
__global__ void __launch_bounds__(NTHREADS, 2) mega(Args a) {
    extern __shared__ __attribute__((aligned(16))) unsigned char lds_raw[];
    float* lds = (float*)lds_raw;

#if N_LAUNCH_MODE == 1
    volatile LAS unsigned* bst = (volatile LAS unsigned*)((LAS unsigned char*)lds_raw + (LDS_BYTES - 64));
    if (ltid() < 16) bst[ltid()] = 0u;
    __syncthreads();
    XcdBarrier bar = xcd_barrier_post((unsigned*)(a.ws + WS_CTL) + 4096, bst);
    run_from<0>((KArgP)__builtin_amdgcn_kernarg_segment_ptr(), lds, bar);
#else
    run_one<0>(a, lds, a.ph_lo);
#endif

}

extern "C" void kernel_launch(void* const* d_in, const int* in_sizes, int n_in, void* d_out, int out_size, void* d_ws, size_t ws_size, hipStream_t stream) {
    static int grid = 0;
    if (grid == 0) {
        if (n_in != 26 || out_size != ML * D || ws_size < WS_END) { fprintf(stderr, "kernel_launch: unexpected shapes (n_in %d out %d ws %zu)\n", n_in, out_size, ws_size); grid = -1; return; }
        int dev = 0, cus = 0, per_cu = 0;
        hipGetDevice(&dev); hipDeviceGetAttribute(&cus, hipDeviceAttributeMultiprocessorCount, dev);
        hipFuncSetAttribute((const void*)mega, hipFuncAttributeMaxDynamicSharedMemorySize, LDS_BYTES);
        hipOccupancyMaxActiveBlocksPerMultiprocessor(&per_cu, (const void*)mega, NTHREADS, LDS_BYTES);
        (void)hipGetLastError();
        if (per_cu < 1) { fprintf(stderr, "kernel_launch: occupancy query says %d blocks per CU\n", per_cu); grid = -1; return; }
        grid = cus;
    }
    if (grid < 0) return;
    hipMemsetAsync((char*)d_ws + WS_CTL, 0, 1 * MiB, stream);
    Args a{};
    for (int i = 0; i < 26; ++i) a.in[i] = (const float*)d_in[i];
    a.out = (float*)d_out; a.ws = (unsigned char*)d_ws;

#if N_LAUNCH_MODE == 1
    a.ph_lo = 0; a.ph_hi = NPHASES;
    void* args[] = {&a};
    hipError_t e = hipLaunchCooperativeKernel((const void*)mega, dim3(grid), dim3(NTHREADS), args, LDS_BYTES, stream);
    if (e != hipSuccess) fprintf(stderr, "cooperative launch failed: %s (grid %d)\n", hipGetErrorString(e), grid);
#else
#ifndef PH_STOP
#define PH_STOP NPHASES
#endif
    for (int ph = 0; ph < PH_STOP; ++ph) { a.ph_lo = ph; a.ph_hi = ph + 1; hipLaunchKernelGGL(mega, dim3(grid), dim3(NTHREADS), LDS_BYTES, stream, a); }
#endif

}
```

```cpp
#include <hip/hip_runtime.h>
#include <hip/hip_cooperative_groups.h>
#include <cstdio>
#include <cstdint>
namespace cg = cooperative_groups;
#define DEV __device__ __forceinline__
#ifndef PM
#define PM 0xffff
#endif
#ifndef USE_FP8_MOE1
#define USE_FP8_MOE1 1
#endif
#ifndef USE_FP8_MOE2
#define USE_FP8_MOE2 1
#endif
#ifndef USE_MFMA_LRU
#define USE_MFMA_LRU 1
#endif
#ifndef USE_GEMM_GATHER
#define USE_GEMM_GATHER 1
#endif
#ifndef USE_MFMA_RET
#define USE_MFMA_RET 1
#endif
#ifndef USE_MFMA_ATTN
#define USE_MFMA_ATTN 1
#endif
#ifndef USE_MFMA_GEMM
#define USE_MFMA_GEMM 1
#endif
#ifndef N_LAUNCH_MODE
#define N_LAUNCH_MODE 1
#endif

typedef unsigned short bf16_t;
typedef float f32x4 __attribute__((ext_vector_type(4)));
typedef unsigned u32x4 __attribute__((ext_vector_type(4)));
typedef unsigned u32x2 __attribute__((ext_vector_type(2)));
typedef short bf16x8_t __attribute__((ext_vector_type(8)));
typedef float f32x16 __attribute__((ext_vector_type(16)));
__device__ __forceinline__ int crow16(int r, int hi) { return (r & 3) + 8 * (r >> 2) + 4 * hi; }
typedef __bf16 bf16x2_t __attribute__((ext_vector_type(2)));
DEV float dot2bf(unsigned w, unsigned x, float acc) { return __builtin_amdgcn_fdot2_f32_bf16(__builtin_bit_cast(bf16x2_t, w), __builtin_bit_cast(bf16x2_t, x), acc, false); }

constexpr int D = 1024, NB = 8, T = 4096, TC = 256;
constexpr int ML = NB * T, MC = NB * TC, M = ML + MC;
constexpr int NE = 16, CAPL = 512, CAPC = 32, SLOTS = NB * CAPL + NB * CAPC;
constexpr int NTHREADS = 512, NWAVES = 8;
constexpr float EPS = 1e-6f;
constexpr float C2 = 0.125f * 1.4426950408889634f;
constexpr int LRU_CH = 136;
constexpr int RET_CH = 34;

constexpr size_t MiB = 1u << 20;
constexpr size_t WS_CTL = 0;
constexpr size_t WS_MOD = 1 * MiB;
constexpr size_t WS_LRUW = 1 * MiB + 512 * 1024;
constexpr size_t WS_PROBL = 2 * MiB;
constexpr size_t WS_PROBC = 4 * MiB;
constexpr size_t WS_IDX = 5 * MiB;
constexpr size_t WS_AFF = 5 * MiB + 512 * 1024;
constexpr size_t WS_SEL = 6 * MiB;
constexpr size_t WS_LAGG = 9 * MiB;
constexpr size_t WS_LCAR = 14 * MiB;
constexpr size_t WS_XC = 17 * MiB;
constexpr size_t WS_RETS = 26 * MiB;
constexpr size_t WS_WT = 60 * MiB;
constexpr size_t WT_IN = 0, WT_OUT = 6 * MiB, WT_GU = 8 * MiB, WT_DN = 72 * MiB;
constexpr size_t WS_XN = 164 * MiB;
constexpr size_t WS_Y = 232 * MiB;
constexpr size_t WS_MIX = 436 * MiB;
constexpr size_t WS_XG = 232 * MiB;
constexpr size_t WS_HID = 368 * MiB;
constexpr size_t WS_Y2 = 232 * MiB;
constexpr size_t WS_VT = 504 * MiB;
constexpr size_t WS_RVT = 540 * MiB;
constexpr size_t WS_END = 557 * MiB;
constexpr size_t YARR = (size_t)M * 256;

constexpr int LDS_BYTES = 147456;

struct Args { const float* in[26]; float* out; unsigned char* ws; int ph_lo, ph_hi; };


__device__ __forceinline__ int ltid() { int t = __builtin_amdgcn_workitem_id_x(); asm volatile("" : "+v"(t)); return t; }
namespace pg8 {
#define PG8_LAS __attribute__((address_space(3)))
typedef unsigned short bf16_t;
typedef short bf16x8 __attribute__((ext_vector_type(8)));
typedef float f32x4 __attribute__((ext_vector_type(4)));
typedef unsigned u32x4 __attribute__((ext_vector_type(4)));
typedef int i32x4 __attribute__((ext_vector_type(4)));
typedef int i32x8 __attribute__((ext_vector_type(8)));
constexpr int BM = 256, BK = 64, HALF = 128, HTB = HALF * BK * 2  , STAGE_BYTES = 8 * HTB, NXCD = 8, WGM = 8;

__host__ __device__ __forceinline__ int lds_byte(int r, int c) { const int st = (r >> 4) * 2 + (c >> 5), rr = r & 15, cc = c & 31, ob = rr * 64 + cc * 2; return st * 1024 + (ob ^ (((ob >> 9) & 1) << 5)); }
__host__ __device__ __forceinline__ void stage_rc(int b, int& R, int& C) { const int st = b / 1024, sb = b % 1024, swz = sb ^ (((sb >> 9) & 1) << 5); R = (st >> 1) * 16 + swz / 64; C = (st & 1) * 32 + (swz % 64) / 2; }
__host__ __device__ __forceinline__ int perm32(int rho) { const int n = rho >> 4, i = rho & 15; return 8 * (i >> 2) + 4 * n + (i & 3); }

struct Unit { int pm, pn; };
struct Gemm { const bf16_t* A; const bf16_t* Bt; int M, N, K; };

struct StaticOrder {
    int nM, nN, nwg, G, c;
    __host__ __device__ void init(int M, int N, int G_, int c_) { nM = M / BM; nN = N / BM; nwg = nM * nN; G = G_; c = c_; }
    __host__ __device__ bool next(int i, Unit& u) const {
        const long L = (long)i * G + c; if (L >= nwg) return false;
        int wgid = (int)L; { const int q = nwg / NXCD, r = nwg % NXCD, xcd = wgid % NXCD, off = wgid / NXCD; wgid = (xcd < r ? xcd * (q + 1) : r * (q + 1) + (xcd - r) * q) + off; }
        const int nig = WGM * nN, gid = wgid / nig, fm = gid * WGM, gsz = (nM - fm) < WGM ? (nM - fm) : WGM;
        u.pm = fm + ((wgid % nig) % gsz); u.pn = (wgid % nig) / gsz; return true;
    }
    __device__ __forceinline__ void a_ready(const Unit&) const {}
    __device__ __forceinline__ void done(const Unit&) const {}
};

__device__ __forceinline__ unsigned cvt_pk_bf16(float lo, float hi) { unsigned r; asm volatile("v_cvt_pk_bf16_f32 %0, %1, %2" : "=v"(r) : "v"(lo), "v"(hi)); return r; }
typedef float f32x2 __attribute__((ext_vector_type(2)));
__device__ __forceinline__ f32x2 gelu_pk(f32x2 v) {
    const f32x2 av = __builtin_elementwise_abs(v), d = av * 0.2316418882f + 1.0f;
    f32x2 t; t.x = __builtin_amdgcn_rcpf(d.x); t.y = __builtin_amdgcn_rcpf(d.y);
    f32x2 q = t * 0.5307027145f + (-0.7265760135f); q = q * t + 0.7107068705f; q = q * t + (-0.142248368f); q = q * t + 0.127414796f; q = q * t;
    const f32x2 s = (v * v) * (-0.72134752044f);
    f32x2 e; e.x = __builtin_amdgcn_exp2f(s.x); e.y = __builtin_amdgcn_exp2f(s.y);
    const f32x2 m = v * (q * e), r = v - m;
    f32x2 o; o.x = v.x < 0.f ? m.x : r.x; o.y = v.y < 0.f ? m.y : r.y; return o;
}

template <int ACT  > struct EpiBf16 {
    static constexpr bool PERM = true, AFTER_DRAIN = false; static_assert(ACT == 0 || ACT == 1, "EpiBf16: ACT is 0 (none) or 1 (gelu_pk)");
    bf16_t* O; int ldc; const float* bias; int split_cols; size_t split_stride; float scale0;
    __device__ __forceinline__ void operator()(const f32x4 (&acc)[2][2][4][2], const Unit& u, int wr, int wc, int fr, int fq) const {
        const int row0 = u.pm * BM + wr * 64 + fr; int colt = u.pn * BM; bf16_t* base = O;
        float sc = 1.f; if (split_cols) { const int t = colt / split_cols; base += (size_t)t * split_stride; colt -= t * split_cols; if (t == 0) sc = scale0; }
        const int col0 = colt + wc * 32 + 8 * fq, bcol0 = u.pn * BM + wc * 32 + 8 * fq;
        f32x4 bv[2][2];
#pragma unroll
        for (int bj = 0; bj < 2; ++bj)
#pragma unroll
            for (int n = 0; n < 2; ++n) bv[bj][n] = bias ? *(const f32x4*)(bias + bcol0 + bj * HALF + 4 * n) : (f32x4){0.f, 0.f, 0.f, 0.f};
#pragma unroll
        for (int ai = 0; ai < 2; ++ai)
#pragma unroll
            for (int m = 0; m < 4; ++m) { bf16_t* rowp = base + (size_t)(row0 + ai * HALF + m * 16) * ldc + col0;
#pragma unroll
                for (int bj = 0; bj < 2; ++bj) { f32x4 v0 = acc[ai][bj][m][0] + bv[bj][0], v1 = acc[ai][bj][m][1] + bv[bj][1];
                    if (ACT == 1) { f32x2 a = gelu_pk((f32x2){v0[0], v0[1]}), b = gelu_pk((f32x2){v0[2], v0[3]}), c = gelu_pk((f32x2){v1[0], v1[1]}), d = gelu_pk((f32x2){v1[2], v1[3]});
                        v0 = (f32x4){a.x, a.y, b.x, b.y}; v1 = (f32x4){c.x, c.y, d.x, d.y}; }
                    v0 = v0 * sc; v1 = v1 * sc; u32x4 w; w.x = cvt_pk_bf16(v0[0], v0[1]); w.y = cvt_pk_bf16(v0[2], v0[3]); w.z = cvt_pk_bf16(v1[0], v1[1]); w.w = cvt_pk_bf16(v1[2], v1[3]);
                    *(u32x4*)(rowp + bj * HALF) = w; } }
    }
};
template <class Epi, class Sched, bool ALIGN_EPI = false, bool SP2 = false>
__device__ __forceinline__ void gemm_phase(PG8_LAS unsigned char* lds, const Gemm g, const Sched& S, const Epi& E) {
    const int tid = ltid(), wid = __builtin_amdgcn_readfirstlane(tid >> 6), lane = tid & 63, wr = wid >> 2, wc = wid & 3, fr = lane & 15, fq = lane >> 4;
    const int K = g.K, nt = K / BK;
    unsigned voffA[2], voffB[2];
#pragma unroll
    for (int i = 0; i < 2; ++i) { int R, C; stage_rc(tid * 16 + i * 8192, R, C); const int Rb = Epi::PERM ? ((R & ~31) + perm32(R & 31)) : R;
        voffA[i] = (unsigned)(R * K + C) * 2u; voffB[i] = (unsigned)(Rb * K + C) * 2u; }
    const size_t kstep = (size_t)(BK * 2);
    const size_t hstep = (size_t)HALF * K * 2;
    const size_t tstep = 2 * hstep;
    const unsigned ldsw = (unsigned)wid * 1024u;
    const int aoff = lds_byte(wr * 64 + fr, fq * 8), boff = lds_byte(wc * 32 + fr, fq * 8);
#define PG8_SA(b, h) (((b) * 2 + (h)) * HTB)
#define PG8_SB(b, h) ((4 + (b) * 2 + (h)) * HTB)
#define PG8_STAGE(bufoff, gbase, voff) do { _Pragma("unroll") for (int _i = 0; _i < 2; ++_i) \
        __builtin_amdgcn_global_load_lds((const unsigned*)((const char*)(gbase) + (voff)[_i]), (PG8_LAS unsigned*)(lds + (bufoff) + ldsw + _i * 8192), 16, 0, 0); } while (0)
#define PG8_LDA(dst, b, h) do { _Pragma("unroll") for (int m = 0; m < 4; ++m) _Pragma("unroll") for (int k = 0; k < 2; ++k) dst[m][k] = *(const PG8_LAS bf16x8*)(lds + PG8_SA(b, h) + aoff + m * 2048 + k * 1024); } while (0)
#define PG8_LDB(dst, b, h) do { _Pragma("unroll") for (int n = 0; n < 2; ++n) _Pragma("unroll") for (int k = 0; k < 2; ++k) dst[n][k] = *(const PG8_LAS bf16x8*)(lds + PG8_SB(b, h) + boff + n * 2048 + k * 1024); } while (0)
#define PG8_MMA(ai, bj, At, Bt) do { __builtin_amdgcn_s_setprio(1); _Pragma("unroll") for (int m = 0; m < 4; ++m) _Pragma("unroll") for (int n = 0; n < 2; ++n) _Pragma("unroll") for (int k = 0; k < 2; ++k) \
        acc[ai][bj][m][n] = __builtin_amdgcn_mfma_f32_16x16x32_bf16(Bt[n][k], At[m][k], acc[ai][bj][m][n], 0, 0, 0); __builtin_amdgcn_s_setprio(0); } while (0)
#define PG8_WAIT_V(n) asm volatile("s_waitcnt vmcnt(" #n ")" ::: "memory")
#define PG8_WAIT_L(n) asm volatile("s_waitcnt lgkmcnt(" #n ")" ::: "memory")
#define PG8_BAR __builtin_amdgcn_s_barrier()
#define PG8_SCHED __builtin_amdgcn_sched_barrier(0)
    Unit cur, nxt; int ui = 0;
    if (!S.next(0, cur)) return;
    f32x4 acc[2][2][4][2];
#pragma unroll
    for (int a = 0; a < 2; ++a)
#pragma unroll
        for (int b = 0; b < 2; ++b)
#pragma unroll
            for (int m = 0; m < 4; ++m)
#pragma unroll
                for (int n = 0; n < 2; ++n) acc[a][b][m][n] = (f32x4){0.f, 0.f, 0.f, 0.f};
    bf16x8 At[4][2], B0[2][2], B1[2][2];
    const char* cA = (const char*)g.A + (size_t)cur.pm * tstep; const char* cB = (const char*)g.Bt + (size_t)cur.pn * tstep;
    S.a_ready(cur);
    if constexpr (SP2) {
        PG8_STAGE(PG8_SB(0, 0), cB, voffB); PG8_STAGE(PG8_SB(0, 1), cB + hstep, voffB); PG8_STAGE(PG8_SA(0, 0), cA, voffA); PG8_STAGE(PG8_SA(0, 1), cA + hstep, voffA);
        if (wr == 1) PG8_BAR;
        PG8_WAIT_V(2); PG8_BAR;
        PG8_STAGE(PG8_SB(1, 0), cB + kstep, voffB); PG8_STAGE(PG8_SA(1, 0), cA + kstep, voffA); PG8_STAGE(PG8_SB(1, 1), cB + hstep + kstep, voffB);
        PG8_WAIT_V(6); PG8_BAR;
    } else {
        PG8_STAGE(PG8_SB(0, 0), cB, voffB); PG8_STAGE(PG8_SA(0, 0), cA, voffA); PG8_STAGE(PG8_SB(0, 1), cB + hstep, voffB); PG8_STAGE(PG8_SA(0, 1), cA + hstep, voffA);
        if (wr == 1) PG8_BAR;
        PG8_WAIT_V(4); PG8_BAR;
        PG8_STAGE(PG8_SB(1, 0), cB + kstep, voffB); PG8_STAGE(PG8_SA(1, 0), cA + kstep, voffA); PG8_STAGE(PG8_SB(1, 1), cB + hstep + kstep, voffB);
        PG8_WAIT_V(6); PG8_BAR;
    }
    for (;;) {
        const bool has_next = S.next(ui + 1, nxt);
        const char* nA = has_next ? (const char*)g.A + (size_t)nxt.pm * tstep : cA; const char* nB = has_next ? (const char*)g.Bt + (size_t)nxt.pn * tstep : cB;
        for (int t = 0; t < nt; t += 2) {
            const bool last = (t == nt - 2);
            const char* a1 = cA + (size_t)(t + 1) * kstep;
            const char* a2 = last ? nA : cA + (size_t)(t + 2) * kstep; const char* b2 = last ? nB : cB + (size_t)(t + 2) * kstep;
            const char* a3 = a2 + kstep; const char* b3 = b2 + kstep;
            if (last && has_next) S.a_ready(nxt);
            if constexpr (SP2) {
            PG8_LDB(B0, 0, 0); PG8_LDB(B1, 0, 1); PG8_SCHED; PG8_LDA(At, 0, 0); PG8_STAGE(PG8_SA(1, 1), a1 + hstep, voffA);
            PG8_WAIT_V(8); PG8_WAIT_L(0); PG8_BAR; PG8_MMA(0, 0, At, B0); PG8_MMA(0, 1, At, B1); PG8_BAR; PG8_SCHED;
            PG8_LDA(At, 0, 1); PG8_STAGE(PG8_SB(0, 0), b2, voffB); PG8_STAGE(PG8_SB(0, 1), b2 + hstep, voffB); PG8_STAGE(PG8_SA(0, 0), a2, voffA);
            PG8_WAIT_V(8); PG8_WAIT_L(0); PG8_BAR; PG8_MMA(1, 0, At, B0); PG8_MMA(1, 1, At, B1); PG8_BAR; PG8_SCHED;
            PG8_LDB(B0, 1, 0); PG8_LDB(B1, 1, 1); PG8_SCHED; PG8_LDA(At, 1, 0); PG8_STAGE(PG8_SA(0, 1), a2 + hstep, voffA);
            PG8_WAIT_V(8); PG8_WAIT_L(0); PG8_BAR; PG8_MMA(0, 0, At, B0); PG8_MMA(0, 1, At, B1); PG8_BAR; PG8_SCHED;
            PG8_LDA(At, 1, 1); PG8_STAGE(PG8_SB(1, 0), b3, voffB); PG8_STAGE(PG8_SB(1, 1), b3 + hstep, voffB); PG8_STAGE(PG8_SA(1, 0), a3, voffA);
            PG8_WAIT_V(8); PG8_WAIT_L(0); PG8_BAR; PG8_MMA(1, 0, At, B0); PG8_MMA(1, 1, At, B1); PG8_BAR; PG8_SCHED;
            } else {
            PG8_LDB(B0, 0, 0); PG8_SCHED; PG8_LDA(At, 0, 0); PG8_STAGE(PG8_SA(1, 1), a1 + hstep, voffA);
            PG8_WAIT_L(8); PG8_BAR; PG8_WAIT_L(0); PG8_MMA(0, 0, At, B0); PG8_BAR; PG8_SCHED;
            PG8_LDB(B1, 0, 1); PG8_STAGE(PG8_SB(0, 0), b2, voffB);
            PG8_BAR; PG8_WAIT_L(0); PG8_MMA(0, 1, At, B1); PG8_BAR;
            PG8_LDA(At, 0, 1); PG8_STAGE(PG8_SA(0, 0), a2, voffA);
            PG8_BAR; PG8_WAIT_L(0); PG8_MMA(1, 0, At, B0); PG8_BAR; PG8_SCHED;
            PG8_STAGE(PG8_SB(0, 1), b2 + hstep, voffB);
            PG8_WAIT_V(6); PG8_BAR; PG8_MMA(1, 1, At, B1); PG8_BAR;
            PG8_LDB(B0, 1, 0); PG8_SCHED; PG8_LDA(At, 1, 0); PG8_STAGE(PG8_SA(0, 1), a2 + hstep, voffA);
            PG8_WAIT_L(8); PG8_BAR; PG8_WAIT_L(0); PG8_MMA(0, 0, At, B0); PG8_BAR; PG8_SCHED;
            PG8_LDB(B1, 1, 1); PG8_STAGE(PG8_SB(1, 0), b3, voffB);
            PG8_BAR; PG8_WAIT_L(0); PG8_MMA(0, 1, At, B1); PG8_BAR;
            PG8_LDA(At, 1, 1); PG8_STAGE(PG8_SA(1, 0), a3, voffA);
            PG8_BAR; PG8_WAIT_L(0); PG8_MMA(1, 0, At, B0); PG8_BAR; PG8_SCHED;
            PG8_STAGE(PG8_SB(1, 1), b3 + hstep, voffB);
            PG8_WAIT_V(6); PG8_BAR; PG8_MMA(1, 1, At, B1); PG8_BAR;
            }
        }
        if constexpr (ALIGN_EPI) { if (wr == 0) PG8_BAR; }
        if constexpr (!Epi::AFTER_DRAIN) { E(acc, cur, wr, wc, fr, fq); S.done(cur); }
        if (!has_next) break;
#pragma unroll
        for (int a = 0; a < 2; ++a)
#pragma unroll
            for (int b = 0; b < 2; ++b)
#pragma unroll
                for (int m = 0; m < 4; ++m)
#pragma unroll
                    for (int n = 0; n < 2; ++n) acc[a][b][m][n] = (f32x4){0.f, 0.f, 0.f, 0.f};
        cur = nxt; cA = nA; cB = nB; ++ui;
        if constexpr (ALIGN_EPI) { if (wr == 1) PG8_BAR; }
    }
    PG8_WAIT_V(0);
    if constexpr (!ALIGN_EPI) { if (wr == 0) PG8_BAR; }
    PG8_BAR;
    if constexpr (Epi::AFTER_DRAIN) { E.fused(acc, cur, wr, wc, fr, fq, lds, wid, lane); S.done(cur); }
#undef PG8_SA
#undef PG8_SB
#undef PG8_STAGE
#undef PG8_LDA
#undef PG8_LDB
#undef PG8_MMA
#undef PG8_WAIT_V
#undef PG8_WAIT_L
#undef PG8_BAR
#undef PG8_SCHED
}
template <class Epi, class Sched, bool ALIGN_EPI = false>
__device__ __forceinline__ void gemm_phase_fp8(PG8_LAS unsigned char* lds, const Gemm g, const Sched& S, const Epi& E, int scale_w, int scale_x) {
    constexpr bool SP2 = true;
    const int tid = ltid(), wid = __builtin_amdgcn_readfirstlane(tid >> 6), lane = tid & 63, wr = wid >> 2, wc = wid & 3, fr = lane & 15, fq = lane >> 4;
    const int K = g.K, nt = K / BK;
    unsigned voffA[2], voffB[2];
#pragma unroll
    for (int i = 0; i < 2; ++i) { int R, C; stage_rc(tid * 16 + i * 8192, R, C); const int Rb = Epi::PERM ? ((R & ~31) + perm32(R & 31)) : R;
        voffA[i] = (unsigned)(R * K + C) * 2u; voffB[i] = (unsigned)(Rb * K + C) * 2u; }
    const size_t kstep = (size_t)(BK * 2);
    const size_t hstep = (size_t)HALF * K * 2;
    const size_t tstep = 2 * hstep;
    const unsigned ldsw = (unsigned)wid * 1024u;
    const int aoff = lds_byte(wr * 64 + fr, fq * 8), boff = lds_byte(wc * 32 + fr, fq * 8);
#define PG8_SA(b, h) (((b) * 2 + (h)) * HTB)
#define PG8_SB(b, h) ((4 + (b) * 2 + (h)) * HTB)
#define PG8_STAGE(bufoff, gbase, voff) do { _Pragma("unroll") for (int _i = 0; _i < 2; ++_i) \
        __builtin_amdgcn_global_load_lds((const unsigned*)((const char*)(gbase) + (voff)[_i]), (PG8_LAS unsigned*)(lds + (bufoff) + ldsw + _i * 8192), 16, 0, 0); } while (0)
#define PG8_LDA(dst, b, h) do { _Pragma("unroll") for (int m = 0; m < 4; ++m) { dst[m].lo = *(const PG8_LAS i32x4*)(lds + PG8_SA(b, h) + aoff + m * 2048); dst[m].hi = *(const PG8_LAS i32x4*)(lds + PG8_SA(b, h) + aoff + m * 2048 + 1024); } } while (0)
#define PG8_LDB(dst, b, h) do { _Pragma("unroll") for (int n = 0; n < 2; ++n) { dst[n].lo = *(const PG8_LAS i32x4*)(lds + PG8_SB(b, h) + boff + n * 2048); dst[n].hi = *(const PG8_LAS i32x4*)(lds + PG8_SB(b, h) + boff + n * 2048 + 1024); } } while (0)
#define PG8_MMA(ai, bj, At, Bt) do { __builtin_amdgcn_s_setprio(1); _Pragma("unroll") for (int m = 0; m < 4; ++m) _Pragma("unroll") for (int n = 0; n < 2; ++n) \
        asm volatile("v_mfma_scale_f32_16x16x128_f8f6f4 %0, %1, %2, %0, %3, %4 op_sel_hi:[0,0,0]" : "+v"(acc[ai][bj][m][n]) : "v"(Bt[n]), "v"(At[m]), "v"(sclB), "v"(sclA));     \
        __builtin_amdgcn_s_setprio(0); } while (0)
#define PG8_WAIT_V(n) asm volatile("s_waitcnt vmcnt(" #n ")" ::: "memory")
#define PG8_WAIT_L(n) asm volatile("s_waitcnt lgkmcnt(" #n ")" ::: "memory")
#define PG8_BAR __builtin_amdgcn_s_barrier()
#define PG8_SCHED __builtin_amdgcn_sched_barrier(0)
    Unit cur, nxt; int ui = 0;
    if (!S.next(0, cur)) return;
    f32x4 acc[2][2][4][2];
#pragma unroll
    for (int a = 0; a < 2; ++a)
#pragma unroll
        for (int b = 0; b < 2; ++b)
#pragma unroll
            for (int m = 0; m < 4; ++m)
#pragma unroll
                for (int n = 0; n < 2; ++n) acc[a][b][m][n] = (f32x4){0.f, 0.f, 0.f, 0.f};
    i32x8 At[4], B0[2], B1[2];
    int sclB = scale_w, sclA = scale_x; asm volatile("" : "+v"(sclB), "+v"(sclA));
    const char* cA = (const char*)g.A + (size_t)cur.pm * tstep; const char* cB = (const char*)g.Bt + (size_t)cur.pn * tstep;
    S.a_ready(cur);
    if constexpr (SP2) {
        PG8_STAGE(PG8_SB(0, 0), cB, voffB); PG8_STAGE(PG8_SB(0, 1), cB + hstep, voffB); PG8_STAGE(PG8_SA(0, 0), cA, voffA); PG8_STAGE(PG8_SA(0, 1), cA + hstep, voffA);
        if (wr == 1) PG8_BAR;
        PG8_WAIT_V(2); PG8_BAR;
        PG8_STAGE(PG8_SB(1, 0), cB + kstep, voffB); PG8_STAGE(PG8_SA(1, 0), cA + kstep, voffA); PG8_STAGE(PG8_SB(1, 1), cB + hstep + kstep, voffB);
        PG8_WAIT_V(6); PG8_BAR;
    } else {
        PG8_STAGE(PG8_SB(0, 0), cB, voffB); PG8_STAGE(PG8_SA(0, 0), cA, voffA); PG8_STAGE(PG8_SB(0, 1), cB + hstep, voffB); PG8_STAGE(PG8_SA(0, 1), cA + hstep, voffA);
        if (wr == 1) PG8_BAR;
        PG8_WAIT_V(4); PG8_BAR;
        PG8_STAGE(PG8_SB(1, 0), cB + kstep, voffB); PG8_STAGE(PG8_SA(1, 0), cA + kstep, voffA); PG8_STAGE(PG8_SB(1, 1), cB + hstep + kstep, voffB);
        PG8_WAIT_V(6); PG8_BAR;
    }
    for (;;) {
        const bool has_next = S.next(ui + 1, nxt);
        const char* nA = has_next ? (const char*)g.A + (size_t)nxt.pm * tstep : cA; const char* nB = has_next ? (const char*)g.Bt + (size_t)nxt.pn * tstep : cB;
#pragma unroll 1
        for (int t = 0; t < nt; t += 2) {
            const bool last = (t == nt - 2);
            const char* a1 = cA + (size_t)(t + 1) * kstep;
            const char* a2 = last ? nA : cA + (size_t)(t + 2) * kstep; const char* b2 = last ? nB : cB + (size_t)(t + 2) * kstep;
            const char* a3 = a2 + kstep; const char* b3 = b2 + kstep;
            if (last && has_next) S.a_ready(nxt);
            if constexpr (SP2) {
            PG8_LDB(B0, 0, 0); PG8_LDB(B1, 0, 1); PG8_SCHED; PG8_LDA(At, 0, 0); PG8_STAGE(PG8_SA(1, 1), a1 + hstep, voffA);
            PG8_WAIT_V(8); PG8_WAIT_L(0); PG8_BAR; PG8_MMA(0, 0, At, B0); PG8_MMA(0, 1, At, B1); PG8_BAR; PG8_SCHED;
            PG8_LDA(At, 0, 1); PG8_STAGE(PG8_SB(0, 0), b2, voffB); PG8_STAGE(PG8_SB(0, 1), b2 + hstep, voffB); PG8_STAGE(PG8_SA(0, 0), a2, voffA);
            PG8_WAIT_V(8); PG8_WAIT_L(0); PG8_BAR; PG8_MMA(1, 0, At, B0); PG8_MMA(1, 1, At, B1); PG8_BAR; PG8_SCHED;
            PG8_LDB(B0, 1, 0); PG8_LDB(B1, 1, 1); PG8_SCHED; PG8_LDA(At, 1, 0); PG8_STAGE(PG8_SA(0, 1), a2 + hstep, voffA);
            PG8_WAIT_V(8); PG8_WAIT_L(0); PG8_BAR; PG8_MMA(0, 0, At, B0); PG8_MMA(0, 1, At, B1); PG8_BAR; PG8_SCHED;
            PG8_LDA(At, 1, 1); PG8_STAGE(PG8_SB(1, 0), b3, voffB); PG8_STAGE(PG8_SB(1, 1), b3 + hstep, voffB); PG8_STAGE(PG8_SA(1, 0), a3, voffA);
            PG8_WAIT_V(8); PG8_WAIT_L(0); PG8_BAR; PG8_MMA(1, 0, At, B0); PG8_MMA(1, 1, At, B1); PG8_BAR; PG8_SCHED;
            } else {
            PG8_LDB(B0, 0, 0); PG8_SCHED; PG8_LDA(At, 0, 0); PG8_STAGE(PG8_SA(1, 1), a1 + hstep, voffA);
            PG8_WAIT_L(8); PG8_BAR; PG8_WAIT_L(0); PG8_MMA(0, 0, At, B0); PG8_BAR; PG8_SCHED;
            PG8_LDB(B1, 0, 1); PG8_STAGE(PG8_SB(0, 0), b2, voffB);
            PG8_BAR; PG8_WAIT_L(0); PG8_MMA(0, 1, At, B1); PG8_BAR;
            PG8_LDA(At, 0, 1); PG8_STAGE(PG8_SA(0, 0), a2, voffA);
            PG8_BAR; PG8_WAIT_L(0); PG8_MMA(1, 0, At, B0); PG8_BAR; PG8_SCHED;
            PG8_STAGE(PG8_SB(0, 1), b2 + hstep, voffB);
            PG8_WAIT_V(6); PG8_BAR; PG8_MMA(1, 1, At, B1); PG8_BAR;
            PG8_LDB(B0, 1, 0); PG8_SCHED; PG8_LDA(At, 1, 0); PG8_STAGE(PG8_SA(0, 1), a2 + hstep, voffA);
            PG8_WAIT_L(8); PG8_BAR; PG8_WAIT_L(0); PG8_MMA(0, 0, At, B0); PG8_BAR; PG8_SCHED;
            PG8_LDB(B1, 1, 1); PG8_STAGE(PG8_SB(1, 0), b3, voffB);
            PG8_BAR; PG8_WAIT_L(0); PG8_MMA(0, 1, At, B1); PG8_BAR;
            PG8_LDA(At, 1, 1); PG8_STAGE(PG8_SA(1, 0), a3, voffA);
            PG8_BAR; PG8_WAIT_L(0); PG8_MMA(1, 0, At, B0); PG8_BAR; PG8_SCHED;
            PG8_STAGE(PG8_SB(1, 1), b3 + hstep, voffB);
            PG8_WAIT_V(6); PG8_BAR; PG8_MMA(1, 1, At, B1); PG8_BAR;
            }
        }
        asm volatile("s_nop 15\n\ts_nop 15" ::: "memory");
        if constexpr (ALIGN_EPI) { if (wr == 0) PG8_BAR; }
        if constexpr (!Epi::AFTER_DRAIN) { E(acc, cur, wr, wc, fr, fq); S.done(cur); }
        if (!has_next) break;
#pragma unroll
        for (int a = 0; a < 2; ++a)
#pragma unroll
            for (int b = 0; b < 2; ++b)
#pragma unroll
                for (int m = 0; m < 4; ++m)
#pragma unroll
                    for (int n = 0; n < 2; ++n) acc[a][b][m][n] = (f32x4){0.f, 0.f, 0.f, 0.f};
        cur = nxt; cA = nA; cB = nB; ++ui;
        if constexpr (ALIGN_EPI) { if (wr == 1) PG8_BAR; }
    }
    PG8_WAIT_V(0);
    if constexpr (!ALIGN_EPI) { if (wr == 0) PG8_BAR; }
    PG8_BAR;
    if constexpr (Epi::AFTER_DRAIN) { E.fused(acc, cur, wr, wc, fr, fq, lds, wid, lane); S.done(cur); }
#undef PG8_SA
#undef PG8_SB
#undef PG8_STAGE
#undef PG8_LDA
#undef PG8_LDB
#undef PG8_MMA
#undef PG8_WAIT_V
#undef PG8_WAIT_L
#undef PG8_BAR
#undef PG8_SCHED
}
template <class Epi, class Sched, bool ALIGN_EPI = false, bool FP8 = false>
__device__ __forceinline__ void gemm_phase_gather(PG8_LAS unsigned char* lds, const Gemm g, const int* idx, const Sched& S, const Epi& E) {
    constexpr bool SP2 = true;
    const int tid = ltid(), wid = __builtin_amdgcn_readfirstlane(tid >> 6), lane = tid & 63, wr = wid >> 2, wc = wid & 3, fr = lane & 15, fq = lane >> 4;
    const int K = g.K, nt = K / BK;
    unsigned voffB[2], vC[2][2], vN[2][2];
#pragma unroll
    for (int i = 0; i < 2; ++i) { int R, C; stage_rc(tid * 16 + i * 8192, R, C); const int Rb = Epi::PERM ? ((R & ~31) + perm32(R & 31)) : R;
        voffB[i] = (unsigned)(Rb * K + C) * 2u; }
#define PG8_GOFF(dst, unit) do { const int t_ = ltid(); _Pragma("unroll") for (int i_ = 0; i_ < 2; ++i_) { int R_, C_; stage_rc(t_ * 16 + i_ * 8192, R_, C_); \
        _Pragma("unroll") for (int h_ = 0; h_ < 2; ++h_) dst[h_][i_] = (unsigned)idx[(unit).pm * 256 + h_ * 128 + R_] * (unsigned)(K * 2) + (unsigned)(C_ * 2); } } while (0)
    const size_t kstep = (size_t)(BK * 2);
    const size_t hstep = (size_t)HALF * K * 2;
    const size_t tstep = 2 * hstep;
    const unsigned ldsw = (unsigned)wid * 1024u;
    const int aoff = lds_byte(wr * 64 + fr, fq * 8), boff = lds_byte(wc * 32 + fr, fq * 8);
#define PG8_SA(b, h) (((b) * 2 + (h)) * HTB)
#define PG8_SB(b, h) ((4 + (b) * 2 + (h)) * HTB)
#define PG8_STAGE(bufoff, gbase, voff) do { _Pragma("unroll") for (int _i = 0; _i < 2; ++_i) \
        __builtin_amdgcn_global_load_lds((const unsigned*)((const char*)(gbase) + (voff)[_i]), (PG8_LAS unsigned*)(lds + (bufoff) + ldsw + _i * 8192), 16, 0, 0); } while (0)
#define PG8_LDA(dst, b, h) do { _Pragma("unroll") for (int m = 0; m < 4; ++m) { dst[m].lo = *(const PG8_LAS i32x4*)(lds + PG8_SA(b, h) + aoff + m * 2048); dst[m].hi = *(const PG8_LAS i32x4*)(lds + PG8_SA(b, h) + aoff + m * 2048 + 1024); } } while (0)
#define PG8_LDB(dst, b, h) do { _Pragma("unroll") for (int n = 0; n < 2; ++n) { dst[n].lo = *(const PG8_LAS i32x4*)(lds + PG8_SB(b, h) + boff + n * 2048); dst[n].hi = *(const PG8_LAS i32x4*)(lds + PG8_SB(b, h) + boff + n * 2048 + 1024); } } while (0)
#define PG8_MMA(ai, bj, At, Bt) do { __builtin_amdgcn_s_setprio(1); _Pragma("unroll") for (int m = 0; m < 4; ++m) _Pragma("unroll") for (int n = 0; n < 2; ++n) \
        asm volatile("v_mfma_scale_f32_16x16x128_f8f6f4 %0, %1, %2, %0, %3, %4 op_sel_hi:[0,0,0]" : "+v"(acc[ai][bj][m][n]) : "v"(Bt[n]), "v"(At[m]), "v"(sclB), "v"(sclA));     \
        __builtin_amdgcn_s_setprio(0); } while (0)
#define PG8_WAIT_V(n) asm volatile("s_waitcnt vmcnt(" #n ")" ::: "memory")
#define PG8_WAIT_L(n) asm volatile("s_waitcnt lgkmcnt(" #n ")" ::: "memory")
#define PG8_BAR __builtin_amdgcn_s_barrier()
#define PG8_SCHED __builtin_amdgcn_sched_barrier(0)
    Unit cur, nxt; int ui = 0;
    if (!S.next(0, cur)) return;
    f32x4 acc[2][2][4][2];
#pragma unroll
    for (int a = 0; a < 2; ++a)
#pragma unroll
        for (int b = 0; b < 2; ++b)
#pragma unroll
            for (int m = 0; m < 4; ++m)
#pragma unroll
                for (int n = 0; n < 2; ++n) acc[a][b][m][n] = (f32x4){0.f, 0.f, 0.f, 0.f};
    i32x8 At[4], B0[2], B1[2];
    int sclB = 122, sclA = 127; asm volatile("" : "+v"(sclB), "+v"(sclA));
    const char* cA = (const char*)g.A; const char* cB = (const char*)g.Bt + (size_t)cur.pn * tstep;
    PG8_GOFF(vC, cur);
    S.a_ready(cur);
    if constexpr (SP2) {
        PG8_STAGE(PG8_SB(0, 0), cB, voffB); PG8_STAGE(PG8_SB(0, 1), cB + hstep, voffB); PG8_STAGE(PG8_SA(0, 0), cA, vC[0]); PG8_STAGE(PG8_SA(0, 1), cA, vC[1]);
        if (wr == 1) PG8_BAR;
        PG8_WAIT_V(2); PG8_BAR;
        PG8_STAGE(PG8_SB(1, 0), cB + kstep, voffB); PG8_STAGE(PG8_SA(1, 0), cA + kstep, vC[0]); PG8_STAGE(PG8_SB(1, 1), cB + hstep + kstep, voffB);
        PG8_WAIT_V(6); PG8_BAR;
    } else {
        PG8_STAGE(PG8_SB(0, 0), cB, voffB); PG8_STAGE(PG8_SA(0, 0), cA, vC[0]); PG8_STAGE(PG8_SB(0, 1), cB + hstep, voffB); PG8_STAGE(PG8_SA(0, 1), cA, vC[1]);
        if (wr == 1) PG8_BAR;
        PG8_WAIT_V(4); PG8_BAR;
        PG8_STAGE(PG8_SB(1, 0), cB + kstep, voffB); PG8_STAGE(PG8_SA(1, 0), cA + kstep, vC[0]); PG8_STAGE(PG8_SB(1, 1), cB + hstep + kstep, voffB);
        PG8_WAIT_V(6); PG8_BAR;
    }
    for (;;) {
        const bool has_next = S.next(ui + 1, nxt);
        const char* nA = cA; const char* nB = has_next ? (const char*)g.Bt + (size_t)nxt.pn * tstep : cB;
        if (has_next) PG8_GOFF(vN, nxt); else { _Pragma("unroll") for (int h_ = 0; h_ < 2; ++h_) _Pragma("unroll") for (int i_ = 0; i_ < 2; ++i_) vN[h_][i_] = vC[h_][i_]; }
#pragma unroll 1
        for (int t = 0; t < nt; t += 2) {
            const bool last = (t == nt - 2);
            const char* a1 = cA + (size_t)(t + 1) * kstep;
            const char* a2 = last ? nA : cA + (size_t)(t + 2) * kstep; const char* b2 = last ? nB : cB + (size_t)(t + 2) * kstep;
            const char* a3 = a2 + kstep; const char* b3 = b2 + kstep;
#define PG8_VSEL(h_) unsigned vsel_[2] = {last ? vN[h_][0] : vC[h_][0], last ? vN[h_][1] : vC[h_][1]}
            if (last && has_next) S.a_ready(nxt);
            if constexpr (SP2) {
            PG8_LDB(B0, 0, 0); PG8_LDB(B1, 0, 1); PG8_SCHED; PG8_LDA(At, 0, 0); PG8_STAGE(PG8_SA(1, 1), a1, vC[1]);
            PG8_WAIT_V(8); PG8_WAIT_L(0); PG8_BAR; PG8_MMA(0, 0, At, B0); PG8_MMA(0, 1, At, B1); PG8_BAR; PG8_SCHED;
            PG8_LDA(At, 0, 1); PG8_STAGE(PG8_SB(0, 0), b2, voffB); PG8_STAGE(PG8_SB(0, 1), b2 + hstep, voffB); { PG8_VSEL(0); PG8_STAGE(PG8_SA(0, 0), a2, vsel_); }
            PG8_WAIT_V(8); PG8_WAIT_L(0); PG8_BAR; PG8_MMA(1, 0, At, B0); PG8_MMA(1, 1, At, B1); PG8_BAR; PG8_SCHED;
            PG8_LDB(B0, 1, 0); PG8_LDB(B1, 1, 1); PG8_SCHED; PG8_LDA(At, 1, 0); { PG8_VSEL(1); PG8_STAGE(PG8_SA(0, 1), a2, vsel_); }
            PG8_WAIT_V(8); PG8_WAIT_L(0); PG8_BAR; PG8_MMA(0, 0, At, B0); PG8_MMA(0, 1, At, B1); PG8_BAR; PG8_SCHED;
            PG8_LDA(At, 1, 1); PG8_STAGE(PG8_SB(1, 0), b3, voffB); PG8_STAGE(PG8_SB(1, 1), b3 + hstep, voffB); { PG8_VSEL(0); PG8_STAGE(PG8_SA(1, 0), a3, vsel_); }
            PG8_WAIT_V(8); PG8_WAIT_L(0); PG8_BAR; PG8_MMA(1, 0, At, B0); PG8_MMA(1, 1, At, B1); PG8_BAR; PG8_SCHED;
            } else {
            PG8_LDB(B0, 0, 0); PG8_SCHED; PG8_LDA(At, 0, 0); PG8_STAGE(PG8_SA(1, 1), a1, vC[1]);
            PG8_WAIT_L(8); PG8_BAR; PG8_WAIT_L(0); PG8_MMA(0, 0, At, B0); PG8_BAR; PG8_SCHED;
            PG8_LDB(B1, 0, 1); PG8_STAGE(PG8_SB(0, 0), b2, voffB);
            PG8_BAR; PG8_WAIT_L(0); PG8_MMA(0, 1, At, B1); PG8_BAR;
            PG8_LDA(At, 0, 1); { PG8_VSEL(0); PG8_STAGE(PG8_SA(0, 0), a2, vsel_); }
            PG8_BAR; PG8_WAIT_L(0); PG8_MMA(1, 0, At, B0); PG8_BAR; PG8_SCHED;
            PG8_STAGE(PG8_SB(0, 1), b2 + hstep, voffB);
            PG8_WAIT_V(6); PG8_BAR; PG8_MMA(1, 1, At, B1); PG8_BAR;
            PG8_LDB(B0, 1, 0); PG8_SCHED; PG8_LDA(At, 1, 0); { PG8_VSEL(1); PG8_STAGE(PG8_SA(0, 1), a2, vsel_); }
            PG8_WAIT_L(8); PG8_BAR; PG8_WAIT_L(0); PG8_MMA(0, 0, At, B0); PG8_BAR; PG8_SCHED;
            PG8_LDB(B1, 1, 1); PG8_STAGE(PG8_SB(1, 0), b3, voffB);
            PG8_BAR; PG8_WAIT_L(0); PG8_MMA(0, 1, At, B1); PG8_BAR;
            PG8_LDA(At, 1, 1); { PG8_VSEL(0); PG8_STAGE(PG8_SA(1, 0), a3, vsel_); }
            PG8_BAR; PG8_WAIT_L(0); PG8_MMA(1, 0, At, B0); PG8_BAR; PG8_SCHED;
            PG8_STAGE(PG8_SB(1, 1), b3 + hstep, voffB);
            PG8_WAIT_V(6); PG8_BAR; PG8_MMA(1, 1, At, B1); PG8_BAR;
            }
        }
        asm volatile("s_nop 15\n\ts_nop 15" ::: "memory");
        if constexpr (ALIGN_EPI) { if (wr == 0) PG8_BAR; }
        if constexpr (!Epi::AFTER_DRAIN) { E(acc, cur, wr, wc, fr, fq); S.done(cur); }
        if (!has_next) break;
#pragma unroll
        for (int a = 0; a < 2; ++a)
#pragma unroll
            for (int b = 0; b < 2; ++b)
#pragma unroll
                for (int m = 0; m < 4; ++m)
#pragma unroll
                    for (int n = 0; n < 2; ++n) acc[a][b][m][n] = (f32x4){0.f, 0.f, 0.f, 0.f};
        cur = nxt; cA = nA; cB = nB; ++ui;
#pragma unroll
        for (int h_ = 0; h_ < 2; ++h_)
#pragma unroll
            for (int i_ = 0; i_ < 2; ++i_) vC[h_][i_] = vN[h_][i_];
        if constexpr (ALIGN_EPI) { if (wr == 1) PG8_BAR; }
    }
    PG8_WAIT_V(0);
    if constexpr (!ALIGN_EPI) { if (wr == 0) PG8_BAR; }
    PG8_BAR;
    if constexpr (Epi::AFTER_DRAIN) { E.fused(acc, cur, wr, wc, fr, fq, lds, wid, lane); S.done(cur); }
#undef PG8_GOFF
#undef PG8_SA
#undef PG8_SB
#undef PG8_STAGE
#undef PG8_LDA
#undef PG8_LDB
#undef PG8_MMA
#undef PG8_WAIT_V
#undef PG8_WAIT_L
#undef PG8_BAR
#undef PG8_SCHED
}
}

namespace pg8 {
struct EpiInproj {
    static constexpr bool PERM = true, AFTER_DRAIN = false;
    EpiBf16<0> plain; const float* gq; const float* gk; float c2, eps; PG8_LAS unsigned char* scratch;
    static __device__ __forceinline__ float sum_fq(float x) {
        auto s = __builtin_amdgcn_permlane16_swap(__float_as_uint(x), __float_as_uint(x), false, false); x = __uint_as_float(s[0]) + __uint_as_float(s[1]);
        auto t = __builtin_amdgcn_permlane32_swap(__float_as_uint(x), __float_as_uint(x), false, false); return __uint_as_float(t[0]) + __uint_as_float(t[1]); }
    __device__ __forceinline__ void operator()(const f32x4 (&acc_)[2][2][4][2], const Unit& u, int wr, int wc, int fr, int fq) const {
        if (u.pn < 4) {
            f32x4 (&acc)[2][2][4][2] = const_cast<f32x4 (&)[2][2][4][2]>(acc_);
            const PG8_LAS unsigned* TAB = (const PG8_LAS unsigned*)scratch; PG8_LAS float* EXQ = (PG8_LAS float*)(scratch + 4096);
            const int rl = wr * 64 + fr;
            float ss[2][2][4];
#pragma unroll
            for (int ai = 0; ai < 2; ++ai)
#pragma unroll
                for (int bj = 0; bj < 2; ++bj)
#pragma unroll
                    for (int m = 0; m < 4; ++m) { const f32x4 a = acc[ai][bj][m][0], b = acc[ai][bj][m][1];
                        ss[ai][bj][m] = sum_fq((a[0] * a[0] + a[1] * a[1]) + (a[2] * a[2] + a[3] * a[3]) + (b[0] * b[0] + b[1] * b[1]) + (b[2] * b[2] + b[3] * b[3]));
                        if (fq == 0) EXQ[(rl + ai * HALF + m * 16) * 8 + bj * 4 + wc] = ss[ai][bj][m]; }
            asm volatile("s_waitcnt lgkmcnt(0)" ::: "memory"); __builtin_amdgcn_s_barrier();
#pragma unroll
            for (int ai = 0; ai < 2; ++ai)
#pragma unroll
                for (int bj = 0; bj < 2; ++bj)
#pragma unroll
                    for (int m = 0; m < 4; ++m) ss[ai][bj][m] += EXQ[(rl + ai * HALF + m * 16) * 8 + bj * 4 + (wc ^ 1)];
            const float* gp = (u.pn < 2 ? gq : gk) + (wc & 1) * 32 + 8 * fq; const f32x4 g0 = *(const f32x4*)gp, g1 = *(const f32x4*)(gp + 4);
            const float scl = u.pn < 2 ? c2 : 1.f;
            const bool lat = u.pm < 128, upper = fq >= 2;
#pragma unroll
            for (int ai = 0; ai < 2; ++ai)
#pragma unroll
                for (int m = 0; m < 4; ++m) {
                    const int t = (u.pm * BM + rl + ai * HALF + m * 16) & 4095, pos = (wc & 1) ? (t & 63) : (t >> 6);
                    const u32x4 t0 = *(const PG8_LAS u32x4*)(TAB + pos * 16 + 8 * (fq & 1)), t1 = *(const PG8_LAS u32x4*)(TAB + pos * 16 + 8 * (fq & 1) + 4);
                    float ca0[4], cb0[4], ca1[4], cb1[4];
#pragma unroll
                    for (int j = 0; j < 4; ++j) { const float c0 = __uint_as_float(t0[j] << 16), s0 = __uint_as_float(t0[j] & 0xffff0000u), c1 = __uint_as_float(t1[j] << 16), s1 = __uint_as_float(t1[j] & 0xffff0000u);
                        ca0[j] = upper ? s0 : c0; cb0[j] = upper ? c0 : -s0; ca1[j] = upper ? s1 : c1; cb1[j] = upper ? c1 : -s1; }
#pragma unroll
                    for (int bj = 0; bj < 2; ++bj) {
                        const float rstd = scl * __builtin_amdgcn_rsqf(ss[ai][bj][m] * (1.f / 64.f) + eps);
                        f32x4 v0 = acc[ai][bj][m][0] * rstd * g0, v1 = acc[ai][bj][m][1] * rstd * g1;
                        if (lat) {
#pragma unroll
                            for (int j = 0; j < 4; ++j) {
                                { auto sw = __builtin_amdgcn_permlane32_swap(__float_as_uint(v0[j]), __float_as_uint(v0[j]), false, false); v0[j] = __builtin_fmaf(ca0[j], __uint_as_float(sw[0]), cb0[j] * __uint_as_float(sw[1])); }
                                { auto sw = __builtin_amdgcn_permlane32_swap(__float_as_uint(v1[j]), __float_as_uint(v1[j]), false, false); v1[j] = __builtin_fmaf(ca1[j], __uint_as_float(sw[0]), cb1[j] * __uint_as_float(sw[1])); } } }
                        acc[ai][bj][m][0] = v0; acc[ai][bj][m][1] = v1; } }
        }
        plain(acc_, u, wr, wc, fr, fq);
    }
};
}

namespace pg8 {
struct EpiRes {
    static constexpr bool PERM = true, AFTER_DRAIN = false;
    const float* x_in; float* out; const float* ctx_in; float* xc; const float* modl; int layer;
    __device__ __forceinline__ void operator()(const f32x4 (&acc)[2][2][4][2], const Unit& u, int wr, int wc, int fr, int fq) const {
        const bool lat = u.pm < 128; const int rowt = lat ? u.pm * BM : (u.pm - 128) * BM;
        const int col0 = u.pn * BM + wc * 32 + 8 * fq;
        const float* g = modl + (size_t)(lat ? (u.pm >> 4) : 8) * 6144 + 2048 + col0;
        f32x4 gv[2][2];
#pragma unroll
        for (int bj = 0; bj < 2; ++bj)
#pragma unroll
            for (int n = 0; n < 2; ++n) gv[bj][n] = *(const f32x4*)(g + bj * HALF + n * 4);
#pragma unroll
        for (int ai = 0; ai < 2; ++ai)
#pragma unroll
            for (int m = 0; m < 4; ++m) { const int row = rowt + ai * HALF + wr * 64 + m * 16 + fr;
#pragma unroll
                for (int bj = 0; bj < 2; ++bj) { const int c = col0 + bj * HALF; f32x4 b0, b1;
                    if (!lat) { const float* bp = ctx_in + (size_t)row * 1024 + c; b0 = *(const f32x4*)bp; b1 = *(const f32x4*)(bp + 4); }
                    else if (layer == 0) { const float* bp = x_in + (size_t)row * 1024 + c; b0 = *(const f32x4*)bp; b1 = *(const f32x4*)(bp + 4); }
                    else { const u32x4 w = *(const u32x4*)((const bf16_t*)(out + (size_t)row * 1024) + c);
                        b0 = (f32x4){__uint_as_float(w.x << 16), __uint_as_float(w.x & 0xffff0000u), __uint_as_float(w.y << 16), __uint_as_float(w.y & 0xffff0000u)};
                        b1 = (f32x4){__uint_as_float(w.z << 16), __uint_as_float(w.z & 0xffff0000u), __uint_as_float(w.w << 16), __uint_as_float(w.w & 0xffff0000u)}; }
                    const f32x4 o0 = b0 + gv[bj][0] * acc[ai][bj][m][0], o1 = b1 + gv[bj][1] * acc[ai][bj][m][1];
                    if (lat) { u32x4 w; w.x = cvt_pk_bf16(o0[0], o0[1]); w.y = cvt_pk_bf16(o0[2], o0[3]); w.z = cvt_pk_bf16(o1[0], o1[1]); w.w = cvt_pk_bf16(o1[2], o1[3]); *(u32x4*)((bf16_t*)(out + (size_t)row * 1024) + c) = w; }
                    else { float* op = xc + (size_t)row * 1024 + c; *(f32x4*)op = o0; *(f32x4*)(op + 4) = o1; } } }
    }
};
__device__ __forceinline__ float silu_f(float x) { return x * __builtin_amdgcn_rcpf(1.f + __builtin_amdgcn_exp2f(-1.4426950408889634f * x)); }
struct EpiSwiglu {
    static constexpr bool PERM = true, AFTER_DRAIN = false, FP8OUT = USE_FP8_MOE2 != 0;
    bf16_t* HID;
    __device__ __forceinline__ void operator()(const f32x4 (&acc)[2][2][4][2], const Unit& u, int wr, int wc, int fr, int fq) const {
        const int row0 = u.pm * BM + wr * 64 + fr, hcol0 = (u.pn & 7) * 128 + wc * 32 + 8 * fq;
#pragma unroll
        for (int ai = 0; ai < 2; ++ai)
#pragma unroll
            for (int m = 0; m < 4; ++m) { bf16_t* rowp = HID + (size_t)(row0 + ai * HALF + m * 16) * 1024 + hcol0;
                const f32x4 g0 = acc[ai][0][m][0], g1 = acc[ai][0][m][1], u0 = acc[ai][1][m][0], u1 = acc[ai][1][m][1];
#define H8(gv, uv) __builtin_amdgcn_fmed3f(8.f * silu_f(gv) * (uv), -448.f, 448.f)
                if (FP8OUT) { int p0 = __builtin_amdgcn_cvt_pk_fp8_f32(H8(g0[0], u0[0]), H8(g0[1], u0[1]), 0, false); p0 = __builtin_amdgcn_cvt_pk_fp8_f32(H8(g0[2], u0[2]), H8(g0[3], u0[3]), p0, true);
                    int p1 = __builtin_amdgcn_cvt_pk_fp8_f32(H8(g1[0], u1[0]), H8(g1[1], u1[1]), 0, false); p1 = __builtin_amdgcn_cvt_pk_fp8_f32(H8(g1[2], u1[2]), H8(g1[3], u1[3]), p1, true);
                    typedef unsigned u32x2_ __attribute__((ext_vector_type(2))); *(u32x2_*)((unsigned char*)HID + (size_t)(row0 + ai * HALF + m * 16) * 1024 + hcol0) = (u32x2_){(unsigned)p0, (unsigned)p1}; }
                else { u32x4 w; w.x = cvt_pk_bf16(silu_f(g0[0]) * u0[0], silu_f(g0[1]) * u0[1]); w.y = cvt_pk_bf16(silu_f(g0[2]) * u0[2], silu_f(g0[3]) * u0[3]);
                w.z = cvt_pk_bf16(silu_f(g1[0]) * u1[0], silu_f(g1[1]) * u1[1]); w.w = cvt_pk_bf16(silu_f(g1[2]) * u1[2], silu_f(g1[3]) * u1[3]);
                *(u32x4*)rowp = w; } }
    }
};
struct EpiBf16Grp {
    static constexpr bool PERM = true, AFTER_DRAIN = false;
    bf16_t* O; int ldc, ncolt;
    __device__ __forceinline__ void operator()(const f32x4 (&acc)[2][2][4][2], const Unit& u, int wr, int wc, int fr, int fq) const {
        const int row0 = u.pm * BM + wr * 64 + fr, col0 = (u.pn % ncolt) * BM + wc * 32 + 8 * fq;
#pragma unroll
        for (int ai = 0; ai < 2; ++ai)
#pragma unroll
            for (int m = 0; m < 4; ++m) { bf16_t* rowp = O + (size_t)(row0 + ai * HALF + m * 16) * ldc + col0;
#pragma unroll
                for (int bj = 0; bj < 2; ++bj) { const f32x4 v0 = acc[ai][bj][m][0], v1 = acc[ai][bj][m][1];
                    u32x4 w; w.x = cvt_pk_bf16(v0[0], v0[1]); w.y = cvt_pk_bf16(v0[2], v0[3]); w.z = cvt_pk_bf16(v1[0], v1[1]); w.w = cvt_pk_bf16(v1[2], v1[3]);
                    *(u32x4*)(rowp + bj * HALF) = w; } }
    }
};
struct GroupOrder {
    int nMe, nNe, G, c;
    __device__ bool next(int i, Unit& u) const {
        const int vc = (G % 8 == 0) ? (c % 8) * (G / 8) + c / 8 : c;
        const int L = i * G + vc, per = nMe * nNe; if (L >= 16 * per) return false;
        const int e = L / per, rem = L % per; u.pm = e * 17 + rem % nMe; u.pn = e * nNe + rem / nMe; return true;
    }
    __device__ __forceinline__ void a_ready(const Unit&) const {}
    __device__ __forceinline__ void done(const Unit&) const {}
};
}

DEV float bf2f(unsigned u) { return __uint_as_float(u << 16); }
DEV unsigned f2bf(float f) { unsigned u = __float_as_uint(f); return (u + 0x7fffu + ((u >> 16) & 1u)) >> 16; }
typedef float f32x2_t __attribute__((ext_vector_type(2)));
DEV unsigned pk2(float lo, float hi) { f32x2_t v = {lo, hi}; bf16x2_t b = __builtin_convertvector(v, bf16x2_t); return __builtin_bit_cast(unsigned, b); }
DEV float clamp8(float x) { return __builtin_amdgcn_fmed3f(x, -448.f, 448.f); }
DEV unsigned pk_fp8x4(float a0, float a1, float a2, float a3) { int p = __builtin_amdgcn_cvt_pk_fp8_f32(clamp8(a0), clamp8(a1), 0, false); p = __builtin_amdgcn_cvt_pk_fp8_f32(clamp8(a2), clamp8(a3), p, true); return (unsigned)p; }
template <int CTRL> DEV float dppf(float x) { return __builtin_bit_cast(float, __builtin_amdgcn_mov_dpp(__builtin_bit_cast(int, x), CTRL, 0xf, 0xf, true)); }
constexpr int DPP_X1 = 0xB1, DPP_X2 = 0x4E, DPP_X3 = 0x1B, DPP_X7 = 0x141, DPP_X8 = 0x128;
DEV float swap16_sum(float x, float y) { auto s = __builtin_amdgcn_permlane16_swap(__float_as_uint(x), __float_as_uint(y), false, false); return __uint_as_float(s[0]) + __uint_as_float(s[1]); }
DEV float swap32_sum(float x, float y) { auto s = __builtin_amdgcn_permlane32_swap(__float_as_uint(x), __float_as_uint(y), false, false); return __uint_as_float(s[0]) + __uint_as_float(s[1]); }
DEV float swap16_max(float x) { auto s = __builtin_amdgcn_permlane16_swap(__float_as_uint(x), __float_as_uint(x), false, false); return fmaxf(__uint_as_float(s[0]), __uint_as_float(s[1])); }
DEV float swap32_max(float x) { auto s = __builtin_amdgcn_permlane32_swap(__float_as_uint(x), __float_as_uint(x), false, false); return fmaxf(__uint_as_float(s[0]), __uint_as_float(s[1])); }
DEV float xor32_get(float x, bool upper) { auto s = __builtin_amdgcn_permlane32_swap(__float_as_uint(x), __float_as_uint(x), false, false); return __uint_as_float(upper ? s[0] : s[1]); }
DEV float row_sum4(float v) { v += dppf<DPP_X1>(v); v += dppf<DPP_X2>(v); return v; }
DEV float row_sum16(float v) { v = row_sum4(v); v += dppf<DPP_X7>(v); v += dppf<DPP_X8>(v); return v; }
DEV float wave_sum(float v) { v = row_sum16(v); v = swap16_sum(v, v); return swap32_sum(v, v); }
DEV void lds_barrier() { asm volatile("s_waitcnt lgkmcnt(0)\n\ts_barrier" ::: "memory"); }
DEV float sigm(float x) { return 1.f / (1.f + expf(-x)); }
DEV float fsigm(float x) { return __builtin_amdgcn_rcpf(1.f + __builtin_amdgcn_exp2f(-1.4426950408889634f * x)); }
DEV float gelu_tanh(float x) { const float u = 0.7978845608028654f * (x + 0.044715f * x * x * x); return x * fsigm(2.f * u); }
DEV float siluf(float x) { return x / (1.f + expf(-x)); }
DEV float fsiluf(float x) { return x * fsigm(x); }

DEV void ld4bf(const bf16_t* p, float* v) { const u32x2 w = *(const u32x2*)p; v[0] = bf2f(w.x & 0xffffu); v[1] = bf2f(w.x >> 16); v[2] = bf2f(w.y & 0xffffu); v[3] = bf2f(w.y >> 16); }
DEV void st4bf(bf16_t* p, const float* v) { u32x2 w; w.x = pk2(v[0], v[1]); w.y = pk2(v[2], v[3]); *(u32x2*)p = w; }
DEV bf16_t* resrow(const Args& a, int r) { return (bf16_t*)(a.out + (size_t)r * D); }
DEV const float* modp(const Args& a, int l, int rowsel, int chunk) { return (const float*)(a.ws + WS_MOD) + ((size_t)(l * 9 + rowsel) * 6 + chunk) * 1024; }
DEV int modrow(int r) { return r < ML ? (r >> 12) : 8; }
DEV float lam_init(int l) { return l == 0 ? 0.2f : (0.8f - 0.6f * 0.7408182206817179f); }

DEV void p0_mod(const Args& a, float* lds) {
    const int tid = ltid(), lane = tid & 63, wave = tid >> 6;
    const float* c = a.in[1]; const float* cc = a.in[3];
    for (int i = tid; i < 9 * 1024; i += NTHREADS) { const float v = i < 8192 ? c[i] : cc[i - 8192]; lds[i] = siluf(v); }
    __syncthreads();
    float* red = lds + 9 * 1024;
    float* MOD = (float*)(a.ws + WS_MOD);
    for (int item = blockIdx.x; item < 192; item += gridDim.x) {
        const int l = item / 96, cgp = item % 96, col = cgp * 64 + lane;
        const float* w = a.in[4] + (size_t)l * 1024 * 6144 + col;
        float acc[9];
#pragma unroll
        for (int r = 0; r < 9; ++r) acc[r] = 0.f;
#pragma unroll 16
        for (int k = wave * 128; k < wave * 128 + 128; ++k) {
            const float wv = w[(size_t)k * 6144];
#pragma unroll
            for (int r = 0; r < 9; ++r) acc[r] += lds[r * 1024 + k] * wv;
        }
#pragma unroll
        for (int r = 0; r < 9; ++r) red[(wave * 9 + r) * 64 + lane] = acc[r];
        __syncthreads();
        for (int o = tid; o < 576; o += NTHREADS) {
            const int r = o >> 6, cl = o & 63; float s = 0.f;
#pragma unroll
            for (int w8 = 0; w8 < 8; ++w8) s += red[(w8 * 9 + r) * 64 + cl];
            MOD[(size_t)(l * 9 + r) * 6144 + cgp * 64 + cl] = s + a.in[5][l * 6144 + cgp * 64 + cl];
        }
        __syncthreads();
    }
}

template <int MODE, bool COMB = true> DEV void p1_norm(const Args& a) {
    const int tid = ltid(), lane = tid & 63, wave = tid >> 6;
    const int gw = blockIdx.x * NWAVES + wave, NGW = gridDim.x * NWAVES;
    const int l = MODE == 0 ? 0 : 1;
    const int lp = MODE == 2 ? 1 : 0;
    bf16_t* XN = (bf16_t*)(a.ws + WS_XN);
    const int* SEL = (const int*)(a.ws + WS_SEL); const float* AFF = (const float*)(a.ws + WS_AFF); const bf16_t* Y2 = (const bf16_t*)(a.ws + WS_Y2);
    float* XC = (float*)(a.ws + WS_XC);
    const int nrows = MODE == 2 ? ML : M;
    constexpr bool CMB = (MODE != 0) && COMB;
    f32x4 v[4], vn[4]; int mysel = -1, nsel = -1;
#define P1_SRC(rr) (MODE == 0 ? ((rr) < ML ? a.in[0] + (size_t)(rr) * D : a.in[2] + (size_t)((rr) - ML) * D) : ((rr) < ML ? (const float*)a.out + (size_t)(rr) * D : (const float*)XC + (size_t)((rr) - ML) * D))
#define P1_LOAD(dst, sel, rr) do { const int r_ = (rr); \
        if (MODE != 0 && r_ < ML) { const bf16_t* s_ = resrow(a, r_); _Pragma("unroll") for (int j = 0; j < 4; ++j) { float t_[4]; ld4bf(s_ + 256 * j + 4 * lane, t_); dst[j] = (f32x4){t_[0], t_[1], t_[2], t_[3]}; } } \
        else { const float* s_ = P1_SRC(r_); _Pragma("unroll") for (int j = 0; j < 4; ++j) dst[j] = *(const f32x4*)(s_ + 256 * j + 4 * lane); } \
        if (CMB) sel = SEL[(size_t)r_ * 16 + (lane & 15)]; } while (0)
    if (gw < nrows) P1_LOAD(v, mysel, gw);
    for (int r = gw; r < nrows; r += NGW) {
        if (r + NGW < nrows) P1_LOAD(vn, nsel, r + NGW);
        if (CMB) {
            float* dst = r < ML ? a.out + (size_t)r * D : XC + (size_t)(r - ML) * D;
            unsigned m = (unsigned)(__ballot(mysel >= 0) & 0xffffull);
            f32x4 acc[4];
#pragma unroll
            for (int j = 0; j < 4; ++j) acc[j] = (f32x4){0.f, 0.f, 0.f, 0.f};
            while (m) {
                int ee[4]; u32x2 w[4][4]; float af[4];
#pragma unroll
                for (int i = 0; i < 4; ++i) { if (m) { ee[i] = __builtin_ctz(m); m &= m - 1u; } else ee[i] = -1; }
#pragma unroll
                for (int i = 0; i < 4; ++i) if (ee[i] >= 0) { const int s = __builtin_amdgcn_readlane(mysel, ee[i]); af[i] = AFF[ee[i] * SLOTS + s]; const bf16_t* yr = Y2 + ((size_t)ee[i] * SLOTS + s) * D;
#pragma unroll
                    for (int j = 0; j < 4; ++j) w[i][j] = *(const u32x2*)(yr + 256 * j + 4 * lane); }
#pragma unroll
                for (int i = 0; i < 4; ++i) if (ee[i] >= 0) {
#pragma unroll
                    for (int j = 0; j < 4; ++j) { acc[j].x += af[i] * bf2f(w[i][j].x & 0xffffu); acc[j].y += af[i] * bf2f(w[i][j].x >> 16); acc[j].z += af[i] * bf2f(w[i][j].y & 0xffffu); acc[j].w += af[i] * bf2f(w[i][j].y >> 16); } }
            }
            const float* g2 = modp(a, lp, modrow(r), 5);
#pragma unroll
            for (int j = 0; j < 4; ++j) { const f32x4 g = *(const f32x4*)(g2 + 256 * j + 4 * lane); v[j] += g * acc[j];
                if (MODE == 1 && r < ML) { float t_[4] = {v[j].x, v[j].y, v[j].z, v[j].w}; st4bf(resrow(a, r) + 256 * j + 4 * lane, t_); }
                else *(f32x4*)(dst + 256 * j + 4 * lane) = v[j]; }
        }
        if (MODE != 2) {
            float ss = 0.f;
#pragma unroll
            for (int j = 0; j < 4; ++j) ss += (v[j].x * v[j].x + v[j].y * v[j].y) + (v[j].z * v[j].z + v[j].w * v[j].w);
            const float rstd = __builtin_amdgcn_rsqf(wave_sum(ss) * (1.f / D) + EPS);
            const float* g = a.in[6] + l * D; const float* sh = modp(a, l, modrow(r), 0); const float* sc = modp(a, l, modrow(r), 1);
#pragma unroll
            for (int j = 0; j < 4; ++j) {
                const int c0 = 256 * j + 4 * lane; const f32x4 gg = *(const f32x4*)(g + c0), s1 = *(const f32x4*)(sc + c0), s0 = *(const f32x4*)(sh + c0);
                const f32x4 y = v[j] * rstd * gg * (1.f + s1) + s0; float t[4] = {y.x, y.y, y.z, y.w}; st4bf(XN + (size_t)r * D + c0, t);
            }
        }
#pragma unroll
        for (int j = 0; j < 4; ++j) v[j] = vn[j];
        mysel = nsel;
    }
#undef P1_SRC
#undef P1_LOAD
}

DEV void transpose_item(const float* W, int N, int K, bf16_t* WT, int k0, int n0, int drow0, float* scr, int lane) {
    float t32[32];
#pragma unroll
    for (int i = 0; i < 32; ++i) t32[i] = W[(size_t)(k0 + 2 * i + (lane >> 5)) * N + n0 + (lane & 31)];
#pragma unroll
    for (int i = 0; i < 32; ++i) scr[(2 * i + (lane >> 5)) * 33 + (lane & 31)] = t32[i];
    const int c = lane & 7;
#pragma unroll
    for (int j = 0; j < 4; ++j) { const int n = (lane >> 3) + 8 * j; const float* s = scr + (8 * c) * 33 + n;
        u32x4 o; o.x = pk2(s[0 * 33], s[1 * 33]); o.y = pk2(s[2 * 33], s[3 * 33]); o.z = pk2(s[4 * 33], s[5 * 33]); o.w = pk2(s[6 * 33], s[7 * 33]);
        *(u32x4*)(WT + (size_t)(drow0 + n) * K + k0 + 8 * c) = o; }
}
DEV void transpose_item8(const float* W, int N, unsigned char* WT8, int k0, int n0, int drow0, float* scr, int lane) {
    float t32[32];
#pragma unroll
    for (int i = 0; i < 32; ++i) t32[i] = W[(size_t)(k0 + 2 * i + (lane >> 5)) * N + n0 + (lane & 31)];
#pragma unroll
    for (int i = 0; i < 32; ++i) scr[(2 * i + (lane >> 5)) * 33 + (lane & 31)] = t32[i];
    const int c = lane & 7;
#pragma unroll
    for (int j = 0; j < 4; ++j) { const int n = (lane >> 3) + 8 * j; const float* s = scr + (8 * c) * 33 + n;
        u32x2 o; o.x = pk_fp8x4(s[0 * 33] * 32.f, s[1 * 33] * 32.f, s[2 * 33] * 32.f, s[3 * 33] * 32.f); o.y = pk_fp8x4(s[4 * 33] * 32.f, s[5 * 33] * 32.f, s[6 * 33] * 32.f, s[7 * 33] * 32.f);
        *(u32x2*)(WT8 + (size_t)(drow0 + n) * 1024 + k0 + 8 * c) = o; }
}
DEV void p1_weights(const Args& a, int l, float* lds) {
    const int tid = ltid(), lane = tid & 63, wave = tid >> 6;
    float* scr = lds + wave * (64 * 33);
    const int gw = blockIdx.x * NWAVES + wave, NGW = gridDim.x * NWAVES;
    bf16_t* WT = (bf16_t*)(a.ws + WS_WT);
    for (int i = blockIdx.x * NTHREADS + tid; i < 8192; i += gridDim.x * NTHREADS) {
        const int ln = i & 63, ks = (i >> 6) & 3, nt = (i >> 8) & 1, mat = i >> 9;
        const float* p = a.in[18] + ((size_t)(l * 16 + mat) * 64 + 16 * ks + 8 * (ln >> 5)) * 64 + nt * 32 + (ln & 31);
        constexpr float NL = -1.4426950408889634f;
        u32x4 x; x.x = pk2(NL * p[0], NL * p[64]); x.y = pk2(NL * p[128], NL * p[192]); x.z = pk2(NL * p[256], NL * p[320]); x.w = pk2(NL * p[384], NL * p[448]);
        *(u32x4*)(a.ws + WS_LRUW + (size_t)i * 16) = x; }
    constexpr int I_IN = 16 * 96, I_OUT = 16 * 32, I_E = 16 * 32;
    constexpr int NITEMS = I_IN + I_OUT + 16 * 3 * I_E;
    for (int it = gw; it < NITEMS; it += NGW) {
        int r = it;
        if (r < I_IN) { const int kb = r / 96, nb = r % 96; transpose_item(a.in[8] + (size_t)l * 1024 * 3072, 3072, 1024, WT + WT_IN / 2, 64 * kb, 32 * nb, 32 * nb, scr, lane); continue; } r -= I_IN;
        if (r < I_OUT) { const int kb = r / 32, nb = r % 32; transpose_item(a.in[9] + (size_t)l * 1024 * 1024, 1024, 1024, WT + WT_OUT / 2, 64 * kb, 32 * nb, 32 * nb, scr, lane); continue; } r -= I_OUT;
        const int e = r / (3 * I_E), q = (r / I_E) % 3, rr = r % I_E, kb = rr / 32, nb = rr % 32, n0 = 32 * nb;
        const size_t eoff = ((size_t)l * 16 + e) * 1024 * 1024;
        if (q < 2 && USE_FP8_MOE1) transpose_item8((q == 0 ? a.in[23] : a.in[24]) + eoff, 1024, (unsigned char*)(WT + WT_GU / 2) + (size_t)e * 2048 * 1024, 64 * kb, n0, (n0 >> 7) * 256 + q * 128 + (n0 & 127), scr, lane);
        else if (q == 0) transpose_item(a.in[23] + eoff, 1024, 1024, WT + WT_GU / 2 + (size_t)e * 2048 * 1024, 64 * kb, n0, (n0 >> 7) * 256 + (n0 & 127), scr, lane);
        else if (q == 1) transpose_item(a.in[24] + eoff, 1024, 1024, WT + WT_GU / 2 + (size_t)e * 2048 * 1024, 64 * kb, n0, (n0 >> 7) * 256 + 128 + (n0 & 127), scr, lane);
        else if (USE_FP8_MOE2) transpose_item8(a.in[25] + eoff, 1024, (unsigned char*)(WT + WT_DN / 2) + (size_t)e * 1024 * 1024, 64 * kb, n0, n0, scr, lane);
        else transpose_item(a.in[25] + eoff, 1024, 1024, WT + WT_DN / 2 + (size_t)e * 1024 * 1024, 64 * kb, n0, n0, scr, lane);
    }
}

template <bool DUAL, class EPI> DEV void sgemm_tile(const bf16_t* A, const float* B, const float* B2, int ldb, float* lds, EPI epi) {
    const int tid = ltid(), tx = tid & 15, ty = tid >> 4;
    float* As = lds;
    float* Bs = lds + 16 * 132;
    float* Bs2 = Bs + 16 * 64;
    float acc[4][4], acc2[4][4];
#pragma unroll
    for (int i = 0; i < 4; ++i)
#pragma unroll
        for (int j = 0; j < 4; ++j) { acc[i][j] = 0.f; acc2[i][j] = 0.f; }
    for (int k0 = 0; k0 < 1024; k0 += 16) {
        { const int r = tid >> 2, kq = (tid & 3) * 4; float t[4]; ld4bf(A + (size_t)r * 1024 + k0 + kq, t);
#pragma unroll
            for (int j = 0; j < 4; ++j) As[(kq + j) * 132 + r] = t[j]; }
        if (tid < 256) { const int kk = tid >> 4, c4 = (tid & 15) * 4; *(f32x4*)(Bs + kk * 64 + c4) = *(const f32x4*)(B + (size_t)(k0 + kk) * ldb + c4); }
        else if (DUAL) { const int t2 = tid - 256, kk = t2 >> 4, c4 = (t2 & 15) * 4; *(f32x4*)(Bs2 + kk * 64 + c4) = *(const f32x4*)(B2 + (size_t)(k0 + kk) * ldb + c4); }
        __syncthreads();
#pragma unroll
        for (int kk = 0; kk < 16; ++kk) {
            const f32x4 av = *(const f32x4*)(As + kk * 132 + ty * 4), bv = *(const f32x4*)(Bs + kk * 64 + tx * 4);
            const float aa[4] = {av.x, av.y, av.z, av.w}, bb[4] = {bv.x, bv.y, bv.z, bv.w};
#pragma unroll
            for (int i = 0; i < 4; ++i)
#pragma unroll
                for (int j = 0; j < 4; ++j) acc[i][j] += aa[i] * bb[j];
            if (DUAL) { const f32x4 b2 = *(const f32x4*)(Bs2 + kk * 64 + tx * 4); const float b2b[4] = {b2.x, b2.y, b2.z, b2.w};
#pragma unroll
                for (int i = 0; i < 4; ++i)
#pragma unroll
                    for (int j = 0; j < 4; ++j) acc2[i][j] += aa[i] * b2b[j]; }
        }
        __syncthreads();
    }
#pragma unroll
    for (int i = 0; i < 4; ++i)
#pragma unroll
        for (int j = 0; j < 4; ++j) epi(ty * 4 + i, tx * 4 + j, acc[i][j], acc2[i][j]);
}

DEV void p2_inproj_simple(const Args& a, int l, float* lds) {
    const bf16_t* XN = (const bf16_t*)(a.ws + WS_XN); bf16_t* Y = (bf16_t*)(a.ws + WS_Y);
    const float* W = a.in[8] + (size_t)l * 1024 * 3072;
    const int ntm = M / 128, ntn = 3072 / 64;
    for (int it = blockIdx.x; it < ntm * ntn; it += gridDim.x) {
        const int tm = it / ntn, tn = it % ntn, row0 = tm * 128, col0 = tn * 64;
        sgemm_tile<false>(XN + (size_t)row0 * 1024, W + col0, nullptr, 3072, lds, [&](int i, int j, float v, float) {
            const int col = col0 + j; Y[(size_t)(col >> 8) * YARR + (size_t)(row0 + i) * 256 + (col & 255)] = (bf16_t)f2bf(v); });
    }
}

DEV void p6_outproj_simple(const Args& a, int l, float* lds) {
    const bf16_t* MIX = (const bf16_t*)(a.ws + WS_MIX); const float* W = a.in[9] + (size_t)l * 1024 * 1024;
    const int nrows = l == 0 ? M : ML, ntm = nrows / 128, ntn = 1024 / 64;
    for (int it = blockIdx.x; it < ntm * ntn; it += gridDim.x) {
        const int tm = it / ntn, tn = it % ntn, row0 = tm * 128, col0 = tn * 64;
        const float* g1 = modp(a, l, modrow(row0), 2);
        const float* base; float* dst;
        if (row0 < ML) { base = (l == 0 ? a.in[0] : a.out) + (size_t)row0 * D; dst = a.out + (size_t)row0 * D; }
        else { base = a.in[2] + (size_t)(row0 - ML) * D; dst = (float*)(a.ws + WS_XC) + (size_t)(row0 - ML) * D; }
        sgemm_tile<false>(MIX + (size_t)row0 * 1024, W + col0, nullptr, 1024, lds, [&](int i, int j, float v, float) {
            const int col = col0 + j; dst[(size_t)i * D + col] = base[(size_t)i * D + col] + g1[col] * v; });
    }
}

DEV void p9_moe1_simple(const Args& a, int l, float* lds) {
    const bf16_t* XG = (const bf16_t*)(a.ws + WS_XG); bf16_t* HID = (bf16_t*)(a.ws + WS_HID);
    const int rows_e = l == 0 ? SLOTS : NB * CAPL, ntm = rows_e / 128, ntn = 1024 / 64;
    for (int it = blockIdx.x; it < 16 * ntm * ntn; it += gridDim.x) {
        const int e = it / (ntm * ntn), rem = it % (ntm * ntn), tm = rem / ntn, tn = rem % ntn, row0 = tm * 128, col0 = tn * 64;
        const size_t eoff = ((size_t)l * 16 + e) * 1024 * 1024;
        bf16_t* hp = HID + ((size_t)e * SLOTS + row0) * 1024;
        sgemm_tile<true>(XG + ((size_t)e * SLOTS + row0) * 1024, a.in[23] + eoff + col0, a.in[24] + eoff + col0, 1024, lds, [&](int i, int j, float g, float u) {
            hp[(size_t)i * 1024 + col0 + j] = (bf16_t)f2bf(siluf(g) * u); });
    }
}

DEV void p10_moe2_simple(const Args& a, int l, float* lds) {
    const bf16_t* HID = (const bf16_t*)(a.ws + WS_HID); bf16_t* Y2 = (bf16_t*)(a.ws + WS_Y2);
    const int rows_e = l == 0 ? SLOTS : NB * CAPL, ntm = rows_e / 128, ntn = 1024 / 64;
    for (int it = blockIdx.x; it < 16 * ntm * ntn; it += gridDim.x) {
        const int e = it / (ntm * ntn), rem = it % (ntm * ntn), tm = rem / ntn, tn = rem % ntn, row0 = tm * 128, col0 = tn * 64;
        const size_t eoff = ((size_t)l * 16 + e) * 1024 * 1024;
        bf16_t* yp = Y2 + ((size_t)e * SLOTS + row0) * 1024;
        sgemm_tile<false>(HID + ((size_t)e * SLOTS + row0) * 1024, a.in[25] + eoff + col0, nullptr, 1024, lds, [&](int i, int j, float v, float) {
            yp[(size_t)i * 1024 + col0 + j] = (bf16_t)f2bf(v); });
    }
}


#define LDS3(p) ((__attribute__((address_space(3))) unsigned char*)(p))
DEV void p2_inproj_mfma(const Args& a, int l, unsigned char* lds_raw) {
    { unsigned* TAB = (unsigned*)(lds_raw + pg8::STAGE_BYTES);
      for (int i = ltid(); i < 1024; i += NTHREADS) { const float inv = exp2f(-(float)(i & 15) * (13.287712379549449f / 16.f)); float sn, cs; sincosf((float)(i >> 4) * inv, &sn, &cs); TAB[i] = f2bf(cs) | (f2bf(sn) << 16); }
      __syncthreads(); }
    pg8::Gemm g{(const bf16_t*)(a.ws + WS_XN), (const bf16_t*)(a.ws + WS_WT + WT_IN), M, 3072, 1024}; pg8::StaticOrder S; S.init(M, 3072, gridDim.x, blockIdx.x);
    pg8::EpiInproj E{{(bf16_t*)(a.ws + WS_Y), 256, nullptr, 256, YARR, 1.f}, a.in[10] + l * 64, a.in[11] + l * 64, C2, EPS, LDS3(lds_raw) + pg8::STAGE_BYTES};
    pg8::gemm_phase<pg8::EpiInproj, pg8::StaticOrder, true, true>(LDS3(lds_raw), g, S, E);
}
DEV void p6_outproj_mfma(const Args& a, int l, unsigned char* lds_raw) {
    const int nrows = l == 0 ? M : ML;
    pg8::Gemm g{(const bf16_t*)(a.ws + WS_MIX), (const bf16_t*)(a.ws + WS_WT + WT_OUT), nrows, 1024, 1024}; pg8::StaticOrder S; S.init(nrows, 1024, gridDim.x, blockIdx.x);
    pg8::EpiRes E{a.in[0], a.out, a.in[2], (float*)(a.ws + WS_XC), (const float*)(a.ws + WS_MOD) + (size_t)l * 9 * 6144, l};
    pg8::gemm_phase<pg8::EpiRes, pg8::StaticOrder, true, true>(LDS3(lds_raw), g, S, E);
}
DEV void p9_moe1_mfma(const Args& a, int l, unsigned char* lds_raw) {
    pg8::Gemm g{(const bf16_t*)(a.ws + WS_XN), (const bf16_t*)(a.ws + WS_WT + WT_GU), 16 * SLOTS, 16 * 2048, 512};
    pg8::GroupOrder S{l == 0 ? 17 : 16, 8, (int)gridDim.x, (int)blockIdx.x};
    pg8::EpiSwiglu E{(bf16_t*)(a.ws + WS_HID)};
    pg8::gemm_phase_gather<pg8::EpiSwiglu, pg8::GroupOrder, true, true>(LDS3(lds_raw), g, (const int*)(a.ws + WS_IDX), S, E);
}
DEV void p10_moe2_mfma(const Args& a, int l, unsigned char* lds_raw) {
    pg8::Gemm g{(const bf16_t*)(a.ws + WS_HID), (const bf16_t*)(a.ws + WS_WT + WT_DN), 16 * SLOTS, 16 * 1024, USE_FP8_MOE2 ? 512 : 1024};
    pg8::GroupOrder S{l == 0 ? 17 : 16, 4, (int)gridDim.x, (int)blockIdx.x};
    pg8::EpiBf16Grp E{(bf16_t*)(a.ws + WS_Y2), 1024, 4};
    if (USE_FP8_MOE2) pg8::gemm_phase_fp8<pg8::EpiBf16Grp, pg8::GroupOrder, true>(LDS3(lds_raw), g, S, E, 122, 124);
    else pg8::gemm_phase<pg8::EpiBf16Grp, pg8::GroupOrder, true, true>(LDS3(lds_raw), g, S, E);
}
DEV void p3_qknorm(const Args& a, int l, float* ldsf) {
    const int tid = ltid(), lane = tid & 63, wave = tid >> 6;
    const int gw = blockIdx.x * NWAVES + wave, NGW = gridDim.x * NWAVES;
    bf16_t* Y = (bf16_t*)(a.ws + WS_Y);
    const int d0 = (lane & 15) * 4;
    float* TC = ldsf; float* TS = ldsf + 1024;
    for (int i = tid; i < 1024; i += NTHREADS) { const float inv = exp2f(-(float)(i & 15) * (13.287712379549449f / 16.f)); float sn, cs; sincosf((float)(i >> 4) * inv, &sn, &cs); TC[i] = cs; TS[i] = sn; }
    __syncthreads();
    u32x2 w[4], wn[4];
#define QK_LOAD(dst, rr) do { _Pragma("unroll") for (int arr = 0; arr < 4; ++arr) dst[arr] = *(const u32x2*)(Y + (size_t)arr * YARR + (size_t)(rr) * 256 + lane * 4); } while (0)
    if (gw < M) QK_LOAD(w, gw);
    float gq[4], gk[4];
#pragma unroll
    for (int j = 0; j < 4; ++j) { gq[j] = a.in[10][l * 64 + d0 + j]; gk[j] = a.in[11][l * 64 + d0 + j]; }
    for (int r = gw; r < M; r += NGW) {
        if (r + NGW < M) QK_LOAD(wn, r + NGW);
        f32x4 c4 = (f32x4){1.f, 1.f, 1.f, 1.f}, s4 = (f32x4){0.f, 0.f, 0.f, 0.f};
        if (r < ML) { const int t = r & 4095, pos = ((lane & 15) < 8) ? (t >> 6) : (t & 63); c4 = *(const f32x4*)(TC + pos * 16 + (d0 & 15)); s4 = *(const f32x4*)(TS + pos * 16 + (d0 & 15)); }
        const float cs[4] = {c4.x, c4.y, c4.z, c4.w}, sn[4] = {s4.x, s4.y, s4.z, s4.w};
        const bool first = (lane & 4) == 0;
#pragma unroll
        for (int arr = 0; arr < 4; ++arr) {
            float v[4] = {bf2f(w[arr].x & 0xffffu), bf2f(w[arr].x >> 16), bf2f(w[arr].y & 0xffffu), bf2f(w[arr].y >> 16)};
            float ss = v[0] * v[0] + v[1] * v[1] + v[2] * v[2] + v[3] * v[3];
            ss = row_sum16(ss);
            const float rstd = 1.0f / sqrtf(ss * (1.f / 64.f) + EPS) * (arr < 2 ? C2 : 1.f);
#pragma unroll
            for (int j = 0; j < 4; ++j) v[j] *= rstd * (arr < 2 ? gq[j] : gk[j]);
            if (r < ML) {
#pragma unroll
                for (int j = 0; j < 4; ++j) { const float pv = dppf<DPP_X3>(dppf<DPP_X7>(v[j])); v[j] = first ? (v[j] * cs[j] - pv * sn[j]) : (pv * sn[j] + v[j] * cs[j]); }
            }
            st4bf(Y + (size_t)arr * YARR + (size_t)r * 256 + lane * 4, v);
        }
#pragma unroll
        for (int arr = 0; arr < 4; ++arr) w[arr] = wn[arr];
    }
#undef QK_LOAD
}

DEV int ret_row0(int b, int c) { return c < 2 ? ML + b * 256 + c * 128 : b * 4096 + (c - 2) * 128; }
DEV void p3_retU(const Args& a, int l, float* lds) {
    const int tid = ltid();
    float* Ks = lds; float* Vs = lds + 128 * 64;
    const bf16_t* Y = (const bf16_t*)(a.ws + WS_Y); float* RS = (float*)(a.ws + WS_RETS);
    for (int it = blockIdx.x; it < NB * 4 * RET_CH; it += gridDim.x) {
        const int c = it % RET_CH, bh = it / RET_CH, h = bh & 3, b = bh >> 2, row0 = ret_row0(b, c);
        for (int i = tid; i < 128 * 16; i += NTHREADS) { const int m = i >> 4, q4 = (i & 15) * 4;
            ld4bf(Y + 7 * YARR + (size_t)(row0 + m) * 256 + h * 64 + q4, Ks + m * 64 + q4); ld4bf(Y + 8 * YARR + (size_t)(row0 + m) * 256 + h * 64 + q4, Vs + m * 64 + q4); }
        __syncthreads();
        const float lgf = a.in[14][l * 8 + h], lgb = a.in[14][l * 8 + 4 + h];
        const int d = tid >> 3, v0 = (tid & 7) * 8;
        float af[8], ab[8];
#pragma unroll
        for (int j = 0; j < 8; ++j) { af[j] = 0.f; ab[j] = 0.f; }
        for (int m = 0; m < 128; ++m) {
            const float kk = Ks[m * 64 + d] * 0.125f, wf = kk * expf(lgf * (float)(127 - m)), wb = kk * expf(lgb * (float)m);
#pragma unroll
            for (int j = 0; j < 8; ++j) { const float vv = Vs[m * 64 + v0 + j]; af[j] += wf * vv; ab[j] += wb * vv; }
        }
        float* o = RS + ((size_t)(bh * RET_CH + c) * 2) * 4096 + d * 64 + v0;
#pragma unroll
        for (int j = 0; j < 8; ++j) { o[j] = af[j]; o[4096 + j] = ab[j]; }
        __syncthreads();
    }
}

constexpr int UBP_ = 132;
constexpr float LOG2E_F = 1.4426950408889634f;
DEV void lru_fetch(const Args& a, int b, int c, int tid, u32x2 (&pre)[5]) {
    const bf16_t* YX = (const bf16_t*)(a.ws + WS_Y) + 10 * YARR;
    const int seqlen = c < 8 ? 256 : 4096, t0 = c < 8 ? c * 32 : (c - 8) * 32, rowbase = c < 8 ? ML + b * 256 : b * 4096;
#pragma unroll
    for (int q = 0; q < 5; ++q) { const int i = tid + q * NTHREADS, ri = i >> 6, c4 = (i & 63) * 4, ts = t0 - 2 + ri; pre[q] = (u32x2){0u, 0u};
        if (i < 35 * 64 && ts >= 0 && ts < seqlen) pre[q] = *(const u32x2*)(YX + (size_t)(rowbase + ts) * 256 + c4); }
}
constexpr int LRU_CW = 30000;
DEV void lru_conv_init(const Args& a, int l, int tid, float* lds) {
    for (int i = tid; i < 1280; i += NTHREADS) lds[LRU_CW + i] = i < 1024 ? a.in[16][l * 1024 + i] : a.in[17][l * 256 + i - 1024];
}
DEV void lru_load_u(const u32x2 (&pre)[5], float* Xs, float* Us, unsigned* UB) {
    const int tid = ltid();
#pragma unroll
    for (int q = 0; q < 5; ++q) { const int i = tid + q * NTHREADS, ri = i >> 6, c4 = (i & 63) * 4;
        if (i < 35 * 64) *(f32x4*)(Xs + ri * 256 + c4) = (f32x4){bf2f(pre[q].x & 0xffffu), bf2f(pre[q].x >> 16), bf2f(pre[q].y & 0xffffu), bf2f(pre[q].y >> 16)}; }
    lds_barrier();
    const int cp = tid & 127, q = tid >> 7;
    f32x2_t cw[5];
#pragma unroll
    for (int k = 0; k < 5; ++k) cw[k] = *(const f32x2_t*)(Xs + LRU_CW + k * 256 + 2 * cp);
#pragma unroll
    for (int hf = 0; hf < 2; ++hf) { f32x2_t xr[7];
#pragma unroll
        for (int i = 0; i < 7; ++i) xr[i] = *(const f32x2_t*)(Xs + (q * 8 + hf * 4 + i) * 256 + 2 * cp);
#pragma unroll
        for (int t = 0; t < 4; ++t) { const int tt = q * 8 + hf * 4 + t;
            const float u0 = cw[4].x + cw[0].x * xr[t].x + cw[1].x * xr[t + 1].x + cw[2].x * xr[t + 2].x + cw[3].x * xr[t + 3].x;
            const float u1 = cw[4].y + cw[0].y * xr[t].y + cw[1].y * xr[t + 1].y + cw[2].y * xr[t + 2].y + cw[3].y * xr[t + 3].y;
            *(f32x2_t*)(Us + tt * 256 + 2 * cp) = (f32x2_t){u0, u1}; UB[tt * UBP_ + cp] = pk2(u0, u1); } }
    lds_barrier();
}
struct LruGate { unsigned wr[32], wi[32]; float br, bi, cl; };
DEV void lru_gate_init(const Args& a, int l, int dir, int ch, LruGate& G) {
    const int blk = ch >> 6, cc = ch & 63;
    const float* w = a.in[18] + ((size_t)(((l * 2 + dir) * 2 + 0) * 4 + blk) * 64) * 64 + cc;
    const float* w2 = a.in[18] + ((size_t)(((l * 2 + dir) * 2 + 1) * 4 + blk) * 64) * 64 + cc;
#pragma unroll
    for (int c = 0; c < 32; ++c) { G.wr[c] = pk2(w[(2 * c) * 64], w[(2 * c + 1) * 64]); G.wi[c] = pk2(w2[(2 * c) * 64], w2[(2 * c + 1) * 64]); }
    G.br = a.in[19][((l * 2 + dir) * 2 + 0) * 256 + ch]; G.bi = a.in[19][((l * 2 + dir) * 2 + 1) * 256 + ch];
    G.cl = -8.f * log1pf(expf(-a.in[20][(l * 2 + dir) * 256 + ch]));
}
DEV void lru_ab(const LruGate& G, const float* Us, const unsigned* UB, int tt, int ch, float& aa, float& bb) {
    const unsigned* u = UB + tt * UBP_ + ((ch >> 6) << 5);
    float ur = G.br, ui = G.bi, ur2 = 0.f, ui2 = 0.f;
#pragma unroll
    for (int c4 = 0; c4 < 8; ++c4) { const u32x4 x = *(const u32x4*)(u + c4 * 4);
        ur = dot2bf(G.wr[4 * c4], x.x, ur); ur2 = dot2bf(G.wr[4 * c4 + 1], x.y, ur2); ur = dot2bf(G.wr[4 * c4 + 2], x.z, ur); ur2 = dot2bf(G.wr[4 * c4 + 3], x.w, ur2);
        ui = dot2bf(G.wi[4 * c4], x.x, ui); ui2 = dot2bf(G.wi[4 * c4 + 1], x.y, ui2); ui = dot2bf(G.wi[4 * c4 + 2], x.z, ui); ui2 = dot2bf(G.wi[4 * c4 + 3], x.w, ui2); }

    const float la = G.cl * fsigm(ur + ur2); aa = __builtin_amdgcn_exp2f(1.4426950408889634f * la); bb = __builtin_amdgcn_sqrtf(fmaxf(1.f - aa * aa, 0.f)) * fsigm(ui + ui2) * Us[tt * 256 + ch];

}

DEV void p3_lru_agg(const Args& a, int l, float* lds) {
    const int tid = ltid(), ch = tid & 255, dir = tid >> 8;
    float* Xs = lds; float* Us = lds + 35 * 256; unsigned* UB = (unsigned*)(Us + 32 * 256);
    float* AGG = (float*)(a.ws + WS_LAGG);
    LruGate G; lru_gate_init(a, l, dir, ch, G);
    for (int it = blockIdx.x; it < NB * LRU_CH; it += gridDim.x) {
        const int b = it / LRU_CH, c = it % LRU_CH;
        { u32x2 pre_[5]; lru_conv_init(a, l, tid, lds); lru_fetch(a, b, c, tid, pre_); lru_load_u(pre_, Xs, Us, UB); }
        float P = 1.f, H = 0.f;
#pragma unroll 4
        for (int tt = 0; tt < 32; ++tt) { float aa, bb; lru_ab(G, Us, UB, tt, ch, aa, bb); H = dir == 0 ? aa * H + bb : H + P * bb; P *= aa; }
        float* o = AGG + ((size_t)(b * LRU_CH + c) * 2 + dir) * 512 + ch; o[0] = P; o[256] = H;
        __syncthreads();
    }
}


constexpr int UBP = 132;
struct LruW { bf16x8_t w[2][2][4]; float br[2], bi[2], cl[2]; };
DEV void lru_w_init(const Args& a, int l, int dir, int blk, int r32, int hi, LruW& W) {
#pragma unroll
    for (int g = 0; g < 2; ++g)
#pragma unroll
        for (int nt = 0; nt < 2; ++nt) {
#pragma unroll
            for (int ks = 0; ks < 4; ++ks) W.w[g][nt][ks] = *(const bf16x8_t*)(a.ws + WS_LRUW + ((size_t)(((((dir * 2 + g) * 4 + blk) * 2 + nt) * 4 + ks) * 64) + hi * 32 + r32) * 16); }
#pragma unroll
    for (int nt = 0; nt < 2; ++nt) { const int ch = blk * 64 + nt * 32 + r32;
        W.br[nt] = -1.4426950408889634f * a.in[19][((l * 2 + dir) * 2 + 0) * 256 + ch]; W.bi[nt] = -1.4426950408889634f * a.in[19][((l * 2 + dir) * 2 + 1) * 256 + ch];
        W.cl[nt] = -8.f * LOG2E_F * log1pf(expf(-a.in[20][(l * 2 + dir) * 256 + ch])); }
}
DEV void lru_ufrags(const unsigned* UB, int blk, int r32, int hi, bf16x8_t (&uf)[4]) {
#pragma unroll
    for (int ks = 0; ks < 4; ++ks) uf[ks] = *(const bf16x8_t*)((const unsigned char*)UB + r32 * (UBP * 4) + (blk * 64 + 16 * ks + 8 * hi) * 2);
}
DEV void lru_ab_nt(const LruW& W, const bf16x8_t (&uf)[4], const float* Us, int blk, int r32, int hi, int nt, f32x16& A, f32x16& B) {
    f32x16 gr, gi;
#pragma unroll
    for (int r = 0; r < 16; ++r) { gr[r] = W.br[nt]; gi[r] = W.bi[nt]; }
#pragma unroll
    for (int ks = 0; ks < 4; ++ks) { gr = __builtin_amdgcn_mfma_f32_32x32x16_bf16(uf[ks], W.w[0][nt][ks], gr, 0, 0, 0); gi = __builtin_amdgcn_mfma_f32_32x32x16_bf16(uf[ks], W.w[1][nt][ks], gi, 0, 0, 0); }
#pragma unroll
    for (int r = 0; r < 16; ++r) { const float aa = __builtin_amdgcn_exp2f(W.cl[nt] * __builtin_amdgcn_rcpf(1.f + __builtin_amdgcn_exp2f(gr[r])));
        A[r] = aa; B[r] = __builtin_amdgcn_sqrtf(fmaxf(1.f - aa * aa, 0.f)) * __builtin_amdgcn_rcpf(1.f + __builtin_amdgcn_exp2f(gi[r])) * Us[crow16(r, hi) * 256 + blk * 64 + nt * 32 + r32]; }
}
template <bool FWD> DEV void lru_segs(const f32x16& A, const f32x16& B, float (&Am)[4], float (&Bm)[4]) {
#pragma unroll
    for (int s = 0; s < 4; ++s) { float pa = 1.f, pb = 0.f;
#pragma unroll
        for (int i = 0; i < 4; ++i) { const int r = 4 * s + (FWD ? i : 3 - i); pb = A[r] * pb + B[r]; pa *= A[r]; }
        Am[s] = pa; Bm[s] = pb; }
}
template <bool FWD> DEV float lru_walk(const float (&Am)[4], const float (&Bm)[4], int hi, float h, float (&start)[4]) {
#pragma unroll
    for (int q = 0; q < 4; ++q) { const int s = FWD ? q : 3 - q;
        const auto sa = __builtin_amdgcn_permlane32_swap(__float_as_uint(Am[s]), __float_as_uint(Am[s]), false, false), sb = __builtin_amdgcn_permlane32_swap(__float_as_uint(Bm[s]), __float_as_uint(Bm[s]), false, false);
        const float Ae = __uint_as_float(sa[0]), Be = __uint_as_float(sb[0]), Ao = __uint_as_float(sa[1]), Bo = __uint_as_float(sb[1]);
        if (FWD) { const float h1 = Ae * h + Be; start[s] = hi ? h1 : h; h = Ao * h1 + Bo; }
        else { const float h1 = Ao * h + Bo; start[s] = hi ? h : h1; h = Ae * h1 + Be; } }
    return h;
}
DEV void p3_lru_agg_mfma(const Args& a, int l, float* lds) {
    const int tid = ltid(), lane = tid & 63, wave = __builtin_amdgcn_readfirstlane(tid >> 6), r32 = lane & 31, hi = lane >> 5, dir = wave >> 2, blk = wave & 3;
    float* Xs = lds; float* Us = lds + 35 * 256; unsigned* UB = (unsigned*)(Us + 32 * 256);
    float* AGG = (float*)(a.ws + WS_LAGG);
    LruW W; lru_w_init(a, l, dir, blk, r32, hi, W);
    lru_conv_init(a, l, tid, lds);
    u32x2 pre[5];
    const int vb = (blockIdx.x + 64) % gridDim.x;
    if (vb < NB * LRU_CH) lru_fetch(a, vb / LRU_CH, vb % LRU_CH, tid, pre);
    for (int it = vb; it < NB * LRU_CH; it += gridDim.x) {
        const int b = it / LRU_CH, c = it % LRU_CH;
        lru_load_u(pre, Xs, Us, UB);
        if (it + (int)gridDim.x < NB * LRU_CH) lru_fetch(a, (it + gridDim.x) / LRU_CH, (it + gridDim.x) % LRU_CH, tid, pre);
        bf16x8_t uf[4]; lru_ufrags(UB, blk, r32, hi, uf);
#pragma unroll
        for (int nt = 0; nt < 2; ++nt) { float Am[4], Bm[4], st[4]; float h, P; f32x16 A, B; lru_ab_nt(W, uf, Us, blk, r32, hi, nt, A, B);
            if (dir == 0) { lru_segs<true>(A, B, Am, Bm); h = lru_walk<true>(Am, Bm, hi, 0.f, st); } else { lru_segs<false>(A, B, Am, Bm); h = lru_walk<false>(Am, Bm, hi, 0.f, st); }
            P = Am[0] * Am[1] * Am[2] * Am[3]; { const auto sp = __builtin_amdgcn_permlane32_swap(__float_as_uint(P), __float_as_uint(P), false, false); P = __uint_as_float(sp[0]) * __uint_as_float(sp[1]); }
            if (hi == 0) { float* o = AGG + ((size_t)(b * LRU_CH + c) * 2 + dir) * 512 + blk * 64 + nt * 32 + r32; o[0] = P; o[256] = h; } }
        lds_barrier();
    }
}
DEV void p5_lru_out_mfma(const Args& a, int l, float* lds) {
    const int tid = ltid(), lane = tid & 63, wave = __builtin_amdgcn_readfirstlane(tid >> 6), r32 = lane & 31, hi = lane >> 5, dir = wave >> 2, blk = wave & 3;
    float* Xs = lds; float* Us = lds + 35 * 256; float* HF = Us + 32 * 256; float* HB = Xs; unsigned* UB = (unsigned*)(HF + 32 * 256);
    const float* CAR = (const float*)(a.ws + WS_LCAR); bf16_t* MIX = (bf16_t*)(a.ws + WS_MIX); const bf16_t* YG = (const bf16_t*)(a.ws + WS_Y) + 11 * YARR;
    LruW W; lru_w_init(a, l, dir, blk, r32, hi, W);
    lru_conv_init(a, l, tid, lds);
    const f32x4 ng = *(const f32x4*)(a.in[21] + l * 256 + lane * 4);
    const int c_lo = l == 0 ? 0 : 8;
    u32x2 pre[5];
    const int vb = (blockIdx.x + 192) % gridDim.x;
    if (vb < NB * (LRU_CH - c_lo)) lru_fetch(a, vb / (LRU_CH - c_lo), c_lo + vb % (LRU_CH - c_lo), tid, pre);
    for (int it = vb; it < NB * (LRU_CH - c_lo); it += gridDim.x) {
        const int b = it / (LRU_CH - c_lo), c = c_lo + it % (LRU_CH - c_lo);
        const int rowbase = c < 8 ? ML + b * 256 + c * 32 : b * 4096 + (c - 8) * 32;
        u32x2 gq[4]; float h0v[2];
#pragma unroll
        for (int q = 0; q < 4; ++q) gq[q] = *(const u32x2*)(YG + (size_t)(rowbase + (tid >> 6) * 4 + q) * 256 + lane * 4);
#pragma unroll
        for (int nt = 0; nt < 2; ++nt) h0v[nt] = CAR[((size_t)(b * LRU_CH + c) * 2 + dir) * 256 + blk * 64 + nt * 32 + r32];
        lru_load_u(pre, Xs, Us, UB);
        { const int itn = it + gridDim.x; if (itn < NB * (LRU_CH - c_lo)) lru_fetch(a, itn / (LRU_CH - c_lo), c_lo + itn % (LRU_CH - c_lo), tid, pre); }
        bf16x8_t uf[4]; lru_ufrags(UB, blk, r32, hi, uf);
        float* H = dir == 0 ? HF : HB;
#pragma unroll
        for (int nt = 0; nt < 2; ++nt) { const int ch = blk * 64 + nt * 32 + r32; float Am[4], Bm[4], st[4]; f32x16 An, Bn; lru_ab_nt(W, uf, Us, blk, r32, hi, nt, An, Bn);
            const float h0 = h0v[nt];
            if (dir == 0) { lru_segs<true>(An, Bn, Am, Bm); lru_walk<true>(Am, Bm, hi, h0, st);
#pragma unroll
                for (int s = 0; s < 4; ++s) { float h = st[s];
#pragma unroll
                    for (int i = 0; i < 4; ++i) { const int r = 4 * s + i; h = An[r] * h + Bn[r]; H[crow16(r, hi) * 256 + ch] = h; } } }
            else { lru_segs<false>(An, Bn, Am, Bm); lru_walk<false>(Am, Bm, hi, h0, st);
#pragma unroll
                for (int s = 0; s < 4; ++s) { float h = st[s];
#pragma unroll
                    for (int i = 3; i >= 0; --i) { const int r = 4 * s + i; h = An[r] * h + Bn[r]; H[crow16(r, hi) * 256 + ch] = h; } } } }
        lds_barrier();
#pragma unroll
        for (int q = 0; q < 4; ++q) {
            const int tt = (tid >> 6) * 4 + q, row = rowbase + tt;
            const float g[4] = {bf2f(gq[q].x & 0xffffu), bf2f(gq[q].x >> 16), bf2f(gq[q].y & 0xffffu), bf2f(gq[q].y >> 16)};
            const f32x4 hf = *(const f32x4*)(HF + tt * 256 + lane * 4), hb = *(const f32x4*)(HB + tt * 256 + lane * 4);
            float y[4] = {(hf.x + hb.x) * gelu_tanh(g[0]), (hf.y + hb.y) * gelu_tanh(g[1]), (hf.z + hb.z) * gelu_tanh(g[2]), (hf.w + hb.w) * gelu_tanh(g[3])};
            const float rstd = __builtin_amdgcn_rsqf(wave_sum(y[0] * y[0] + y[1] * y[1] + y[2] * y[2] + y[3] * y[3]) * (1.f / 256.f) + EPS);
            y[0] *= rstd * ng.x; y[1] *= rstd * ng.y; y[2] *= rstd * ng.z; y[3] *= rstd * ng.w;
            st4bf(MIX + (size_t)row * D + 768 + lane * 4, y);
        }
        lds_barrier();
    }
}
DEV void p4_lru_carry(const Args& a, float* lds) {
    const int tid = ltid(), j = tid & 15, part = tid >> 4;
    float* SA = lds; float* SH = lds + 272; float* SC = lds + 544;
    for (int g = blockIdx.x; g < NB * 2 * 256 / 16; g += gridDim.x) {
        const int cid = g * 16 + j, ch = cid & 255, dir = (cid >> 8) & 1, b = cid >> 9;
        const float* AGG = (const float*)(a.ws + WS_LAGG) + ((size_t)b * LRU_CH * 2 + dir) * 512 + ch;
        float* CAR = (float*)(a.ws + WS_LCAR) + ((size_t)b * LRU_CH * 2 + dir) * 256 + ch;
        float A8[8], H8[8]; int cc[8];
        if (part < 17) {
#pragma unroll
            for (int i = 0; i < 8; ++i) { const int k = part * 8 + i; cc[i] = dir == 0 ? k : (k < 8 ? 7 - k : LRU_CH - 1 - (k - 8)); A8[i] = AGG[(size_t)cc[i] * 1024]; H8[i] = AGG[(size_t)cc[i] * 1024 + 256]; }
            float Ac = 1.f, Hc = 0.f;
#pragma unroll
            for (int i = 0; i < 8; ++i) { Hc = A8[i] * Hc + H8[i]; Ac *= A8[i]; }
            SA[part * 16 + j] = Ac; SH[part * 16 + j] = Hc;
        }
        __syncthreads();
        if (tid < 16) { float carry = 0.f;
#pragma unroll
            for (int p = 0; p < 17; ++p) { SC[p * 16 + tid] = carry; carry = SA[p * 16 + tid] * carry + SH[p * 16 + tid]; } }
        __syncthreads();
        if (part < 17) { float carry = SC[part * 16 + j];
#pragma unroll
            for (int i = 0; i < 8; ++i) { CAR[(size_t)cc[i] * 512] = carry; carry = A8[i] * carry + H8[i]; } }
        __syncthreads();
    }
}

DEV void p5_lru_out(const Args& a, int l, float* lds) {
    const int tid = ltid(), ch = tid & 255, dir = tid >> 8, lane = tid & 63, wave = tid >> 6;
    float* Xs = lds; float* Us = lds + 35 * 256; float* HF = Us + 32 * 256; float* HB = Xs ; unsigned* UB = (unsigned*)(HF + 32 * 256);
    const float* CAR = (const float*)(a.ws + WS_LCAR); bf16_t* MIX = (bf16_t*)(a.ws + WS_MIX); const bf16_t* YG = (const bf16_t*)(a.ws + WS_Y) + 11 * YARR;
    LruGate G; lru_gate_init(a, l, dir, ch, G);
    const int c_lo = l == 0 ? 0 : 8;
    for (int it = blockIdx.x; it < NB * (LRU_CH - c_lo); it += gridDim.x) {
        const int b = it / (LRU_CH - c_lo), c = c_lo + it % (LRU_CH - c_lo);
        { u32x2 pre_[5]; lru_conv_init(a, l, tid, lds); lru_fetch(a, b, c, tid, pre_); lru_load_u(pre_, Xs, Us, UB); }

        float h = CAR[((size_t)(b * LRU_CH + c) * 2 + dir) * 256 + ch];

        if (dir == 0) {
#pragma unroll 4
            for (int tt = 0; tt < 32; ++tt) { float aa, bb; lru_ab(G, Us, UB, tt, ch, aa, bb); h = aa * h + bb; HF[tt * 256 + ch] = h; } }
        else {
#pragma unroll 4
            for (int tt = 31; tt >= 0; --tt) { float aa, bb; lru_ab(G, Us, UB, tt, ch, aa, bb); h = aa * h + bb; HB[tt * 256 + ch] = h; } }

        __syncthreads();
        const int rowbase = c < 8 ? ML + b * 256 + c * 32 : b * 4096 + (c - 8) * 32;

        const f32x4 ng = *(const f32x4*)(a.in[21] + l * 256 + lane * 4);

#pragma unroll
        for (int q = 0; q < 4; ++q) {
            const int tt = wave * 4 + q, row = rowbase + tt;
            float g[4]; ld4bf(YG + (size_t)row * 256 + lane * 4, g);
            const f32x4 hf = *(const f32x4*)(HF + tt * 256 + lane * 4), hb = *(const f32x4*)(HB + tt * 256 + lane * 4);
            float y[4] = {(hf.x + hb.x) * gelu_tanh(g[0]), (hf.y + hb.y) * gelu_tanh(g[1]), (hf.z + hb.z) * gelu_tanh(g[2]), (hf.w + hb.w) * gelu_tanh(g[3])};
            const float rstd = __builtin_amdgcn_rsqf(wave_sum(y[0] * y[0] + y[1] * y[1] + y[2] * y[2] + y[3] * y[3]) * (1.f / 256.f) + EPS);
            y[0] *= rstd * ng.x; y[1] *= rstd * ng.y; y[2] *= rstd * ng.z; y[3] *= rstd * ng.w;
            st4bf(MIX + (size_t)row * D + 768 + lane * 4, y);
        }
        __syncthreads();
    }
}


constexpr float LOG2E = 1.4426950408889634f;
DEV void p3_ret_prep(const Args& a, int l, unsigned char* lds) {
    const int tid = ltid(), lane = tid & 63, wave = __builtin_amdgcn_readfirstlane(tid >> 6), r32 = lane & 31, hi = lane >> 5, dir = wave >> 2, vt = (wave >> 1) & 1, dt = wave & 1;
    const bf16_t* Y = (const bf16_t*)(a.ws + WS_Y); bf16_t* RVT = (bf16_t*)(a.ws + WS_RVT); float* RS = (float*)(a.ws + WS_RETS);
    constexpr int ROWB = 272, TILE = 64 * ROWB, STG = 3 * TILE;
    bf16_t* Lk = (bf16_t*)(lds + STG); bf16_t* Lv = Lk + 128 * 72;
    u32x4 pre[4];
#define RP_FETCH(itx) do { const int c_ = (itx) % RET_CH, bh_ = (itx) / RET_CH, h_ = bh_ & 3, b_ = bh_ >> 2, row0_ = ret_row0(b_, c_); \
        _Pragma("unroll") for (int q = 0; q < 4; ++q) { const int i = tid + q * NTHREADS, arr = i >> 10, kr = (i >> 3) & 127, c8 = (i & 7) * 8; \
            pre[q] = *(const u32x4*)(Y + (size_t)(7 + arr) * YARR + (size_t)(row0_ + kr) * 256 + h_ * 64 + c8); } } while (0)
    const int vb = (blockIdx.x + 128) % gridDim.x;
    if (vb < NB * 4 * RET_CH) RP_FETCH(vb);
    for (int it = vb; it < NB * 4 * RET_CH; it += gridDim.x) {
        const int c = it % RET_CH, bh = it / RET_CH, h = bh & 3;
#pragma unroll
        for (int q = 0; q < 4; ++q) { const int i = tid + q * NTHREADS, arr = i >> 10, kr = (i >> 3) & 127, c8 = (i & 7) * 8; *(u32x4*)((arr ? Lv : Lk) + kr * 72 + c8) = pre[q]; }
        __syncthreads();
        if (it + (int)gridDim.x < NB * 4 * RET_CH) RP_FETCH(it + gridDim.x);
        { const int dd = tid >> 2, col = dd & 63; const bool isk = dd >= 64;
            const float lgf = a.in[14][l * 8 + h] * LOG2E, lgb = a.in[14][l * 8 + 4 + h] * LOG2E;
            const bf16_t* L = isk ? Lk : Lv;
#pragma unroll
            for (int gg = 0; gg < 2; ++gg) { const int g = (tid & 3) + 4 * gg; unsigned w[8], wb[8];
#pragma unroll
                for (int p2 = 0; p2 < 8; ++p2) { const int p = 2 * p2, ml = g * 16 + 8 * ((p & 7) >> 2) + 4 * (p >> 3) + (p & 3);
                    const unsigned x0 = L[ml * 72 + col], x1 = L[(ml + 1) * 72 + col];
                    if (isk) { const float f0 = bf2f(x0) * 0.125f, f1 = bf2f(x1) * 0.125f;
                        w[p2] = pk2(f0 * __builtin_amdgcn_exp2f(lgf * (float)(127 - ml)), f1 * __builtin_amdgcn_exp2f(lgf * (float)(126 - ml)));
                        wb[p2] = pk2(f0 * __builtin_amdgcn_exp2f(lgb * (float)ml), f1 * __builtin_amdgcn_exp2f(lgb * (float)(ml + 1))); }
                    else { w[p2] = x0 | (x1 << 16); wb[p2] = 0u; } }
                unsigned char* i0 = lds + (isk ? TILE : 0) + col * ROWB + g * 32;
                *(u32x4*)i0 = (u32x4){w[0], w[1], w[2], w[3]}; *(u32x4*)(i0 + 16) = (u32x4){w[4], w[5], w[6], w[7]};
                if (isk) { *(u32x4*)(i0 + TILE) = (u32x4){wb[0], wb[1], wb[2], wb[3]}; *(u32x4*)(i0 + TILE + 16) = (u32x4){wb[4], wb[5], wb[6], wb[7]}; }
                else { bf16_t* d0 = RVT + ((size_t)bh * 64 + col) * 4352 + c * 128 + g * 16; *(u32x4*)d0 = (u32x4){w[0], w[1], w[2], w[3]}; *(u32x4*)(d0 + 8) = (u32x4){w[4], w[5], w[6], w[7]}; } } }
        lds_barrier();
        f32x16 acc;
#pragma unroll
        for (int r = 0; r < 16; ++r) acc[r] = 0.f;
#pragma unroll
        for (int ks = 0; ks < 8; ++ks) {
            const bf16x8_t af = *(const bf16x8_t*)(lds + (vt * 32 + r32) * ROWB + ks * 32 + hi * 16);
            const bf16x8_t bf = *(const bf16x8_t*)(lds + (1 + dir) * TILE + (dt * 32 + r32) * ROWB + ks * 32 + hi * 16);
            acc = __builtin_amdgcn_mfma_f32_32x32x16_bf16(af, bf, acc, 0, 0, 0);
        }
        float* o = RS + ((size_t)(bh * RET_CH + c) * 2 + dir) * 4096 + dt * 32 + r32;
#pragma unroll
        for (int r = 0; r < 16; ++r) o[(vt * 32 + crow16(r, hi)) * 64] = acc[r];
        lds_barrier();
    }
}
DEV void p5_ret_out_mfma(const Args& a, int l, unsigned char* lds) {
    const int tid = ltid(), lane = tid & 63, wave = __builtin_amdgcn_readfirstlane(tid >> 6), r32 = lane & 31, hi = lane >> 5, nt = wave & 3, vt = wave >> 2;
    const bf16_t* Y = (const bf16_t*)(a.ws + WS_Y); const bf16_t* RVT = (const bf16_t*)(a.ws + WS_RVT); const float* RS = (const float*)(a.ws + WS_RETS); bf16_t* MIX = (bf16_t*)(a.ws + WS_MIX);
    constexpr int QROW = 144, QT = 128 * QROW, VROW = 272, VT_ = 64 * VROW;
    const int c_lo = l == 0 ? 0 : 2, ncs = RET_CH - c_lo;
    u32x4 pre[6];
#define RO_FETCH(itx) do { const int c_ = c_lo + (itx) % ncs, bh_ = (itx) / ncs, h_ = bh_ & 3, b_ = bh_ >> 2, row0_ = ret_row0(b_, c_); \
        _Pragma("unroll") for (int q = 0; q < 4; ++q) { const int i = tid + q * NTHREADS, arr = i >> 10, row = (i >> 3) & 127, c16 = i & 7; \
            pre[q] = *(const u32x4*)(Y + (size_t)(6 + arr) * YARR + (size_t)(row0_ + row) * 256 + h_ * 64 + c16 * 8); } \
        _Pragma("unroll") for (int q = 0; q < 2; ++q) { const int i = tid + q * NTHREADS, row = i >> 4, c16 = i & 15; \
            pre[4 + q] = *(const u32x4*)(RVT + ((size_t)bh_ * 64 + row) * 4352 + c_ * 128 + c16 * 8); } } while (0)
    if ((int)blockIdx.x < NB * 4 * ncs) RO_FETCH(blockIdx.x);
    for (int it = blockIdx.x; it < NB * 4 * ncs; it += gridDim.x) {
        const int c = c_lo + it % ncs, bh = it / ncs, h = bh & 3, b = bh >> 2, row0 = ret_row0(b, c);
#pragma unroll
        for (int q = 0; q < 4; ++q) { const int i = tid + q * NTHREADS, arr = i >> 10, row = (i >> 3) & 127, c16 = i & 7; *(u32x4*)(lds + arr * QT + row * QROW + c16 * 16) = pre[q]; }
#pragma unroll
        for (int q = 0; q < 2; ++q) { const int i = tid + q * NTHREADS, row = i >> 4, c16 = i & 15; *(u32x4*)(lds + 2 * QT + row * VROW + c16 * 16) = pre[4 + q]; }
        bf16x8_t sfr[4], sbr[4]; u32x4 gq[2];
        { const bf16_t* Sf = (const bf16_t*)(a.ws + WS_XN) + ((size_t)(bh * RET_CH + c) * 2) * 4096 + (vt * 32 + r32) * 64 + hi * 8;
#pragma unroll
            for (int ks = 0; ks < 4; ++ks) { sfr[ks] = *(const bf16x8_t*)(Sf + ks * 16); sbr[ks] = *(const bf16x8_t*)(Sf + 4096 + ks * 16); }
            const bf16_t* gp = Y + 9 * YARR + (size_t)(row0 + (tid >> 2)) * 256 + h * 64 + (tid & 3) * 16; gq[0] = *(const u32x4*)gp; gq[1] = *(const u32x4*)(gp + 8); }
        __syncthreads();
        if (it + (int)gridDim.x < NB * 4 * ncs) RO_FETCH(it + gridDim.x);
        const float lgf = a.in[14][l * 8 + h] * LOG2E, lgb = a.in[14][l * 8 + 4 + h] * LOG2E;
        bf16x8_t qf[4];
#pragma unroll
        for (int ks = 0; ks < 4; ++ks) qf[ks] = *(const bf16x8_t*)(lds + (nt * 32 + r32) * QROW + ks * 32 + hi * 16);
        f32x16 o;
#pragma unroll
        for (int r = 0; r < 16; ++r) o[r] = 0.f;
        const int n_l = nt * 32 + r32;
#pragma unroll 1
        for (int mt = 0; mt < 4; ++mt) {
            f32x16 x;
#pragma unroll
            for (int r = 0; r < 16; ++r) x[r] = 0.f;
#pragma unroll
            for (int ks = 0; ks < 4; ++ks) { const bf16x8_t kf = *(const bf16x8_t*)(lds + QT + (mt * 32 + r32) * QROW + ks * 32 + hi * 16); x = __builtin_amdgcn_mfma_f32_32x32x16_bf16(kf, qf[ks], x, 0, 0, 0); }
#pragma unroll
            for (int r = 0; r < 16; ++r) { const int m = mt * 32 + crow16(r, hi), df = n_l - m;
                x[r] *= 0.125f * __builtin_amdgcn_exp2f(df >= 0 ? lgf * (float)df : lgb * (float)(-df)); }
#pragma unroll
            for (int sp = 0; sp < 2; ++sp) { u32x4 w; w.x = pk2(x[8 * sp], x[8 * sp + 1]); w.y = pk2(x[8 * sp + 2], x[8 * sp + 3]); w.z = pk2(x[8 * sp + 4], x[8 * sp + 5]); w.w = pk2(x[8 * sp + 6], x[8 * sp + 7]);
                const bf16x8_t vf = *(const bf16x8_t*)(lds + 2 * QT + (vt * 32 + r32) * VROW + (mt * 2 + sp) * 32 + hi * 16);
                o = __builtin_amdgcn_mfma_f32_32x32x16_bf16(__builtin_bit_cast(bf16x8_t, w), vf, o, 0, 0, 0); }
        }
        f32x16 of, ob;
#pragma unroll
        for (int r = 0; r < 16; ++r) { of[r] = 0.f; ob[r] = 0.f; }
#pragma unroll
        for (int ks = 0; ks < 4; ++ks) {
            of = __builtin_amdgcn_mfma_f32_32x32x16_bf16(qf[ks], sfr[ks], of, 0, 0, 0);
            ob = __builtin_amdgcn_mfma_f32_32x32x16_bf16(qf[ks], sbr[ks], ob, 0, 0, 0);
        }
        __syncthreads();
        float* OT = (float*)lds;
#pragma unroll
        for (int r = 0; r < 16; ++r) { const int n = nt * 32 + crow16(r, hi);
            OT[n * 64 + vt * 32 + r32] = o[r] + __builtin_amdgcn_exp2f(lgf * (float)(n + 1)) * of[r] + __builtin_amdgcn_exp2f(lgb * (float)(128 - n)) * ob[r]; }
        __syncthreads();
        { const int n = tid >> 2, v0 = (tid & 3) * 16; float ov[16]; float ss = 0.f;
#pragma unroll
            for (int j4 = 0; j4 < 4; ++j4) { const f32x4 x = *(const f32x4*)(OT + n * 64 + v0 + j4 * 4); ov[j4 * 4] = x.x; ov[j4 * 4 + 1] = x.y; ov[j4 * 4 + 2] = x.z; ov[j4 * 4 + 3] = x.w; ss += (x.x * x.x + x.y * x.y) + (x.z * x.z + x.w * x.w); }
            ss = row_sum4(ss);
            const float rstd = __builtin_amdgcn_rsqf(ss * (1.f / 64.f) + EPS);
            const size_t row = (size_t)(row0 + n); const float* ng = a.in[15] + l * 64 + v0;
            bf16_t* mp = MIX + row * D + 512 + h * 64 + v0;
#pragma unroll
            for (int j4 = 0; j4 < 4; ++j4) { const unsigned g0 = gq[j4 >> 1][(j4 & 1) * 2], g1 = gq[j4 >> 1][(j4 & 1) * 2 + 1]; const float g[4] = {bf2f(g0 & 0xffffu), bf2f(g0 >> 16), bf2f(g1 & 0xffffu), bf2f(g1 >> 16)}; float y[4];
#pragma unroll
                for (int j = 0; j < 4; ++j) y[j] = ov[j4 * 4 + j] * rstd * ng[j4 * 4 + j] * fsiluf(g[j]);
                st4bf(mp + j4 * 4, y); } }
        __syncthreads();
    }
}
DEV void p5_ret_out_dma(const Args& a, int l, unsigned char* lds_) {
    typedef __attribute__((address_space(3))) unsigned char* lptr;
    lptr lds = (lptr)lds_;
    const int tid = ltid(), lane = tid & 63, wave = __builtin_amdgcn_readfirstlane(tid >> 6), r32 = lane & 31, hi = lane >> 5, nt = wave & 3, vt = wave >> 2;
    const bf16_t* Y = (const bf16_t*)(a.ws + WS_Y); const bf16_t* RVT = (const bf16_t*)(a.ws + WS_RVT); bf16_t* MIX = (bf16_t*)(a.ws + WS_MIX);
    constexpr int RB = 65536, KOFF = 16384, VOFF = 32768, GOFF = 49152;
    const int c_lo = l == 0 ? 0 : 2, ncs = RET_CH - c_lo, nitems = NB * 4 * ncs;
#define RD_ISSUE(itx, bufb) do { const int c_ = c_lo + (itx) % ncs, bh_ = (itx) / ncs, h_ = bh_ & 3, b_ = bh_ >> 2, row0_ = ret_row0(b_, c_); \
        _Pragma("unroll") for (int i_ = 0; i_ < 2; ++i_) { const int P_ = (wave * 2 + i_) * 64 + lane; \
            { const int row_ = P_ >> 3, cs_ = (P_ & 7) ^ ((row_ >> 1) & 7); const bf16_t* src_ = Y + (size_t)6 * YARR + (size_t)(row0_ + row_) * 256 + h_ * 64 + cs_ * 8; \
              __builtin_amdgcn_global_load_lds((const unsigned*)src_, (__attribute__((address_space(3))) unsigned*)(lds + (bufb) + (wave * 2 + i_) * 1024), 16, 0, 0); \
              __builtin_amdgcn_global_load_lds((const unsigned*)(src_ + YARR), (__attribute__((address_space(3))) unsigned*)(lds + (bufb) + KOFF + (wave * 2 + i_) * 1024), 16, 0, 0); \
              __builtin_amdgcn_global_load_lds((const unsigned*)(Y + (size_t)9 * YARR + (size_t)(row0_ + row_) * 256 + h_ * 64 + (P_ & 7) * 8), (__attribute__((address_space(3))) unsigned*)(lds + (bufb) + GOFF + (wave * 2 + i_) * 1024), 16, 0, 0); } \
            { const int row_ = P_ >> 4, cs_ = (P_ & 15) ^ (row_ & 15); const bf16_t* src_ = RVT + ((size_t)bh_ * 64 + row_) * 4352 + c_ * 128 + cs_ * 8; \
              __builtin_amdgcn_global_load_lds((const unsigned*)src_, (__attribute__((address_space(3))) unsigned*)(lds + (bufb) + VOFF + (wave * 2 + i_) * 1024), 16, 0, 0); } } } while (0)
    __attribute__((address_space(3))) float* NG = (__attribute__((address_space(3))) float*)(lds + 2 * RB);
    if (tid < 64) NG[tid] = a.in[15][l * 64 + tid];
    bf16x8_t sfr[4], sbr[4];
#define RD_STATE(itx) do { const int c_ = c_lo + (itx) % ncs, bh_ = (itx) / ncs, h_ = bh_ & 3, b_ = bh_ >> 2, row0_ = ret_row0(b_, c_); \
        const bf16_t* Sf_ = (const bf16_t*)(a.ws + WS_XN) + ((size_t)(bh_ * RET_CH + c_) * 2) * 4096 + (vt * 32 + r32) * 64 + hi * 8; \
        _Pragma("unroll") for (int ks = 0; ks < 4; ++ks) { sfr[ks] = *(const bf16x8_t*)(Sf_ + ks * 16); sbr[ks] = *(const bf16x8_t*)(Sf_ + 4096 + ks * 16); } \
        } while (0)
    int it = blockIdx.x, par = 0;
    if (it < nitems) { RD_STATE(it); RD_ISSUE(it, 0); }
    for (; it < nitems; it += gridDim.x, par ^= 1) {
        const int buf = par * RB;
        const int c = c_lo + it % ncs, bh = it / ncs, h = bh & 3, b = bh >> 2, row0 = ret_row0(b, c);
        const float lgf = a.in[14][l * 8 + h] * LOG2E, lgb = a.in[14][l * 8 + 4 + h] * LOG2E;
        __builtin_amdgcn_s_waitcnt(0x0F70);
        __syncthreads();
        typedef const __attribute__((address_space(3))) bf16x8_t* fptr;
        bf16x8_t qf[4];
        { const int R = nt * 32 + r32, sw = (R >> 1) & 7;
#pragma unroll
            for (int ks = 0; ks < 4; ++ks) qf[ks] = *(fptr)(lds + buf + R * 128 + (((ks * 2 + hi) ^ sw) * 16)); }
        f32x16 of, ob;
#pragma unroll
        for (int r = 0; r < 16; ++r) { of[r] = 0.f; ob[r] = 0.f; }
#pragma unroll
        for (int ks = 0; ks < 4; ++ks) {
            of = __builtin_amdgcn_mfma_f32_32x32x16_bf16(qf[ks], sfr[ks], of, 0, 0, 0);
            ob = __builtin_amdgcn_mfma_f32_32x32x16_bf16(qf[ks], sbr[ks], ob, 0, 0, 0);
        }
        asm volatile("" : "+v"(of), "+v"(ob));
        __builtin_amdgcn_sched_barrier(0);
        { const int itn = it + (int)gridDim.x < nitems ? it + (int)gridDim.x : it;
          RD_STATE(itn); RD_ISSUE(itn, RB - buf); }
        __builtin_amdgcn_sched_barrier(0);
        f32x16 o;
#pragma unroll
        for (int r = 0; r < 16; ++r) o[r] = 0.f;
        const int n_l = nt * 32 + r32;
        const int Rv = vt * 32 + r32, swv = Rv & 15;
#pragma unroll 1
        for (int mt = 0; mt < 4; ++mt) {
            f32x16 x;
#pragma unroll
            for (int r = 0; r < 16; ++r) x[r] = 0.f;
            const int Rk = mt * 32 + r32, swk = (Rk >> 1) & 7;
#pragma unroll
            for (int ks = 0; ks < 4; ++ks) { const bf16x8_t kf = *(fptr)(lds + buf + KOFF + Rk * 128 + (((ks * 2 + hi) ^ swk) * 16)); x = __builtin_amdgcn_mfma_f32_32x32x16_bf16(kf, qf[ks], x, 0, 0, 0); }
#pragma unroll
            for (int r = 0; r < 16; ++r) { const int m = mt * 32 + crow16(r, hi), df = n_l - m;
                x[r] *= 0.125f * __builtin_amdgcn_exp2f(df >= 0 ? lgf * (float)df : lgb * (float)(-df)); }
#pragma unroll
            for (int sp = 0; sp < 2; ++sp) { u32x4 w; w.x = pk2(x[8 * sp], x[8 * sp + 1]); w.y = pk2(x[8 * sp + 2], x[8 * sp + 3]); w.z = pk2(x[8 * sp + 4], x[8 * sp + 5]); w.w = pk2(x[8 * sp + 6], x[8 * sp + 7]);
                const bf16x8_t vf = *(fptr)(lds + buf + VOFF + Rv * 256 + ((((mt * 2 + sp) * 2 + hi) ^ swv) * 16));
                o = __builtin_amdgcn_mfma_f32_32x32x16_bf16(__builtin_bit_cast(bf16x8_t, w), vf, o, 0, 0, 0); }
        }
        asm volatile("s_waitcnt lgkmcnt(0)\n\ts_barrier" ::: "memory");
        __attribute__((address_space(3))) float* OT = (__attribute__((address_space(3))) float*)(lds + buf);
#pragma unroll
        for (int r = 0; r < 16; ++r) { const int n = nt * 32 + crow16(r, hi);
            OT[n * 64 + vt * 32 + r32] = o[r] + __builtin_amdgcn_exp2f(lgf * (float)(n + 1)) * of[r] + __builtin_amdgcn_exp2f(lgb * (float)(128 - n)) * ob[r]; }
        asm volatile("s_waitcnt lgkmcnt(0)\n\ts_barrier" ::: "memory");
        { const int n = tid >> 2, v0 = (tid & 3) * 16; float ov[16]; float ss = 0.f;
#pragma unroll
            for (int j4 = 0; j4 < 4; ++j4) { const f32x4 x = *(const __attribute__((address_space(3))) f32x4*)(OT + n * 64 + v0 + j4 * 4); ov[j4 * 4] = x.x; ov[j4 * 4 + 1] = x.y; ov[j4 * 4 + 2] = x.z; ov[j4 * 4 + 3] = x.w; ss += (x.x * x.x + x.y * x.y) + (x.z * x.z + x.w * x.w); }
            ss = row_sum4(ss);
            const float rstd = __builtin_amdgcn_rsqf(ss * (1.f / 64.f) + EPS);
            const size_t row = (size_t)(row0 + n); const __attribute__((address_space(3))) float* ng = NG + v0;
            bf16_t* mp = MIX + row * D + 512 + h * 64 + v0;
            const u32x4 gq0 = *(const __attribute__((address_space(3))) u32x4*)(lds + buf + GOFF + n * 128 + v0 * 2), gq1 = *(const __attribute__((address_space(3))) u32x4*)(lds + buf + GOFF + n * 128 + v0 * 2 + 16);
#pragma unroll
            for (int j4 = 0; j4 < 4; ++j4) { const unsigned g0 = (j4 < 2 ? gq0 : gq1)[(j4 & 1) * 2], g1 = (j4 < 2 ? gq0 : gq1)[(j4 & 1) * 2 + 1]; const float g[4] = {bf2f(g0 & 0xffffu), bf2f(g0 >> 16), bf2f(g1 & 0xffffu), bf2f(g1 >> 16)}; float y[4];
#pragma unroll
                for (int j = 0; j < 4; ++j) y[j] = ov[j4 * 4 + j] * rstd * ng[j4 * 4 + j] * fsiluf(g[j]);
                st4bf(mp + j4 * 4, y); } }
    }
    asm volatile("s_waitcnt vmcnt(0)" ::: "memory");
    __syncthreads();
#undef RD_ISSUE
#undef RD_STATE
}
DEV void p4_ret_scan(const Args& a, int l) {
    const float* RS = (const float*)(a.ws + WS_RETS); bf16_t* RSB = (bf16_t*)(a.ws + WS_XN);
    for (int it = blockIdx.x; it < 512; it += gridDim.x) {
        const int gid = it * NTHREADS + ltid(), elem = gid & 4095, dir = (gid >> 12) & 1, bh = gid >> 13, h = bh & 3;
        const float gC = expf(a.in[14][l * 8 + dir * 4 + h] * 128.f);
        const float* p = RS + ((size_t)bh * RET_CH * 2 + dir) * 4096 + elem;
        bf16_t* q = RSB + ((size_t)bh * RET_CH * 2 + dir) * 4096 + elem;
        float u[RET_CH];
#pragma unroll
        for (int c = 0; c < RET_CH; ++c) u[c] = p[(size_t)c * 8192];
        float st = 0.f;
        if (dir == 0) {
#pragma unroll
            for (int c = 0; c < RET_CH; ++c) { q[(size_t)c * 8192] = (bf16_t)f2bf(st); st = gC * st + u[c]; } }
        else {
#pragma unroll
            for (int c = 1; c >= 0; --c) { q[(size_t)c * 8192] = (bf16_t)f2bf(st); st = gC * st + u[c]; }
#pragma unroll
            for (int c = RET_CH - 1; c >= 2; --c) { q[(size_t)c * 8192] = (bf16_t)f2bf(st); st = gC * st + u[c]; }
        }
    }
}
DEV void p5_ret_out(const Args& a, int l, float* lds) {
    const int tid = ltid();
    bf16_t* Qs = (bf16_t*)lds; bf16_t* Ks = Qs + 128 * 64; bf16_t* Vs = Ks + 128 * 64; float* S = lds + (3 * 128 * 64) / 2;
    const bf16_t* Y = (const bf16_t*)(a.ws + WS_Y); const float* RS = (const float*)(a.ws + WS_RETS); bf16_t* MIX = (bf16_t*)(a.ws + WS_MIX);
    const int c_lo = l == 0 ? 0 : 2, ncs = RET_CH - c_lo;
    for (int it = blockIdx.x; it < NB * 4 * ncs; it += gridDim.x) {
        const int c = c_lo + it % ncs, bh = it / ncs, h = bh & 3, b = bh >> 2, row0 = ret_row0(b, c);
        for (int i = tid; i < 128 * 16; i += NTHREADS) { const int m = i >> 4, q4 = (i & 15) * 4; const size_t go = (size_t)(row0 + m) * 256 + h * 64 + q4;
            *(u32x2*)(Qs + m * 64 + q4) = *(const u32x2*)(Y + 6 * YARR + go); *(u32x2*)(Ks + m * 64 + q4) = *(const u32x2*)(Y + 7 * YARR + go); *(u32x2*)(Vs + m * 64 + q4) = *(const u32x2*)(Y + 8 * YARR + go); }
        __syncthreads();
        const float lgf = a.in[14][l * 8 + h], lgb = a.in[14][l * 8 + 4 + h];
        { const int n0 = (tid >> 4) * 4, m0 = (tid & 15) * 8; float s[4][8];
#pragma unroll
            for (int i = 0; i < 4; ++i)
#pragma unroll
                for (int j = 0; j < 8; ++j) s[i][j] = 0.f;
            for (int d = 0; d < 64; ++d) { float q[4], k[8];
#pragma unroll
                for (int i = 0; i < 4; ++i) q[i] = bf2f(Qs[(n0 + i) * 64 + d]);
#pragma unroll
                for (int j = 0; j < 8; ++j) k[j] = bf2f(Ks[(m0 + j) * 64 + d]);
#pragma unroll
                for (int i = 0; i < 4; ++i)
#pragma unroll
                    for (int j = 0; j < 8; ++j) s[i][j] += q[i] * k[j]; }
#pragma unroll
            for (int i = 0; i < 4; ++i)
#pragma unroll
                for (int j = 0; j < 8; ++j) { const int n = n0 + i, m = m0 + j; const float dec = n >= m ? expf(lgf * (float)(n - m)) : expf(lgb * (float)(m - n)); S[n * 129 + m] = s[i][j] * 0.125f * dec; } }
        __syncthreads();
        { const int n = tid >> 2, v0 = (tid & 3) * 16; float o[16];
#pragma unroll
            for (int j = 0; j < 16; ++j) o[j] = 0.f;
            for (int m = 0; m < 128; ++m) { const float sv = S[n * 129 + m];
#pragma unroll
                for (int j = 0; j < 16; ++j) o[j] += sv * bf2f(Vs[m * 64 + v0 + j]); }
            const float cf = expf(lgf * (float)(n + 1)), cb = expf(lgb * (float)(128 - n));
            const float* Sf = RS + ((size_t)(bh * RET_CH + c) * 2) * 4096 + v0; const float* Sb = Sf + 4096;
            for (int d = 0; d < 64; ++d) { const float qv = bf2f(Qs[n * 64 + d]), qf = qv * cf, qb = qv * cb;
#pragma unroll
                for (int j4 = 0; j4 < 4; ++j4) { const f32x4 x = *(const f32x4*)(Sf + d * 64 + j4 * 4), y = *(const f32x4*)(Sb + d * 64 + j4 * 4);
                    o[j4 * 4] += qf * x.x + qb * y.x; o[j4 * 4 + 1] += qf * x.y + qb * y.y; o[j4 * 4 + 2] += qf * x.z + qb * y.z; o[j4 * 4 + 3] += qf * x.w + qb * y.w; } }
            float ss = 0.f;
#pragma unroll
            for (int j = 0; j < 16; ++j) ss += o[j] * o[j];
            ss = row_sum4(ss);
            const float rstd = 1.0f / sqrtf(ss * (1.f / 64.f) + EPS);
            const int row = row0 + n; const bf16_t* gp = Y + 9 * YARR + (size_t)row * 256 + h * 64 + v0; const float* ng = a.in[15] + l * 64 + v0;
            bf16_t* mp = MIX + (size_t)row * D + 512 + h * 64 + v0;
#pragma unroll
            for (int j4 = 0; j4 < 4; ++j4) { float g[4]; ld4bf(gp + j4 * 4, g); float y[4];
#pragma unroll
                for (int j = 0; j < 4; ++j) y[j] = o[j4 * 4 + j] * rstd * ng[j4 * 4 + j] * siluf(g[j]);
                st4bf(mp + j4 * 4, y); } }
        __syncthreads();
    }
}

DEV float att_lambda(const Args& a, int l) {
    const float* lp = a.in[12] + l * 256; float s1 = 0.f, s2 = 0.f;
    for (int i = 0; i < 64; ++i) { s1 += lp[i] * lp[64 + i]; s2 += lp[128 + i] * lp[192 + i]; }
    return expf(s1) - expf(s2) + lam_init(l);
}
DEV float att_bound2(const Args& a, int l) {
    float mq = 0.f, mk = 0.f;
    for (int i = 0; i < 64; ++i) { mq = fmaxf(mq, fabsf(a.in[10][l * 64 + i])); mk = fmaxf(mk, fabsf(a.in[11][l * 64 + i])); }
    return 8.f * 1.4426950408889634f * mq * mk * 1.01f;
}

DEV void attn_simple_item(const Args& a, int l, int b, int h, int qblk, bool ctx, float lam, float bound2, float* lds) {
    const int tid = ltid(), q = tid & 63, part = tid >> 6, map = part >> 2, vq = part & 3;
    float* Ks = lds; float* Vs = lds + 64 * 128; float* red = lds + 2 * 64 * 128;
    const bf16_t* Y = (const bf16_t*)(a.ws + WS_Y); bf16_t* MIX = (bf16_t*)(a.ws + WS_MIX);
    const int qrow = (ctx ? ML + b * 256 : b * 4096) + qblk * 64 + q;
    const int arrh = h >> 1, colh = (h & 1) * 128;
    float qv[64];
    { const bf16_t* qp = Y + (size_t)arrh * YARR + (size_t)qrow * 256 + colh + map * 64;
#pragma unroll
        for (int d4 = 0; d4 < 16; ++d4) ld4bf(qp + d4 * 4, qv + d4 * 4); }
    float o[32], lsum = 0.f;
#pragma unroll
    for (int j = 0; j < 32; ++j) o[j] = 0.f;
    const int ntiles = ctx ? 4 : 68;
    for (int tj = 0; tj < ntiles; ++tj) {
        const int krow0 = tj < 4 ? ML + b * 256 + tj * 64 : b * 4096 + (tj - 4) * 64;
        for (int i = tid; i < 64 * 32; i += NTHREADS) { const int kr = i >> 5, c4 = (i & 31) * 4; const size_t go = (size_t)(krow0 + kr) * 256 + colh + c4;
            ld4bf(Y + (size_t)(2 + arrh) * YARR + go, Ks + kr * 128 + c4); ld4bf(Y + (size_t)(4 + arrh) * YARR + go, Vs + kr * 128 + c4); }
        __syncthreads();
        for (int kr = 0; kr < 64; ++kr) {
            const float* kp = Ks + kr * 128 + map * 64; float s = 0.f;
#pragma unroll
            for (int d4 = 0; d4 < 16; ++d4) { const f32x4 kk = *(const f32x4*)(kp + d4 * 4); s += qv[d4 * 4] * kk.x + qv[d4 * 4 + 1] * kk.y + qv[d4 * 4 + 2] * kk.z + qv[d4 * 4 + 3] * kk.w; }
            const float p = exp2f(s - bound2); lsum += p;
            const float* vp = Vs + kr * 128 + vq * 32;
#pragma unroll
            for (int j4 = 0; j4 < 8; ++j4) { const f32x4 vv = *(const f32x4*)(vp + j4 * 4); o[j4 * 4] += p * vv.x; o[j4 * 4 + 1] += p * vv.y; o[j4 * 4 + 2] += p * vv.z; o[j4 * 4 + 3] += p * vv.w; }
        }
        __syncthreads();
    }
    float* Ob = Ks;
    const float il = 1.f / lsum;
    if (map == 0) {
#pragma unroll
        for (int j = 0; j < 32; ++j) Ob[q * 128 + vq * 32 + j] = o[j] * il; }
    __syncthreads();
    if (map == 1) {
#pragma unroll
        for (int j = 0; j < 32; ++j) Ob[q * 128 + vq * 32 + j] -= lam * o[j] * il; }
    __syncthreads();
    float ss = 0.f;
#pragma unroll
    for (int j = 0; j < 16; ++j) { const float x = Ob[q * 128 + part * 16 + j]; ss += x * x; }
    red[q * 8 + part] = ss;
    __syncthreads();
    float tot = 0.f;
#pragma unroll
    for (int p8 = 0; p8 < 8; ++p8) tot += red[q * 8 + p8];
    const float rstd = 1.0f / sqrtf(tot * (1.f / 128.f) + EPS), sc = rstd * (1.f - lam_init(l));
    const float* sg = a.in[13] + l * 128 + part * 16; bf16_t* mp = MIX + (size_t)qrow * D + h * 128 + part * 16;
#pragma unroll
    for (int j4 = 0; j4 < 4; ++j4) { float y[4];
#pragma unroll
        for (int j = 0; j < 4; ++j) y[j] = Ob[q * 128 + part * 16 + j4 * 4 + j] * sc * sg[j4 * 4 + j];
        st4bf(mp + j4 * 4, y); }
    __syncthreads();
}

constexpr int ATT_KROW = 128, ATT_KMAP = 64 * ATT_KROW, ATT_VOFF = 2 * ATT_KMAP, ATT_BUF = ATT_VOFF + 128 * ATT_KROW;
constexpr int ATT_EX = 0, ATT_LW = 2 * ATT_BUF, ATT_STG = ATT_LW + 1024, ATT_STGROW = 272;
DEV void p3_vt(const Args& a, float* ldsf) {
    const int tid = ltid();
    bf16_t* Ls = (bf16_t*)ldsf;
    const bf16_t* Y = (const bf16_t*)(a.ws + WS_Y); bf16_t* VT = (bf16_t*)(a.ws + WS_VT);
    u32x4 pre[2];
#define VT_FETCH(itx) do { const int t_ = (itx) % 68, bh_ = (itx) / 68, h_ = bh_ & 3, b_ = bh_ >> 2, kr0_ = t_ < 4 ? ML + b_ * 256 + t_ * 64 : b_ * 4096 + (t_ - 4) * 64; \
        _Pragma("unroll") for (int q = 0; q < 2; ++q) { const int i = tid + q * NTHREADS, kr = i >> 4, c8 = (i & 15) * 8; \
            pre[q] = *(const u32x4*)(Y + (size_t)(4 + (h_ >> 1)) * YARR + (size_t)(kr0_ + kr) * 256 + (h_ & 1) * 128 + c8); } } while (0)
    if ((int)blockIdx.x < NB * 4 * 68) VT_FETCH(blockIdx.x);
    for (int it = blockIdx.x; it < NB * 4 * 68; it += gridDim.x) {
        const int t = it % 68, bh = it / 68;
#pragma unroll
        for (int q = 0; q < 2; ++q) { const int i = tid + q * NTHREADS, kr = i >> 4, c8 = (i & 15) * 8; *(u32x4*)(Ls + kr * 136 + c8) = pre[q]; }
        __syncthreads();
        if (it + (int)gridDim.x < NB * 4 * 68) VT_FETCH(it + gridDim.x);
        { const int d = tid >> 2, g = tid & 3; unsigned w[8];
#pragma unroll
            for (int p2 = 0; p2 < 8; ++p2) { const int p = 2 * p2, kv0 = 8 * ((p & 7) >> 2) + 4 * (p >> 3) + (p & 3);
                w[p2] = (unsigned)Ls[(g * 16 + kv0) * 136 + d] | ((unsigned)Ls[(g * 16 + kv0 + 1) * 136 + d] << 16); }
            bf16_t* dst = VT + ((size_t)bh * 128 + d) * 4352 + t * 64 + g * 16;
            *(u32x4*)dst = (u32x4){w[0], w[1], w[2], w[3]}; *(u32x4*)(dst + 8) = (u32x4){w[4], w[5], w[6], w[7]}; }
        __syncthreads();
    }
#undef VT_FETCH
}
DEV void attn_unit(const Args& a, int l, int b, int h, int qb, bool ctx, float lam, float bound2, unsigned char* lds) {
    const int tid = ltid(), lane = tid & 63, wave = __builtin_amdgcn_readfirstlane(tid >> 6), r32 = lane & 31, hi = lane >> 5, qg = wave & 3, map = wave >> 2;
    const bf16_t* Y = (const bf16_t*)(a.ws + WS_Y); const bf16_t* VT = (const bf16_t*)(a.ws + WS_VT); bf16_t* MIX = (bf16_t*)(a.ws + WS_MIX);
    const int NT = ctx ? 4 : 68;
    const int qrow0 = (ctx ? ML + b * 256 : b * 4096) + qb * 128 + qg * 32;
    bf16x8_t qf[4];
    { const bf16_t* qp = Y + (size_t)(h >> 1) * YARR + (size_t)(qrow0 + r32) * 256 + (h & 1) * 128 + map * 64 + 8 * hi;
#pragma unroll
        for (int s = 0; s < 4; ++s) qf[s] = *(const bf16x8_t*)(qp + 16 * s); }
    const bf16_t* Kg = Y + (size_t)(2 + (h >> 1)) * YARR + (h & 1) * 128;
    const bf16_t* Vg = VT + (size_t)(b * 4 + h) * 128 * 4352;
    typedef __attribute__((address_space(3))) unsigned char* lptr;
    lptr ldsl = (lptr)lds;
    int dgo[4];
#pragma unroll
    for (int i = 0; i < 4; ++i) { const int P = (wave * 4 + i) * 64 + lane;
        if (wave < 4) { const int m = P >> 9, row = (P >> 3) & 63, c = (P & 7) ^ ((row >> 1) & 7); dgo[i] = row * 256 + m * 64 + c * 8; }
        else { const int P2 = P - 1024, d = P2 >> 3, c = (P2 & 7) ^ ((d >> 1) & 7); dgo[i] = d * 4352 + c * 8; } }
#define ATT_DMA(t, bufb) do { const int t_ = (t); const bf16_t* src_ = wave < 4 ? Kg + (size_t)(t_ < 4 ? ML + b * 256 + t_ * 64 : b * 4096 + (t_ - 4) * 64) * 256 : Vg + t_ * 64; \
        _Pragma("unroll") for (int i = 0; i < 4; ++i) __builtin_amdgcn_global_load_lds((const unsigned*)(src_ + dgo[i]), (__attribute__((address_space(3))) unsigned*)(ldsl + (bufb) + (wave * 4 + i) * 1024), 16, 0, 0); } while (0)
    f32x16 o[4];
#pragma unroll
    for (int dt = 0; dt < 4; ++dt)
#pragma unroll
        for (int r = 0; r < 16; ++r) o[dt][r] = 0.f;
    float lsum = 0.f;
    ATT_DMA(0, 0);
    __builtin_amdgcn_s_waitcnt(0x0F70);
    __syncthreads();
    const int sw = (r32 >> 1) & 7;
    int coff[4];
#pragma unroll
    for (int ks = 0; ks < 4; ++ks) coff[ks] = ((2 * ks + hi) ^ sw) * 16;
    const int kfo = map * ATT_KMAP + r32 * ATT_KROW, vfo = ATT_VOFF + r32 * ATT_KROW;
    typedef const __attribute__((address_space(3))) bf16x8_t* fptr;
    for (int t = 0; t < NT; ++t) {
        const int buf = (t & 1) * ATT_BUF;
        if (t + 1 < NT) ATT_DMA(t + 1, ATT_BUF - buf);
        bf16x8_t pf[4];
#pragma unroll
        for (int kt = 0; kt < 2; ++kt) {
            f32x16 s;
#pragma unroll
            for (int r = 0; r < 16; ++r) s[r] = -bound2;
#pragma unroll
            for (int ks = 0; ks < 4; ++ks) { const bf16x8_t kf = *(fptr)(ldsl + buf + kfo + kt * 32 * ATT_KROW + coff[ks]); s = __builtin_amdgcn_mfma_f32_32x32x16_bf16(kf, qf[ks], s, 0, 0, 0); }
#pragma unroll
            for (int r = 0; r < 16; ++r) { s[r] = __builtin_amdgcn_exp2f(s[r]); lsum += s[r]; }
#pragma unroll
            for (int sp = 0; sp < 2; ++sp) { u32x4 w; w.x = pk2(s[8 * sp], s[8 * sp + 1]); w.y = pk2(s[8 * sp + 2], s[8 * sp + 3]); w.z = pk2(s[8 * sp + 4], s[8 * sp + 5]); w.w = pk2(s[8 * sp + 6], s[8 * sp + 7]);
                pf[2 * kt + sp] = __builtin_bit_cast(bf16x8_t, w); }
        }
#pragma unroll
        for (int dt = 0; dt < 4; ++dt)
#pragma unroll
            for (int g = 0; g < 4; ++g) { const bf16x8_t vf = *(fptr)(ldsl + buf + vfo + dt * 32 * ATT_KROW + coff[g]); o[dt] = __builtin_amdgcn_mfma_f32_32x32x16_bf16(pf[g], vf, o[dt], 0, 0, 0); }
        __builtin_amdgcn_s_waitcnt(0x0F70);
        __syncthreads();
    }
#undef ATT_DMA
    lsum = swap32_sum(lsum, lsum);
    float* LW = (float*)(lds + ATT_LW) + wave * 32;
    if (hi == 0) LW[r32] = lsum;
    float* EX = (float*)(lds + ATT_EX);
    asm volatile("s_waitcnt lgkmcnt(0)" ::: "memory");
    float il[16];
#pragma unroll
    for (int r = 0; r < 16; ++r) il[r] = 1.f / LW[crow16(r, hi)];
    if (map == 1) {
#pragma unroll
        for (int dt = 0; dt < 4; ++dt)
#pragma unroll
            for (int r = 0; r < 16; ++r) EX[(qg * 32 + crow16(r, hi)) * 128 + dt * 32 + r32] = o[dt][r] * il[r] * lam;
    }
    __syncthreads();
    if (map == 0) {
        float ss[16];
#pragma unroll
        for (int r = 0; r < 16; ++r) ss[r] = 0.f;
#pragma unroll
        for (int dt = 0; dt < 4; ++dt)
#pragma unroll
            for (int r = 0; r < 16; ++r) { const float v = o[dt][r] * il[r] - EX[(qg * 32 + crow16(r, hi)) * 128 + dt * 32 + r32]; o[dt][r] = v; ss[r] += v * v; }
#pragma unroll
        for (int r = 0; r < 16; ++r) { float x = row_sum16(ss[r]); x = swap16_sum(x, x);
            ss[r] = (1.f - lam_init(l)) / sqrtf(x * (1.f / 128.f) + EPS); }
        bf16_t* stg = (bf16_t*)(lds + ATT_STG + qg * 32 * ATT_STGROW);
#pragma unroll
        for (int dt = 0; dt < 4; ++dt) { const float sg = a.in[13][l * 128 + dt * 32 + r32];
#pragma unroll
            for (int r = 0; r < 16; ++r) stg[crow16(r, hi) * (ATT_STGROW / 2) + dt * 32 + r32] = (bf16_t)f2bf(o[dt][r] * ss[r] * sg); }
        asm volatile("s_waitcnt lgkmcnt(0)" ::: "memory");
#pragma unroll
        for (int i = 0; i < 8; ++i) { const int id = lane + 64 * i, row = id >> 4, c = id & 15;
            *(u32x4*)(MIX + (size_t)(qrow0 + row) * D + h * 128 + c * 8) = *(const u32x4*)((const unsigned char*)stg + row * ATT_STGROW + c * 16); }
    }
    __syncthreads();
}
constexpr int AT2_LW = 2 * ATT_BUF, AT2_STG = AT2_LW + 2048;
template <bool SHIFT> DEV void attn_unit2(const Args& a, int l, int b, int h, int qb, bool ctx, float lam, float bound2, float oml, unsigned char* lds) {
    const int tid = ltid(), lane = tid & 63, wave = __builtin_amdgcn_readfirstlane(tid >> 6), r32 = lane & 31, hi = lane >> 5;
    const bf16_t* Y = (const bf16_t*)(a.ws + WS_Y); const bf16_t* VT = (const bf16_t*)(a.ws + WS_VT); bf16_t* MIX = (bf16_t*)(a.ws + WS_MIX);
    const int NT = ctx ? 4 : 68;
    const float shift = bound2 > 96.f ? bound2 - 96.f : 0.f;
    const int qrow0 = (ctx ? ML + b * 256 : b * 4096) + qb * 256 + wave * 32;
    bf16x8_t qf[2][4];
    { const bf16_t* qp = Y + (size_t)(h >> 1) * YARR + (size_t)(qrow0 + r32) * 256 + (h & 1) * 128 + 8 * hi;
#pragma unroll
        for (int m = 0; m < 2; ++m)
#pragma unroll
            for (int s = 0; s < 4; ++s) qf[m][s] = *(const bf16x8_t*)(qp + m * 64 + 16 * s); }
    const bf16_t* Kg = Y + (size_t)(2 + (h >> 1)) * YARR + (h & 1) * 128;
    const bf16_t* Vg = VT + (size_t)(b * 4 + h) * 128 * 4352;
    typedef __attribute__((address_space(3))) unsigned char* lptr;
    lptr ldsl = (lptr)lds;
#define ATT_DMA(t, bufb) do { const int t_ = (t); const int ln_ = ltid() & 63; const bool isk_ = wave < 4; \
        const bf16_t* src_ = isk_ ? Kg + (size_t)(t_ < 4 ? ML + b * 256 + t_ * 64 : b * 4096 + (t_ - 4) * 64) * 256 + (wave >> 1) * 64 + (wave & 1) * 32 * 256 : Vg + t_ * 64 + (size_t)(wave - 4) * 32 * 4352; \
        const int st_ = isk_ ? 256 : 4352, ca_ = (ln_ & 7) ^ (ln_ >> 4), g0_ = (ln_ >> 3) * st_ + ca_ * 8, g1_ = (ln_ >> 3) * st_ + (ca_ ^ 4) * 8; \
        _Pragma("unroll") for (int i = 0; i < 4; ++i) \
            __builtin_amdgcn_global_load_lds((const unsigned*)(src_ + (size_t)(i * 8 * st_) + ((i & 1) ? g1_ : g0_)), (__attribute__((address_space(3))) unsigned*)(ldsl + (bufb) + (wave * 4 + i) * 1024), 16, 0, 0); } while (0)
    f32x16 o0[4], o1[4];
#pragma unroll
    for (int dt = 0; dt < 4; ++dt)
#pragma unroll
        for (int r = 0; r < 16; ++r) { o0[dt][r] = 0.f; o1[dt][r] = 0.f; }
    float lsum0 = 0.f, lsum1 = 0.f;
    ATT_DMA(0, 0);
    __builtin_amdgcn_s_waitcnt(0x0F70);
    __syncthreads();
    typedef const __attribute__((address_space(3))) bf16x8_t* fptr;
#pragma unroll 1
    for (int t = 0; t < NT; ++t) {
        const int buf = (t & 1) * ATT_BUF;
        if (t + 1 < NT) ATT_DMA(t + 1, ATT_BUF - buf);
        const int ln = ltid() & 63;
        const int r32l = ln & 31, hil = ln >> 5, sw = (r32l >> 1) & 7, kfo = r32l * ATT_KROW, vfo = ATT_VOFF + r32l * ATT_KROW;
        int coff[4];
#pragma unroll
        for (int ks = 0; ks < 4; ++ks) coff[ks] = ((2 * ks + hil) ^ sw) * 16;
#pragma unroll
        for (int kt = 0; kt < 2; ++kt) {
            bf16x8_t pf0[2], pf1[2];
#pragma unroll
            for (int m = 0; m < 2; ++m) {
                f32x16 s;
#pragma unroll
                for (int r = 0; r < 16; ++r) s[r] = 0.f;
#pragma unroll
                for (int ks = 0; ks < 4; ++ks) { const bf16x8_t kf = *(fptr)(ldsl + buf + m * ATT_KMAP + kfo + kt * 32 * ATT_KROW + coff[ks]); s = __builtin_amdgcn_mfma_f32_32x32x16_bf16(kf, qf[m][ks], s, 0, 0, 0); }
                if (SHIFT) {
#pragma unroll
                    for (int r = 0; r < 16; ++r) s[r] -= shift; }
                float ls = 0.f;
#pragma unroll
                for (int r = 0; r < 16; ++r) { s[r] = __builtin_amdgcn_exp2f(s[r]); ls += s[r]; }
                if (m == 0) lsum0 += ls; else lsum1 += ls;
#pragma unroll
                for (int sp = 0; sp < 2; ++sp) { u32x4 w; w.x = pk2(s[8 * sp], s[8 * sp + 1]); w.y = pk2(s[8 * sp + 2], s[8 * sp + 3]); w.z = pk2(s[8 * sp + 4], s[8 * sp + 5]); w.w = pk2(s[8 * sp + 6], s[8 * sp + 7]);
                    if (m == 0) pf0[sp] = __builtin_bit_cast(bf16x8_t, w); else pf1[sp] = __builtin_bit_cast(bf16x8_t, w); }
            }
#pragma unroll
            for (int dt = 0; dt < 4; ++dt)
#pragma unroll
                for (int sp = 0; sp < 2; ++sp) { const bf16x8_t vf = *(fptr)(ldsl + buf + vfo + dt * 32 * ATT_KROW + coff[2 * kt + sp]);
                    o0[dt] = __builtin_amdgcn_mfma_f32_32x32x16_bf16(pf0[sp], vf, o0[dt], 0, 0, 0); o1[dt] = __builtin_amdgcn_mfma_f32_32x32x16_bf16(pf1[sp], vf, o1[dt], 0, 0, 0); }
        }
        __builtin_amdgcn_s_waitcnt(0x0F70);
        __syncthreads();
    }
#undef ATT_DMA
    lsum0 = swap32_sum(lsum0, lsum0); lsum1 = swap32_sum(lsum1, lsum1);
    const int lane_e = ltid() & 63, r32e = lane_e & 31, hie = lane_e >> 5;
    float* LW = (float*)(lds + AT2_LW) + wave * 64;
    if (hie == 0) { LW[r32e] = lsum0; LW[32 + r32e] = lsum1; }
    asm volatile("s_waitcnt lgkmcnt(0)" ::: "memory");
    float ss[16];
#pragma unroll
    for (int r = 0; r < 16; ++r) { const float il0 = 1.f / LW[crow16(r, hie)], il1 = lam / LW[32 + crow16(r, hie)]; float acc = 0.f;
#pragma unroll
        for (int dt = 0; dt < 4; ++dt) { const float v = o0[dt][r] * il0 - o1[dt][r] * il1; o0[dt][r] = v; acc += v * v; }
        ss[r] = acc; }
#pragma unroll
    for (int r = 0; r < 16; ++r) { float x = row_sum16(ss[r]); x = swap16_sum(x, x);
        ss[r] = oml / sqrtf(x * (1.f / 128.f) + EPS); }
    bf16_t* stg = (bf16_t*)(lds + AT2_STG + wave * 32 * ATT_STGROW);
#pragma unroll
    for (int dt = 0; dt < 4; ++dt) { const float sg = a.in[13][l * 128 + dt * 32 + r32e];
#pragma unroll
        for (int r = 0; r < 16; ++r) stg[crow16(r, hie) * (ATT_STGROW / 2) + dt * 32 + r32e] = (bf16_t)f2bf(o0[dt][r] * ss[r] * sg); }
    asm volatile("s_waitcnt lgkmcnt(0)" ::: "memory");
    const int lane_s = ltid() & 63;
#pragma unroll
    for (int i = 0; i < 8; ++i) { const int id = lane_s + 64 * i, row = id >> 4, c = id & 15;
        *(u32x4*)((bf16_t*)(a.ws + WS_MIX) + (size_t)((ctx ? ML + b * 256 : b * 4096) + qb * 256 + wave * 32 + row) * D + h * 128 + c * 8) = *(const u32x4*)((const unsigned char*)stg + row * ATT_STGROW + c * 16); }
    __syncthreads();
}
DEV void p4_attn_mfma(const Args& a, int l, unsigned char* lds) {
    const float lam = __uint_as_float(__builtin_amdgcn_readfirstlane(__float_as_uint(att_lambda(a, l)))), bound2 = __uint_as_float(__builtin_amdgcn_readfirstlane(__float_as_uint(att_bound2(a, l))));
    const float oml = __uint_as_float(__builtin_amdgcn_readfirstlane(__float_as_uint(1.f - lam_init(l))));
    const int nlat = NB * 4 * 16, nctx = l == 0 ? NB * 4 : 0;
    for (int it = blockIdx.x; it < nlat + nctx; it += gridDim.x) {
        const bool ctx = it >= nlat; const int i2 = it - nlat;
        const int qb = ctx ? 0 : (it & 15), h = ctx ? (i2 & 3) : ((it >> 4) & 3), b = ctx ? (i2 >> 2) : (it >> 6);
        if (bound2 > 96.f) attn_unit2<true>(a, l, b, h, qb, ctx, lam, bound2, oml, lds); else attn_unit2<false>(a, l, b, h, qb, ctx, lam, bound2, oml, lds);
    }
}
DEV void p4_attn_simple(const Args& a, int l, float* lds) {
    const float lam = att_lambda(a, l), bound2 = att_bound2(a, l);
    const int nlat = NB * 4 * 64, nctx = l == 0 ? NB * 4 * 4 : 0;
    for (int it = blockIdx.x; it < nlat + nctx; it += gridDim.x) {
        if (it < nlat) { const int qb = it & 63, h = (it >> 6) & 3, b = it >> 8; attn_simple_item(a, l, b, h, qb, false, lam, bound2, lds); }
        else { const int i2 = it - nlat, qb = i2 & 3, h = (i2 >> 2) & 3, b = i2 >> 4; attn_simple_item(a, l, b, h, qb, true, lam, bound2, lds); }
    }
}

template <int R, bool LAT> DEV void p7_rows(const Args& a, int l, const float* RW, int row_lo, int ngroups, int lane, int gw, int NGW) {
    unsigned char* XN8 = a.ws + WS_XN; bf16_t* XN = (bf16_t*)(a.ws + WS_XN); float* PL = (float*)(a.ws + WS_PROBL); float* PC = (float*)(a.ws + WS_PROBC);
    const int b3 = (lane >> 3) & 1, b2 = (lane >> 2) & 1, my_e = (lane >> 5) * 8 + ((lane >> 4) & 1) * 4 + b3 * 2 + b2;
    constexpr bool lat = LAT;
    u32x2 pre[LAT ? R : 1][4]; f32x4 prf[LAT ? 1 : R][4];
#define P7_LOAD(gg) do { const int r0_ = row_lo + (gg) * R; \
        if constexpr (LAT) { _Pragma("unroll") for (int q = 0; q < R; ++q) { const bf16_t* s_ = resrow(a, r0_ + q); _Pragma("unroll") for (int j = 0; j < 4; ++j) pre[q][j] = *(const u32x2*)(s_ + 256 * j + 4 * lane); } } \
        else { _Pragma("unroll") for (int q = 0; q < R; ++q) { const float* s_ = (const float*)(a.ws + WS_XC) + (size_t)(r0_ + q - ML) * D; _Pragma("unroll") for (int j = 0; j < 4; ++j) prf[q][j] = *(const f32x4*)(s_ + 256 * j + 4 * lane); } } } while (0)
    if (gw < ngroups) P7_LOAD(gw);
    for (int g = gw; g < ngroups; g += NGW) {
        const int r0 = row_lo + g * R;
        f32x4 v[R][4];
#pragma unroll
        for (int q = 0; q < R; ++q)
#pragma unroll
            for (int j = 0; j < 4; ++j) { if constexpr (LAT) v[q][j] = (f32x4){bf2f(pre[q][j].x & 0xffffu), bf2f(pre[q][j].x >> 16), bf2f(pre[q][j].y & 0xffffu), bf2f(pre[q][j].y >> 16)}; else v[q][j] = prf[q][j]; }
        if (g + NGW < ngroups) P7_LOAD(g + NGW);
        float rstd[R];
#pragma unroll
        for (int q = 0; q < R; ++q) { float ss = 0.f;
#pragma unroll
            for (int j = 0; j < 4; ++j) ss += (v[q][j].x * v[q][j].x + v[q][j].y * v[q][j].y) + (v[q][j].z * v[q][j].z + v[q][j].w * v[q][j].w);
            rstd[q] = __builtin_amdgcn_rsqf(wave_sum(ss) * (1.f / D) + EPS); }
        const float* gp = a.in[7] + l * D; const float* sh = modp(a, l, modrow(r0), 3); const float* sc = modp(a, l, modrow(r0), 4);
#pragma unroll
        for (int j = 0; j < 4; ++j) {
            const int c0 = 256 * j + 4 * lane; const f32x4 gm = *(const f32x4*)(gp + c0) * (1.f + *(const f32x4*)(sc + c0)), s0 = *(const f32x4*)(sh + c0);
#pragma unroll
            for (int q = 0; q < R; ++q) { const f32x4 y = v[q][j] * rstd[q] * gm + s0;
                if (USE_FP8_MOE1) *(unsigned*)(XN8 + (size_t)(r0 + q) * D + c0) = pk_fp8x4(y.x, y.y, y.z, y.w); else { float t[4] = {y.x, y.y, y.z, y.w}; st4bf(XN + (size_t)(r0 + q) * D + c0, t); }
                v[q][j] = y; }
        }
        f32x2_t lg2[R][8];
#pragma unroll
        for (int q = 0; q < R; ++q)
#pragma unroll
            for (int e = 0; e < 8; ++e) lg2[q][e] = (f32x2_t){0.f, 0.f};
        { f32x4 wc[4], wn[4];
#pragma unroll
            for (int e4 = 0; e4 < 4; ++e4) wc[e4] = *(const f32x4*)(RW + ((e4 * 64 + lane) * 4));
#pragma unroll
            for (int k = 0; k < 16; ++k) { const int j = k >> 2, i = k & 3;
                if (k + 1 < 16) {
#pragma unroll
                    for (int e4 = 0; e4 < 4; ++e4) wn[e4] = *(const f32x4*)(RW + ((((k + 1) * 4 + e4) * 64 + lane) * 4)); }
#pragma unroll
                for (int e4 = 0; e4 < 4; ++e4)
#pragma unroll
                    for (int q = 0; q < R; ++q) { const float t = i == 0 ? v[q][j].x : i == 1 ? v[q][j].y : i == 2 ? v[q][j].z : v[q][j].w;
                        const f32x2_t t2 = {t, t};
                        lg2[q][e4 * 2] = __builtin_elementwise_fma(t2, (f32x2_t){wc[e4].x, wc[e4].y}, lg2[q][e4 * 2]); lg2[q][e4 * 2 + 1] = __builtin_elementwise_fma(t2, (f32x2_t){wc[e4].z, wc[e4].w}, lg2[q][e4 * 2 + 1]); }
                __builtin_amdgcn_sched_barrier(0);
#pragma unroll
                for (int e4 = 0; e4 < 4; ++e4) wc[e4] = wn[e4]; } }
        float a1 = 0.f;
#pragma unroll
        for (int q = 0; q < R; ++q) { float a8[8], a4[4], a2[2], t1;
#pragma unroll
            for (int i = 0; i < 8; ++i) a8[i] = swap32_sum(lg2[q][i >> 1][i & 1], lg2[q][4 + (i >> 1)][i & 1]);
#pragma unroll
            for (int i = 0; i < 4; ++i) a4[i] = swap16_sum(a8[i], a8[4 + i]);
#pragma unroll
            for (int i = 0; i < 2; ++i) { const float snd = b3 ? a4[i] : a4[2 + i], kp = b3 ? a4[2 + i] : a4[i]; a2[i] = kp + dppf<DPP_X8>(snd); }
            { const float snd = b2 ? a2[0] : a2[1], kp = b2 ? a2[1] : a2[0]; t1 = kp + dppf<DPP_X7>(snd); }
            t1 = row_sum4(t1);
            if (R == 1 || (lane & 3) == q) a1 = t1; }
        float mx = a1;
        mx = fmaxf(mx, dppf<DPP_X7>(dppf<DPP_X3>(mx))); mx = fmaxf(mx, dppf<DPP_X8>(mx)); mx = swap16_max(mx); mx = swap32_max(mx);
        const float pe = __builtin_amdgcn_exp2f((a1 - mx) * 1.4426950408889634f); float den = pe;
        den += dppf<DPP_X7>(dppf<DPP_X3>(den)); den += dppf<DPP_X8>(den); den = swap16_sum(den, den); den = swap32_sum(den, den);
        if (R == 4 || (lane & 3) == 0) { const float p = pe * __builtin_amdgcn_rcpf(den); const int r = r0 + (R == 4 ? (lane & 3) : 0);
            if (r < ML) PL[((size_t)(r >> 12) * 16 + my_e) * 4096 + (r & 4095)] = p; else PC[((size_t)((r - ML) >> 8) * 16 + my_e) * 256 + ((r - ML) & 255)] = p; }
    }
#undef P7_LOAD
}
DEV void p7_norm2_router(const Args& a, int l, float* lds) {
    const int tid = ltid(), lane = tid & 63, wave = tid >> 6;
    const int gw = blockIdx.x * NWAVES + wave, NGW = gridDim.x * NWAVES;
    float* RW = lds;
    for (int i = tid; i < 1024 * 16 / 4; i += NTHREADS) {
        const int col = i >> 2, e4 = i & 3, jj = col >> 8, ln = (col & 255) >> 2, ii = col & 3;
        *(f32x4*)(RW + ((((jj * 4 + ii) * 4 + e4) * 64 + ln) * 4)) = *(const f32x4*)(a.in[22] + (size_t)l * 1024 * 16 + i * 4); }
    __syncthreads();
    p7_rows<4, true>(a, l, RW, 0, ML / 4, lane, gw, NGW);
    if (l == 0) p7_rows<1, false>(a, l, RW, ML, MC, lane, gw, NGW);
}
DEV void p8_topk(const Args& a, int l, float* ldsf) {
    const int tid = ltid(), lane = tid & 63, wave = tid >> 6;
    unsigned* hist = (unsigned*)ldsf;
    unsigned* res = hist + 320;
    unsigned* wtot = hist + 384;
    int* sidx = (int*)(hist + 512);
    const float* PL = (const float*)(a.ws + WS_PROBL); const float* PC = (const float*)(a.ws + WS_PROBC);
    int* IDX = (int*)(a.ws + WS_IDX); float* AFF = (float*)(a.ws + WS_AFF); int* SEL = (int*)(a.ws + WS_SEL);
    const bf16_t* XN = (const bf16_t*)(a.ws + WS_XN); bf16_t* XG = (bf16_t*)(a.ws + WS_XG);
    const int nitems = l == 0 ? 256 : 128;
    for (int it = blockIdx.x; it < nitems; it += gridDim.x) {
        const bool isctx = it >= 128; const int be = it & 127, b = be >> 4, e = be & 15;
        const int k = isctx ? CAPC : CAPL;
        const float* p = isctx ? PC + (size_t)(b * 16 + e) * 256 : PL + (size_t)(b * 16 + e) * 4096;
        const int rowbase = isctx ? ML + b * 256 : b * 4096, slotbase = isctx ? NB * CAPL + b * CAPC : b * CAPL;
        const int cnt = isctx ? (tid < 256 ? 1 : 0) : 8, i0 = isctx ? tid : tid * 8;
        unsigned key[8];
#pragma unroll
        for (int j = 0; j < 8; ++j) key[j] = j < cnt ? __float_as_uint(p[i0 + j]) : 0u;
        unsigned prefix = 0u, mask = 0u; int krem = k;
        for (int pass = 0; pass < 4; ++pass) {
            const int shift = 24 - 8 * pass;
            if (tid < 257) hist[tid] = 0u;
            __syncthreads();
#pragma unroll
            for (int j = 0; j < 8; ++j) if (j < cnt && (key[j] & mask) == prefix) atomicAdd(&hist[(key[j] >> shift) & 255u], 1u);
            __syncthreads();

            if (wave == 0) {
                const unsigned h0 = hist[4 * lane], h1 = hist[4 * lane + 1], h2 = hist[4 * lane + 2], h3 = hist[4 * lane + 3], tot = h0 + h1 + h2 + h3;
                unsigned sfx = tot;
#pragma unroll
                for (int o = 1; o < 64; o <<= 1) { const unsigned t = __shfl_down(sfx, o); if (lane + o < 64) sfx += t; }
                const unsigned above = sfx - tot, s3 = above + h3, s2 = s3 + h2, s1 = s2 + h1, s0 = s1 + h0, kr = (unsigned)krem;
                if (s3 >= kr && above < kr) { res[0] = 4 * lane + 3; res[1] = kr - above; }
                else if (s2 >= kr && s3 < kr) { res[0] = 4 * lane + 2; res[1] = kr - s3; }
                else if (s1 >= kr && s2 < kr) { res[0] = 4 * lane + 1; res[1] = kr - s2; }
                else if (s0 >= kr && s1 < kr) { res[0] = 4 * lane; res[1] = kr - s1; }
            }
            __syncthreads();
            prefix |= res[0] << shift; mask |= 255u << shift; krem = (int)res[1];
            __syncthreads();
        }
        const unsigned Tk = prefix;
        unsigned cntp = 0u;
#pragma unroll
        for (int j = 0; j < 8; ++j) if (j < cnt) cntp += (key[j] > Tk ? 1u : 0u) + (key[j] == Tk ? 65536u : 0u);
        unsigned sc = cntp;
#pragma unroll
        for (int o = 1; o < 64; o <<= 1) { const unsigned t = __shfl_up(sc, o); if (lane >= o) sc += t; }
        if (lane == 63) wtot[wave] = sc;
        __syncthreads();
        unsigned woff = 0u;
        for (int w = 0; w < wave; ++w) woff += wtot[w];
        unsigned ex = woff + sc - cntp;
        unsigned gtr = ex & 0xffffu, eqr = ex >> 16;
        const int total_gt = k - krem;
#pragma unroll
        for (int j = 0; j < 8; ++j) if (j < cnt) {
            int slot = -1;
            if (key[j] > Tk) { slot = (int)gtr; ++gtr; }
            else if (key[j] == Tk) { if ((int)eqr < krem) slot = total_gt + (int)eqr; ++eqr; }
            const int row = rowbase + i0 + j;
            SEL[(size_t)row * 16 + e] = slot >= 0 ? slotbase + slot : -1;
            if (slot >= 0) { IDX[e * SLOTS + slotbase + slot] = row; AFF[e * SLOTS + slotbase + slot] = __uint_as_float(key[j]); sidx[slot] = row; }
        }
        __syncthreads();
    }
}
DEV void p8_gather(const Args& a, int l) {
    const int tid = ltid(), lane = tid & 63, wave = tid >> 6;
    const int gw = blockIdx.x * NWAVES + wave, NGW = gridDim.x * NWAVES;
    const int* IDX = (const int*)(a.ws + WS_IDX); const unsigned char* XN8 = a.ws + WS_XN; unsigned char* XG8 = a.ws + WS_XG;
    const int per_e = l == 0 ? SLOTS : NB * CAPL, total = 16 * per_e;
    for (int base = gw * 8; base < total; base += NGW * 8) {
        u32x4 v[8]; size_t dsto[8];
#pragma unroll
        for (int i = 0; i < 8; ++i) { const int R = base + i, e = R / per_e, s = R - e * per_e; const int row = __builtin_amdgcn_readfirstlane(IDX[e * SLOTS + s]);
            dsto[i] = ((size_t)e * SLOTS + s) * 1024; v[i] = *(const u32x4*)(XN8 + (size_t)row * 1024 + lane * 16); }
#pragma unroll
        for (int i = 0; i < 8; ++i) *(u32x4*)(XG8 + dsto[i] + lane * 16) = v[i];
    }
}


#define LAS __attribute__((address_space(3)))
#define XB_TMO      128
#define XB_XCNT(j)  (256  + 64 * (j))
#define XB_XSUB(j)  (1280 + 64 * (j))
#define XB_XGEN(j)  (2304 + 64 * (j))
#define XB_TOP      3328
#define XB_TOPGEN   3392
#define XCD_BAR_WORDS 3456
#define XB_SPIN_CAP (1u << 18)

__device__ __forceinline__ unsigned xb_ld(unsigned* p)              { return __hip_atomic_load(p, __ATOMIC_RELAXED, __HIP_MEMORY_SCOPE_AGENT); }
__device__ __forceinline__ unsigned xb_add(unsigned* p, unsigned v) { return __hip_atomic_fetch_add(p, v, __ATOMIC_RELAXED, __HIP_MEMORY_SCOPE_AGENT); }
__device__ __forceinline__ unsigned xb_xcc_id() { return (unsigned)__builtin_amdgcn_s_getreg((3 << 11) | 20) & 0xFu; }
#define XB_SPIN(cond, bar) do { unsigned _sp = 0; while (cond) { __builtin_amdgcn_s_sleep(1); \
    if ((++_sp & 255u) == 0u) { if (xb_ld(&(bar)[XB_TMO])) break; if (_sp > XB_SPIN_CAP) { atomicAdd(&(bar)[XB_TMO], 1u); break; } } } } while (0)

struct XcdBarrier {
    unsigned* bar; unsigned x;
    volatile LAS unsigned* st;
};

__device__ __forceinline__ XcdBarrier xcd_barrier_post(unsigned* bar, volatile LAS unsigned* st) {
    XcdBarrier b; b.bar = bar; b.x = xb_xcc_id(); b.st = st;
    if (threadIdx.x == 0) (void)xb_add(&bar[XB_XCNT(b.x)], 1u);
    return b;
}
__device__ __forceinline__ void xcd_barrier_complete(unsigned* bar, unsigned x, unsigned& nloc, unsigned& nx) {
    const unsigned G = gridDim.x * gridDim.y * gridDim.z;
    unsigned sum, cnt, mine, sp = 0u;
    for (;;) {
        sum = 0u; cnt = 0u; mine = 0u;
#pragma unroll
        for (unsigned j = 0; j < 16; ++j) { const unsigned c = xb_ld(&bar[XB_XCNT(j)]); sum += c; cnt += (c > 0u) ? 1u : 0u; mine = (j == x) ? c : mine; }
        if (sum == G) break;
        __builtin_amdgcn_s_sleep(1);
        if ((++sp & 255u) == 0u) { if (xb_ld(&bar[XB_TMO])) break; if (sp > XB_SPIN_CAP) { atomicAdd(&bar[XB_TMO], 1u); break; } }
    }
    nloc = mine > 0u ? mine : 1u; nx = cnt > 0u ? cnt : 1u;
}

__device__ __forceinline__ void xcd_barrier(const XcdBarrier& b) {
    asm volatile("s_waitcnt vmcnt(0)" ::: "memory");
    __syncthreads();
    if (threadIdx.x == 0) {
        unsigned* bar = b.bar;
        __builtin_amdgcn_s_waitcnt(0);
        unsigned nloc = b.st[0], nx = b.st[1];
        if (nloc == 0u) { xcd_barrier_complete(bar, b.x, nloc, nx); b.st[0] = nloc; b.st[1] = nx; }
        const unsigned old = xb_add(&bar[XB_XSUB(b.x)], 1u);
        const unsigned gen = old / nloc;
        if (old + 1u == (gen + 1u) * nloc) {
            __builtin_amdgcn_fence(__ATOMIC_RELEASE, "agent");
            asm volatile("s_waitcnt vmcnt(0)" ::: "memory");
            const unsigned og = xb_add(&bar[XB_TOP], 1u);
            const unsigned tg = og / nx;
            if (og + 1u == (tg + 1u) * nx) xb_add(&bar[XB_TOPGEN], 1u);
            else XB_SPIN(xb_ld(&bar[XB_TOPGEN]) == tg, bar);
            __builtin_amdgcn_fence(__ATOMIC_ACQUIRE, "agent");
            xb_add(&bar[XB_XGEN(b.x)], 1u);
            asm volatile("s_waitcnt vmcnt(0)" ::: "memory");
        } else {
            XB_SPIN(xb_ld(&bar[XB_XGEN(b.x)]) == gen, bar);
            __builtin_amdgcn_fence(__ATOMIC_ACQUIRE, "agent");
            asm volatile("s_waitcnt vmcnt(0)" ::: "memory");
        }
    }
    __syncthreads();
}
constexpr int NPHASES = 22;
#ifndef DUP
#define DUP 0
#endif
#define REP(bit) for (int rep_ = 0; rep_ < (((DUP) & (bit)) ? 2 : 1); ++rep_)
template <int PH> DEV void run_phase(const Args& a, float* lds) {
    if constexpr (PH == 0) { if (PM & 1) p0_mod(a, lds); }
    else if constexpr (PH == NPHASES - 1) { if ((PM & 2) && (PM & 32768)) p1_norm<2>(a); }
    else {
        constexpr int l = (PH - 1) / 10, s = (PH - 1) % 10;
        if constexpr (s == 0) { if (PM & 4) { REP(2048) { p1_weights(a, l, lds); } if (l == 0) p1_norm<0>(a); else p1_norm<1, (PM & 32768) != 0>(a); } }
        if constexpr (s == 1) { if (PM & 8) REP(1) { if (USE_MFMA_GEMM) p2_inproj_mfma(a, l, (unsigned char*)lds); else p2_inproj_simple(a, l, lds); } }
        if constexpr (s == 2) { if (PM & 16) { if (USE_MFMA_ATTN) { REP(4096) { p3_vt(a, lds); __syncthreads(); } } } if (PM & 32) REP(2) { if (USE_MFMA_RET) p3_ret_prep(a, l, (unsigned char*)lds); else p3_retU(a, l, lds); } __syncthreads(); if (PM & 64) REP(4) { if (USE_MFMA_LRU) p3_lru_agg_mfma(a, l, lds); else p3_lru_agg(a, l, lds); } }
        if constexpr (s == 3) { if (PM & 128) { p4_lru_carry(a, lds); p4_ret_scan(a, l); } if (PM & 256) REP(8) { if (USE_MFMA_ATTN) p4_attn_mfma(a, l, (unsigned char*)lds); else p4_attn_simple(a, l, lds); } }
        if constexpr (s == 4) { if (PM & 512) REP(16) { if (USE_MFMA_RET) p5_ret_out_dma(a, l, (unsigned char*)lds); else p5_ret_out(a, l, lds); } __syncthreads(); if (PM & 1024) REP(32) { if (USE_MFMA_LRU) p5_lru_out_mfma(a, l, lds); else p5_lru_out(a, l, lds); } }
        if constexpr (s == 5) { if (PM & 2048) { if (USE_MFMA_GEMM) p6_outproj_mfma(a, l, (unsigned char*)lds); else p6_outproj_simple(a, l, lds); } }
        if constexpr (s == 6) { if (PM & 4096) REP(128) { p7_norm2_router(a, l, lds); __syncthreads(); } }
        if constexpr (s == 7) { if (PM & 8192) REP(256) { p8_topk(a, l, lds); } }
        if constexpr (s == 8) { if (PM & 16384) REP(512) { if (USE_MFMA_GEMM) p9_moe1_mfma(a, l, (unsigned char*)lds); else p9_moe1_simple(a, l, lds); } }
        if constexpr (s == 9) { if (PM & 32768) REP(1024) { if (USE_MFMA_GEMM) p10_moe2_mfma(a, l, (unsigned char*)lds); else p10_moe2_simple(a, l, lds); } }
    }
}
typedef const __attribute__((address_space(4))) Args* KArgP;
template <int PH> DEV void run_from(KArgP ap, float* lds, const XcdBarrier& bar) {
    asm volatile("" : "+s"(ap));
    run_phase<PH>(*(const Args*)ap, lds);
    if constexpr (PH + 1 < NPHASES) {
        if constexpr (PH == 0) { if (((const Args*)ap)->ph_lo < 0) cg::this_grid().sync(); }
        xcd_barrier(bar);
        run_from<PH + 1>(ap, lds, bar);
    }
}
template <int PH> DEV void run_one(const Args& a, float* lds, int ph) {
    if (ph == PH) { run_phase<PH>(a, lds); return; }
    if constexpr (PH + 1 < NPHASES) run_one<PH + 1>(a, lds, ph);
}
__global__ void __launch_bounds__(NTHREADS, 2) mega(Args a) {
    extern __shared__ __attribute__((aligned(16))) unsigned char lds_raw[];
    float* lds = (float*)lds_raw;

#if N_LAUNCH_MODE == 1
    volatile LAS unsigned* bst = (volatile LAS unsigned*)((LAS unsigned char*)lds_raw + (LDS_BYTES - 64));
    if (ltid() < 16) bst[ltid()] = 0u;
    __syncthreads();
    XcdBarrier bar = xcd_barrier_post((unsigned*)(a.ws + WS_CTL) + 4096, bst);
    run_from<0>((KArgP)__builtin_amdgcn_kernarg_segment_ptr(), lds, bar);
#else
    run_one<0>(a, lds, a.ph_lo);
#endif

}

extern "C" void kernel_launch(void* const* d_in, const int* in_sizes, int n_in, void* d_out, int out_size, void* d_ws, size_t ws_size, hipStream_t stream) {
    static int grid = 0;
    if (grid == 0) {
        if (n_in != 26 || out_size != ML * D || ws_size < WS_END) { fprintf(stderr, "kernel_launch: unexpected shapes (n_in %d out %d ws %zu)\n", n_in, out_size, ws_size); grid = -1; return; }
        int dev = 0, cus = 0, per_cu = 0;
        hipGetDevice(&dev); hipDeviceGetAttribute(&cus, hipDeviceAttributeMultiprocessorCount, dev);
        hipFuncSetAttribute((const void*)mega, hipFuncAttributeMaxDynamicSharedMemorySize, LDS_BYTES);
        hipOccupancyMaxActiveBlocksPerMultiprocessor(&per_cu, (const void*)mega, NTHREADS, LDS_BYTES);
        (void)hipGetLastError();
        if (per_cu < 1) { fprintf(stderr, "kernel_launch: occupancy query says %d blocks per CU\n", per_cu); grid = -1; return; }
        grid = cus;
    }
    if (grid < 0) return;
    hipMemsetAsync((char*)d_ws + WS_CTL, 0, 1 * MiB, stream);
    Args a{};
    for (int i = 0; i < 26; ++i) a.in[i] = (const float*)d_in[i];
    a.out = (float*)d_out; a.ws = (unsigned char*)d_ws;

#if N_LAUNCH_MODE == 1
    a.ph_lo = 0; a.ph_hi = NPHASES;
    void* args[] = {&a};
    hipError_t e = hipLaunchCooperativeKernel((const void*)mega, dim3(grid), dim3(NTHREADS), args, LDS_BYTES, stream);
    if (e != hipSuccess) fprintf(stderr, "cooperative launch failed: %s (grid %d)\n", hipGetErrorString(e), grid);
#else
#ifndef PH_STOP
#define PH_STOP NPHASES
#endif
    for (int ph = 0; ph < PH_STOP; ++ph) { a.ph_lo = ph; a.ph_hi = ph + 1; hipLaunchKernelGGL(mega, dim3(grid), dim3(NTHREADS), LDS_BYTES, stream, a); }
#endif

}
```

```cpp
#include <hip/hip_runtime.h>
#include <hip/hip_cooperative_groups.h>
#include <cstdio>
#include <cstdint>
namespace cg = cooperative_groups;
#define DEV __device__ __forceinline__
#ifndef PM
#define PM 0xffff
#endif
#ifndef USE_FP8_MOE1
#define USE_FP8_MOE1 1
#endif
#ifndef USE_FP8_MOE2
#define USE_FP8_MOE2 1
#endif
#ifndef USE_MFMA_LRU
#define USE_MFMA_LRU 1
#endif
#ifndef USE_GEMM_GATHER
#define USE_GEMM_GATHER 1
#endif
#ifndef USE_MFMA_RET
#define USE_MFMA_RET 1
#endif
#ifndef USE_MFMA_ATTN
#define USE_MFMA_ATTN 1
#endif
#ifndef USE_MFMA_GEMM
#define USE_MFMA_GEMM 1
#endif
#ifndef N_LAUNCH_MODE
#define N_LAUNCH_MODE 1
#endif

typedef unsigned short bf16_t;
typedef float f32x4 __attribute__((ext_vector_type(4)));
typedef unsigned u32x4 __attribute__((ext_vector_type(4)));
typedef unsigned u32x2 __attribute__((ext_vector_type(2)));
typedef short bf16x8_t __attribute__((ext_vector_type(8)));
typedef float f32x16 __attribute__((ext_vector_type(16)));
__device__ __forceinline__ int crow16(int r, int hi) { return (r & 3) + 8 * (r >> 2) + 4 * hi; }
typedef __bf16 bf16x2_t __attribute__((ext_vector_type(2)));
DEV float dot2bf(unsigned w, unsigned x, float acc) { return __builtin_amdgcn_fdot2_f32_bf16(__builtin_bit_cast(bf16x2_t, w), __builtin_bit_cast(bf16x2_t, x), acc, false); }

constexpr int D = 1024, NB = 8, T = 4096, TC = 256;
constexpr int ML = NB * T, MC = NB * TC, M = ML + MC;
constexpr int NE = 16, CAPL = 512, CAPC = 32, SLOTS = NB * CAPL + NB * CAPC;
constexpr int NTHREADS = 512, NWAVES = 8;
constexpr float EPS = 1e-6f;
constexpr float C2 = 0.125f * 1.4426950408889634f;
constexpr int LRU_CH = 136;
constexpr int RET_CH = 34;

constexpr size_t MiB = 1u << 20;
constexpr size_t WS_CTL = 0;
constexpr size_t WS_MOD = 1 * MiB;
constexpr size_t WS_LRUW = 1 * MiB + 512 * 1024;
constexpr size_t WS_PROBL = 2 * MiB;
constexpr size_t WS_PROBC = 4 * MiB;
constexpr size_t WS_IDX = 5 * MiB;
constexpr size_t WS_AFF = 5 * MiB + 512 * 1024;
constexpr size_t WS_SEL = 6 * MiB;
constexpr size_t WS_LAGG = 9 * MiB;
constexpr size_t WS_LCAR = 14 * MiB;
constexpr size_t WS_XC = 17 * MiB;
constexpr size_t WS_RETS = 26 * MiB;
constexpr size_t WS_WT = 60 * MiB;
constexpr size_t WT_IN = 0, WT_OUT = 6 * MiB, WT_GU = 8 * MiB, WT_DN = 72 * MiB;
constexpr size_t WS_XN = 164 * MiB;
constexpr size_t WS_Y = 232 * MiB;
constexpr size_t WS_MIX = 436 * MiB;
constexpr size_t WS_XG = 232 * MiB;
constexpr size_t WS_HID = 368 * MiB;
constexpr size_t WS_Y2 = 232 * MiB;
constexpr size_t WS_VT = 504 * MiB;
constexpr size_t WS_RVT = 540 * MiB;
constexpr size_t WS_END = 557 * MiB;
constexpr size_t YARR = (size_t)M * 256;

constexpr int LDS_BYTES = 147456;

struct Args { const float* in[26]; float* out; unsigned char* ws; int ph_lo, ph_hi; };


__device__ __forceinline__ int ltid() { int t = __builtin_amdgcn_workitem_id_x(); asm volatile("" : "+v"(t)); return t; }
namespace pg8 {
#define PG8_LAS __attribute__((address_space(3)))
typedef unsigned short bf16_t;
typedef short bf16x8 __attribute__((ext_vector_type(8)));
typedef float f32x4 __attribute__((ext_vector_type(4)));
typedef unsigned u32x4 __attribute__((ext_vector_type(4)));
typedef int i32x4 __attribute__((ext_vector_type(4)));
typedef int i32x8 __attribute__((ext_vector_type(8)));
constexpr int BM = 256, BK = 64, HALF = 128, HTB = HALF * BK * 2  , STAGE_BYTES = 8 * HTB, NXCD = 8, WGM = 8;

__host__ __device__ __forceinline__ int lds_byte(int r, int c) { const int st = (r >> 4) * 2 + (c >> 5), rr = r & 15, cc = c & 31, ob = rr * 64 + cc * 2; return st * 1024 + (ob ^ (((ob >> 9) & 1) << 5)); }
__host__ __device__ __forceinline__ void stage_rc(int b, int& R, int& C) { const int st = b / 1024, sb = b % 1024, swz = sb ^ (((sb >> 9) & 1) << 5); R = (st >> 1) * 16 + swz / 64; C = (st & 1) * 32 + (swz % 64) / 2; }
__host__ __device__ __forceinline__ int perm32(int rho) { const int n = rho >> 4, i = rho & 15; return 8 * (i >> 2) + 4 * n + (i & 3); }

struct Unit { int pm, pn; };
struct Gemm { const bf16_t* A; const bf16_t* Bt; int M, N, K; };

struct StaticOrder {
    int nM, nN, nwg, G, c;
    __host__ __device__ void init(int M, int N, int G_, int c_) { nM = M / BM; nN = N / BM; nwg = nM * nN; G = G_; c = c_; }
    __host__ __device__ bool next(int i, Unit& u) const {
        const long L = (long)i * G + c; if (L >= nwg) return false;
        int wgid = (int)L; { const int q = nwg / NXCD, r = nwg % NXCD, xcd = wgid % NXCD, off = wgid / NXCD; wgid = (xcd < r ? xcd * (q + 1) : r * (q + 1) + (xcd - r) * q) + off; }
        const int nig = WGM * nN, gid = wgid / nig, fm = gid * WGM, gsz = (nM - fm) < WGM ? (nM - fm) : WGM;
        u.pm = fm + ((wgid % nig) % gsz); u.pn = (wgid % nig) / gsz; return true;
    }
    __device__ __forceinline__ void a_ready(const Unit&) const {}
    __device__ __forceinline__ void done(const Unit&) const {}
};

__device__ __forceinline__ unsigned cvt_pk_bf16(float lo, float hi) { unsigned r; asm volatile("v_cvt_pk_bf16_f32 %0, %1, %2" : "=v"(r) : "v"(lo), "v"(hi)); return r; }
typedef float f32x2 __attribute__((ext_vector_type(2)));
__device__ __forceinline__ f32x2 gelu_pk(f32x2 v) {
    const f32x2 av = __builtin_elementwise_abs(v), d = av * 0.2316418882f + 1.0f;
    f32x2 t; t.x = __builtin_amdgcn_rcpf(d.x); t.y = __builtin_amdgcn_rcpf(d.y);
    f32x2 q = t * 0.5307027145f + (-0.7265760135f); q = q * t + 0.7107068705f; q = q * t + (-0.142248368f); q = q * t + 0.127414796f; q = q * t;
    const f32x2 s = (v * v) * (-0.72134752044f);
    f32x2 e; e.x = __builtin_amdgcn_exp2f(s.x); e.y = __builtin_amdgcn_exp2f(s.y);
    const f32x2 m = v * (q * e), r = v - m;
    f32x2 o; o.x = v.x < 0.f ? m.x : r.x; o.y = v.y < 0.f ? m.y : r.y; return o;
}

template <int ACT  > struct EpiBf16 {
    static constexpr bool PERM = true, AFTER_DRAIN = false; static_assert(ACT == 0 || ACT == 1, "EpiBf16: ACT is 0 (none) or 1 (gelu_pk)");
    bf16_t* O; int ldc; const float* bias; int split_cols; size_t split_stride; float scale0;
    __device__ __forceinline__ void operator()(const f32x4 (&acc)[2][2][4][2], const Unit& u, int wr, int wc, int fr, int fq) const {
        const int row0 = u.pm * BM + wr * 64 + fr; int colt = u.pn * BM; bf16_t* base = O;
        float sc = 1.f; if (split_cols) { const int t = colt / split_cols; base += (size_t)t * split_stride; colt -= t * split_cols; if (t == 0) sc = scale0; }
        const int col0 = colt + wc * 32 + 8 * fq, bcol0 = u.pn * BM + wc * 32 + 8 * fq;
        f32x4 bv[2][2];
#pragma unroll
        for (int bj = 0; bj < 2; ++bj)
#pragma unroll
            for (int n = 0; n < 2; ++n) bv[bj][n] = bias ? *(const f32x4*)(bias + bcol0 + bj * HALF + 4 * n) : (f32x4){0.f, 0.f, 0.f, 0.f};
#pragma unroll
        for (int ai = 0; ai < 2; ++ai)
#pragma unroll
            for (int m = 0; m < 4; ++m) { bf16_t* rowp = base + (size_t)(row0 + ai * HALF + m * 16) * ldc + col0;
#pragma unroll
                for (int bj = 0; bj < 2; ++bj) { f32x4 v0 = acc[ai][bj][m][0] + bv[bj][0], v1 = acc[ai][bj][m][1] + bv[bj][1];
                    if (ACT == 1) { f32x2 a = gelu_pk((f32x2){v0[0], v0[1]}), b = gelu_pk((f32x2){v0[2], v0[3]}), c = gelu_pk((f32x2){v1[0], v1[1]}), d = gelu_pk((f32x2){v1[2], v1[3]});
                        v0 = (f32x4){a.x, a.y, b.x, b.y}; v1 = (f32x4){c.x, c.y, d.x, d.y}; }
                    v0 = v0 * sc; v1 = v1 * sc; u32x4 w; w.x = cvt_pk_bf16(v0[0], v0[1]); w.y = cvt_pk_bf16(v0[2], v0[3]); w.z = cvt_pk_bf16(v1[0], v1[1]); w.w = cvt_pk_bf16(v1[2], v1[3]);
                    *(u32x4*)(rowp + bj * HALF) = w; } }
    }
};
template <class Epi, class Sched, bool ALIGN_EPI = false, bool SP2 = false>
__device__ __forceinline__ void gemm_phase(PG8_LAS unsigned char* lds, const Gemm g, const Sched& S, const Epi& E) {
    const int tid = ltid(), wid = __builtin_amdgcn_readfirstlane(tid >> 6), lane = tid & 63, wr = wid >> 2, wc = wid & 3, fr = lane & 15, fq = lane >> 4;
    const int K = g.K, nt = K / BK;
    unsigned voffA[2], voffB[2];
#pragma unroll
    for (int i = 0; i < 2; ++i) { int R, C; stage_rc(tid * 16 + i * 8192, R, C); const int Rb = Epi::PERM ? ((R & ~31) + perm32(R & 31)) : R;
        voffA[i] = (unsigned)(R * K + C) * 2u; voffB[i] = (unsigned)(Rb * K + C) * 2u; }
    const size_t kstep = (size_t)(BK * 2);
    const size_t hstep = (size_t)HALF * K * 2;
    const size_t tstep = 2 * hstep;
    const unsigned ldsw = (unsigned)wid * 1024u;
    const int aoff = lds_byte(wr * 64 + fr, fq * 8), boff = lds_byte(wc * 32 + fr, fq * 8);
#define PG8_SA(b, h) (((b) * 2 + (h)) * HTB)
#define PG8_SB(b, h) ((4 + (b) * 2 + (h)) * HTB)
#define PG8_STAGE(bufoff, gbase, voff) do { _Pragma("unroll") for (int _i = 0; _i < 2; ++_i) \
        __builtin_amdgcn_global_load_lds((const unsigned*)((const char*)(gbase) + (voff)[_i]), (PG8_LAS unsigned*)(lds + (bufoff) + ldsw + _i * 8192), 16, 0, 0); } while (0)
#define PG8_LDA(dst, b, h) do { _Pragma("unroll") for (int m = 0; m < 4; ++m) _Pragma("unroll") for (int k = 0; k < 2; ++k) dst[m][k] = *(const PG8_LAS bf16x8*)(lds + PG8_SA(b, h) + aoff + m * 2048 + k * 1024); } while (0)
#define PG8_LDB(dst, b, h) do { _Pragma("unroll") for (int n = 0; n < 2; ++n) _Pragma("unroll") for (int k = 0; k < 2; ++k) dst[n][k] = *(const PG8_LAS bf16x8*)(lds + PG8_SB(b, h) + boff + n * 2048 + k * 1024); } while (0)
#define PG8_MMA(ai, bj, At, Bt) do { __builtin_amdgcn_s_setprio(1); _Pragma("unroll") for (int m = 0; m < 4; ++m) _Pragma("unroll") for (int n = 0; n < 2; ++n) _Pragma("unroll") for (int k = 0; k < 2; ++k) \
        acc[ai][bj][m][n] = __builtin_amdgcn_mfma_f32_16x16x32_bf16(Bt[n][k], At[m][k], acc[ai][bj][m][n], 0, 0, 0); __builtin_amdgcn_s_setprio(0); } while (0)
#define PG8_WAIT_V(n) asm volatile("s_waitcnt vmcnt(" #n ")" ::: "memory")
#define PG8_WAIT_L(n) asm volatile("s_waitcnt lgkmcnt(" #n ")" ::: "memory")
#define PG8_BAR __builtin_amdgcn_s_barrier()
#define PG8_SCHED __builtin_amdgcn_sched_barrier(0)
    Unit cur, nxt; int ui = 0;
    if (!S.next(0, cur)) return;
    f32x4 acc[2][2][4][2];
#pragma unroll
    for (int a = 0; a < 2; ++a)
#pragma unroll
        for (int b = 0; b < 2; ++b)
#pragma unroll
            for (int m = 0; m < 4; ++m)
#pragma unroll
                for (int n = 0; n < 2; ++n) acc[a][b][m][n] = (f32x4){0.f, 0.f, 0.f, 0.f};
    bf16x8 At[4][2], B0[2][2], B1[2][2];
    const char* cA = (const char*)g.A + (size_t)cur.pm * tstep; const char* cB = (const char*)g.Bt + (size_t)cur.pn * tstep;
    S.a_ready(cur);
    if constexpr (SP2) {
        PG8_STAGE(PG8_SB(0, 0), cB, voffB); PG8_STAGE(PG8_SB(0, 1), cB + hstep, voffB); PG8_STAGE(PG8_SA(0, 0), cA, voffA); PG8_STAGE(PG8_SA(0, 1), cA + hstep, voffA);
        if (wr == 1) PG8_BAR;
        PG8_WAIT_V(2); PG8_BAR;
        PG8_STAGE(PG8_SB(1, 0), cB + kstep, voffB); PG8_STAGE(PG8_SA(1, 0), cA + kstep, voffA); PG8_STAGE(PG8_SB(1, 1), cB + hstep + kstep, voffB);
        PG8_WAIT_V(6); PG8_BAR;
    } else {
        PG8_STAGE(PG8_SB(0, 0), cB, voffB); PG8_STAGE(PG8_SA(0, 0), cA, voffA); PG8_STAGE(PG8_SB(0, 1), cB + hstep, voffB); PG8_STAGE(PG8_SA(0, 1), cA + hstep, voffA);
        if (wr == 1) PG8_BAR;
        PG8_WAIT_V(4); PG8_BAR;
        PG8_STAGE(PG8_SB(1, 0), cB + kstep, voffB); PG8_STAGE(PG8_SA(1, 0), cA + kstep, voffA); PG8_STAGE(PG8_SB(1, 1), cB + hstep + kstep, voffB);
        PG8_WAIT_V(6); PG8_BAR;
    }
    for (;;) {
        const bool has_next = S.next(ui + 1, nxt);
        const char* nA = has_next ? (const char*)g.A + (size_t)nxt.pm * tstep : cA; const char* nB = has_next ? (const char*)g.Bt + (size_t)nxt.pn * tstep : cB;
        for (int t = 0; t < nt; t += 2) {
            const bool last = (t == nt - 2);
            const char* a1 = cA + (size_t)(t + 1) * kstep;
            const char* a2 = last ? nA : cA + (size_t)(t + 2) * kstep; const char* b2 = last ? nB : cB + (size_t)(t + 2) * kstep;
            const char* a3 = a2 + kstep; const char* b3 = b2 + kstep;
            if (last && has_next) S.a_ready(nxt);
            if constexpr (SP2) {
            PG8_LDB(B0, 0, 0); PG8_LDB(B1, 0, 1); PG8_SCHED; PG8_LDA(At, 0, 0); PG8_STAGE(PG8_SA(1, 1), a1 + hstep, voffA);
            PG8_WAIT_V(8); PG8_WAIT_L(0); PG8_BAR; PG8_MMA(0, 0, At, B0); PG8_MMA(0, 1, At, B1); PG8_BAR; PG8_SCHED;
            PG8_LDA(At, 0, 1); PG8_STAGE(PG8_SB(0, 0), b2, voffB); PG8_STAGE(PG8_SB(0, 1), b2 + hstep, voffB); PG8_STAGE(PG8_SA(0, 0), a2, voffA);
            PG8_WAIT_V(8); PG8_WAIT_L(0); PG8_BAR; PG8_MMA(1, 0, At, B0); PG8_MMA(1, 1, At, B1); PG8_BAR; PG8_SCHED;
            PG8_LDB(B0, 1, 0); PG8_LDB(B1, 1, 1); PG8_SCHED; PG8_LDA(At, 1, 0); PG8_STAGE(PG8_SA(0, 1), a2 + hstep, voffA);
            PG8_WAIT_V(8); PG8_WAIT_L(0); PG8_BAR; PG8_MMA(0, 0, At, B0); PG8_MMA(0, 1, At, B1); PG8_BAR; PG8_SCHED;
            PG8_LDA(At, 1, 1); PG8_STAGE(PG8_SB(1, 0), b3, voffB); PG8_STAGE(PG8_SB(1, 1), b3 + hstep, voffB); PG8_STAGE(PG8_SA(1, 0), a3, voffA);
            PG8_WAIT_V(8); PG8_WAIT_L(0); PG8_BAR; PG8_MMA(1, 0, At, B0); PG8_MMA(1, 1, At, B1); PG8_BAR; PG8_SCHED;
            } else {
            PG8_LDB(B0, 0, 0); PG8_SCHED; PG8_LDA(At, 0, 0); PG8_STAGE(PG8_SA(1, 1), a1 + hstep, voffA);
            PG8_WAIT_L(8); PG8_BAR; PG8_WAIT_L(0); PG8_MMA(0, 0, At, B0); PG8_BAR; PG8_SCHED;
            PG8_LDB(B1, 0, 1); PG8_STAGE(PG8_SB(0, 0), b2, voffB);
            PG8_BAR; PG8_WAIT_L(0); PG8_MMA(0, 1, At, B1); PG8_BAR;
            PG8_LDA(At, 0, 1); PG8_STAGE(PG8_SA(0, 0), a2, voffA);
            PG8_BAR; PG8_WAIT_L(0); PG8_MMA(1, 0, At, B0); PG8_BAR; PG8_SCHED;
            PG8_STAGE(PG8_SB(0, 1), b2 + hstep, voffB);
            PG8_WAIT_V(6); PG8_BAR; PG8_MMA(1, 1, At, B1); PG8_BAR;
            PG8_LDB(B0, 1, 0); PG8_SCHED; PG8_LDA(At, 1, 0); PG8_STAGE(PG8_SA(0, 1), a2 + hstep, voffA);
            PG8_WAIT_L(8); PG8_BAR; PG8_WAIT_L(0); PG8_MMA(0, 0, At, B0); PG8_BAR; PG8_SCHED;
            PG8_LDB(B1, 1, 1); PG8_STAGE(PG8_SB(1, 0), b3, voffB);
            PG8_BAR; PG8_WAIT_L(0); PG8_MMA(0, 1, At, B1); PG8_BAR;
            PG8_LDA(At, 1, 1); PG8_STAGE(PG8_SA(1, 0), a3, voffA);
            PG8_BAR; PG8_WAIT_L(0); PG8_MMA(1, 0, At, B0); PG8_BAR; PG8_SCHED;
            PG8_STAGE(PG8_SB(1, 1), b3 + hstep, voffB);
            PG8_WAIT_V(6); PG8_BAR; PG8_MMA(1, 1, At, B1); PG8_BAR;
            }
        }
        if constexpr (ALIGN_EPI) { if (wr == 0) PG8_BAR; }
        if constexpr (!Epi::AFTER_DRAIN) { E(acc, cur, wr, wc, fr, fq); S.done(cur); }
        if (!has_next) break;
#pragma unroll
        for (int a = 0; a < 2; ++a)
#pragma unroll
            for (int b = 0; b < 2; ++b)
#pragma unroll
                for (int m = 0; m < 4; ++m)
#pragma unroll
                    for (int n = 0; n < 2; ++n) acc[a][b][m][n] = (f32x4){0.f, 0.f, 0.f, 0.f};
        cur = nxt; cA = nA; cB = nB; ++ui;
        if constexpr (ALIGN_EPI) { if (wr == 1) PG8_BAR; }
    }
    PG8_WAIT_V(0);
    if constexpr (!ALIGN_EPI) { if (wr == 0) PG8_BAR; }
    PG8_BAR;
    if constexpr (Epi::AFTER_DRAIN) { E.fused(acc, cur, wr, wc, fr, fq, lds, wid, lane); S.done(cur); }
#undef PG8_SA
#undef PG8_SB
#undef PG8_STAGE
#undef PG8_LDA
#undef PG8_LDB
#undef PG8_MMA
#undef PG8_WAIT_V
#undef PG8_WAIT_L
#undef PG8_BAR
#undef PG8_SCHED
}
template <class Epi, class Sched, bool ALIGN_EPI = false>
__device__ __forceinline__ void gemm_phase_fp8(PG8_LAS unsigned char* lds, const Gemm g, const Sched& S, const Epi& E, int scale_w, int scale_x) {
    constexpr bool SP2 = true;
    const int tid = ltid(), wid = __builtin_amdgcn_readfirstlane(tid >> 6), lane = tid & 63, wr = wid >> 2, wc = wid & 3, fr = lane & 15, fq = lane >> 4;
    const int K = g.K, nt = K / BK;
    unsigned voffA[2], voffB[2];
#pragma unroll
    for (int i = 0; i < 2; ++i) { int R, C; stage_rc(tid * 16 + i * 8192, R, C); const int Rb = Epi::PERM ? ((R & ~31) + perm32(R & 31)) : R;
        voffA[i] = (unsigned)(R * K + C) * 2u; voffB[i] = (unsigned)(Rb * K + C) * 2u; }
    const size_t kstep = (size_t)(BK * 2);
    const size_t hstep = (size_t)HALF * K * 2;
    const size_t tstep = 2 * hstep;
    const unsigned ldsw = (unsigned)wid * 1024u;
    const int aoff = lds_byte(wr * 64 + fr, fq * 8), boff = lds_byte(wc * 32 + fr, fq * 8);
#define PG8_SA(b, h) (((b) * 2 + (h)) * HTB)
#define PG8_SB(b, h) ((4 + (b) * 2 + (h)) * HTB)
#define PG8_STAGE(bufoff, gbase, voff) do { _Pragma("unroll") for (int _i = 0; _i < 2; ++_i) \
        __builtin_amdgcn_global_load_lds((const unsigned*)((const char*)(gbase) + (voff)[_i]), (PG8_LAS unsigned*)(lds + (bufoff) + ldsw + _i * 8192), 16, 0, 0); } while (0)
#define PG8_LDA(dst, b, h) do { _Pragma("unroll") for (int m = 0; m < 4; ++m) { dst[m].lo = *(const PG8_LAS i32x4*)(lds + PG8_SA(b, h) + aoff + m * 2048); dst[m].hi = *(const PG8_LAS i32x4*)(lds + PG8_SA(b, h) + aoff + m * 2048 + 1024); } } while (0)
#define PG8_LDB(dst, b, h) do { _Pragma("unroll") for (int n = 0; n < 2; ++n) { dst[n].lo = *(const PG8_LAS i32x4*)(lds + PG8_SB(b, h) + boff + n * 2048); dst[n].hi = *(const PG8_LAS i32x4*)(lds + PG8_SB(b, h) + boff + n * 2048 + 1024); } } while (0)
#define PG8_MMA(ai, bj, At, Bt) do { __builtin_amdgcn_s_setprio(1); _Pragma("unroll") for (int m = 0; m < 4; ++m) _Pragma("unroll") for (int n = 0; n < 2; ++n) \
        asm volatile("v_mfma_scale_f32_16x16x128_f8f6f4 %0, %1, %2, %0, %3, %4 op_sel_hi:[0,0,0]" : "+v"(acc[ai][bj][m][n]) : "v"(Bt[n]), "v"(At[m]), "v"(sclB), "v"(sclA));     \
        __builtin_amdgcn_s_setprio(0); } while (0)
#define PG8_WAIT_V(n) asm volatile("s_waitcnt vmcnt(" #n ")" ::: "memory")
#define PG8_WAIT_L(n) asm volatile("s_waitcnt lgkmcnt(" #n ")" ::: "memory")
#define PG8_BAR __builtin_amdgcn_s_barrier()
#define PG8_SCHED __builtin_amdgcn_sched_barrier(0)
    Unit cur, nxt; int ui = 0;
    if (!S.next(0, cur)) return;
    f32x4 acc[2][2][4][2];
#pragma unroll
    for (int a = 0; a < 2; ++a)
#pragma unroll
        for (int b = 0; b < 2; ++b)
#pragma unroll
            for (int m = 0; m < 4; ++m)
#pragma unroll
                for (int n = 0; n < 2; ++n) acc[a][b][m][n] = (f32x4){0.f, 0.f, 0.f, 0.f};
    i32x8 At[4], B0[2], B1[2];
    int sclB = scale_w, sclA = scale_x; asm volatile("" : "+v"(sclB), "+v"(sclA));
    const char* cA = (const char*)g.A + (size_t)cur.pm * tstep; const char* cB = (const char*)g.Bt + (size_t)cur.pn * tstep;
    S.a_ready(cur);
    if constexpr (SP2) {
        PG8_STAGE(PG8_SB(0, 0), cB, voffB); PG8_STAGE(PG8_SB(0, 1), cB + hstep, voffB); PG8_STAGE(PG8_SA(0, 0), cA, voffA); PG8_STAGE(PG8_SA(0, 1), cA + hstep, voffA);
        if (wr == 1) PG8_BAR;
        PG8_WAIT_V(2); PG8_BAR;
        PG8_STAGE(PG8_SB(1, 0), cB + kstep, voffB); PG8_STAGE(PG8_SA(1, 0), cA + kstep, voffA); PG8_STAGE(PG8_SB(1, 1), cB + hstep + kstep, voffB);
        PG8_WAIT_V(6); PG8_BAR;
    } else {
        PG8_STAGE(PG8_SB(0, 0), cB, voffB); PG8_STAGE(PG8_SA(0, 0), cA, voffA); PG8_STAGE(PG8_SB(0, 1), cB + hstep, voffB); PG8_STAGE(PG8_SA(0, 1), cA + hstep, voffA);
        if (wr == 1) PG8_BAR;
        PG8_WAIT_V(4); PG8_BAR;
        PG8_STAGE(PG8_SB(1, 0), cB + kstep, voffB); PG8_STAGE(PG8_SA(1, 0), cA + kstep, voffA); PG8_STAGE(PG8_SB(1, 1), cB + hstep + kstep, voffB);
        PG8_WAIT_V(6); PG8_BAR;
    }
    for (;;) {
        const bool has_next = S.next(ui + 1, nxt);
        const char* nA = has_next ? (const char*)g.A + (size_t)nxt.pm * tstep : cA; const char* nB = has_next ? (const char*)g.Bt + (size_t)nxt.pn * tstep : cB;
#pragma unroll 1
        for (int t = 0; t < nt; t += 2) {
            const bool last = (t == nt - 2);
            const char* a1 = cA + (size_t)(t + 1) * kstep;
            const char* a2 = last ? nA : cA + (size_t)(t + 2) * kstep; const char* b2 = last ? nB : cB + (size_t)(t + 2) * kstep;
            const char* a3 = a2 + kstep; const char* b3 = b2 + kstep;
            if (last && has_next) S.a_ready(nxt);
            if constexpr (SP2) {
            PG8_LDB(B0, 0, 0); PG8_LDB(B1, 0, 1); PG8_SCHED; PG8_LDA(At, 0, 0); PG8_STAGE(PG8_SA(1, 1), a1 + hstep, voffA);
            PG8_WAIT_V(8); PG8_WAIT_L(0); PG8_BAR; PG8_MMA(0, 0, At, B0); PG8_MMA(0, 1, At, B1); PG8_BAR; PG8_SCHED;
            PG8_LDA(At, 0, 1); PG8_STAGE(PG8_SB(0, 0), b2, voffB); PG8_STAGE(PG8_SB(0, 1), b2 + hstep, voffB); PG8_STAGE(PG8_SA(0, 0), a2, voffA);
            PG8_WAIT_V(8); PG8_WAIT_L(0); PG8_BAR; PG8_MMA(1, 0, At, B0); PG8_MMA(1, 1, At, B1); PG8_BAR; PG8_SCHED;
            PG8_LDB(B0, 1, 0); PG8_LDB(B1, 1, 1); PG8_SCHED; PG8_LDA(At, 1, 0); PG8_STAGE(PG8_SA(0, 1), a2 + hstep, voffA);
            PG8_WAIT_V(8); PG8_WAIT_L(0); PG8_BAR; PG8_MMA(0, 0, At, B0); PG8_MMA(0, 1, At, B1); PG8_BAR; PG8_SCHED;
            PG8_LDA(At, 1, 1); PG8_STAGE(PG8_SB(1, 0), b3, voffB); PG8_STAGE(PG8_SB(1, 1), b3 + hstep, voffB); PG8_STAGE(PG8_SA(1, 0), a3, voffA);
            PG8_WAIT_V(8); PG8_WAIT_L(0); PG8_BAR; PG8_MMA(1, 0, At, B0); PG8_MMA(1, 1, At, B1); PG8_BAR; PG8_SCHED;
            } else {
            PG8_LDB(B0, 0, 0); PG8_SCHED; PG8_LDA(At, 0, 0); PG8_STAGE(PG8_SA(1, 1), a1 + hstep, voffA);
            PG8_WAIT_L(8); PG8_BAR; PG8_WAIT_L(0); PG8_MMA(0, 0, At, B0); PG8_BAR; PG8_SCHED;
            PG8_LDB(B1, 0, 1); PG8_STAGE(PG8_SB(0, 0), b2, voffB);
            PG8_BAR; PG8_WAIT_L(0); PG8_MMA(0, 1, At, B1); PG8_BAR;
            PG8_LDA(At, 0, 1); PG8_STAGE(PG8_SA(0, 0), a2, voffA);
            PG8_BAR; PG8_WAIT_L(0); PG8_MMA(1, 0, At, B0); PG8_BAR; PG8_SCHED;
            PG8_STAGE(PG8_SB(0, 1), b2 + hstep, voffB);
            PG8_WAIT_V(6); PG8_BAR; PG8_MMA(1, 1, At, B1); PG8_BAR;
            PG8_LDB(B0, 1, 0); PG8_SCHED; PG8_LDA(At, 1, 0); PG8_STAGE(PG8_SA(0, 1), a2 + hstep, voffA);
            PG8_WAIT_L(8); PG8_BAR; PG8_WAIT_L(0); PG8_MMA(0, 0, At, B0); PG8_BAR; PG8_SCHED;
            PG8_LDB(B1, 1, 1); PG8_STAGE(PG8_SB(1, 0), b3, voffB);
            PG8_BAR; PG8_WAIT_L(0); PG8_MMA(0, 1, At, B1); PG8_BAR;
            PG8_LDA(At, 1, 1); PG8_STAGE(PG8_SA(1, 0), a3, voffA);
            PG8_BAR; PG8_WAIT_L(0); PG8_MMA(1, 0, At, B0); PG8_BAR; PG8_SCHED;
            PG8_STAGE(PG8_SB(1, 1), b3 + hstep, voffB);
            PG8_WAIT_V(6); PG8_BAR; PG8_MMA(1, 1, At, B1); PG8_BAR;
            }
        }
        asm volatile("s_nop 15\n\ts_nop 15" ::: "memory");
        if constexpr (ALIGN_EPI) { if (wr == 0) PG8_BAR; }
        if constexpr (!Epi::AFTER_DRAIN) { E(acc, cur, wr, wc, fr, fq); S.done(cur); }
        if (!has_next) break;
#pragma unroll
        for (int a = 0; a < 2; ++a)
#pragma unroll
            for (int b = 0; b < 2; ++b)
#pragma unroll
                for (int m = 0; m < 4; ++m)
#pragma unroll
                    for (int n = 0; n < 2; ++n) acc[a][b][m][n] = (f32x4){0.f, 0.f, 0.f, 0.f};
        cur = nxt; cA = nA; cB = nB; ++ui;
        if constexpr (ALIGN_EPI) { if (wr == 1) PG8_BAR; }
    }
    PG8_WAIT_V(0);
    if constexpr (!ALIGN_EPI) { if (wr == 0) PG8_BAR; }
    PG8_BAR;
    if constexpr (Epi::AFTER_DRAIN) { E.fused(acc, cur, wr, wc, fr, fq, lds, wid, lane); S.done(cur); }
#undef PG8_SA
#undef PG8_SB
#undef PG8_STAGE
#undef PG8_LDA
#undef PG8_LDB
#undef PG8_MMA
#undef PG8_WAIT_V
#undef PG8_WAIT_L
#undef PG8_BAR
#undef PG8_SCHED
}
template <class Epi, class Sched, bool ALIGN_EPI = false, bool FP8 = false>
__device__ __forceinline__ void gemm_phase_gather(PG8_LAS unsigned char* lds, const Gemm g, const int* idx, const Sched& S, const Epi& E) {
    constexpr bool SP2 = true;
    const int tid = ltid(), wid = __builtin_amdgcn_readfirstlane(tid >> 6), lane = tid & 63, wr = wid >> 2, wc = wid & 3, fr = lane & 15, fq = lane >> 4;
    const int K = g.K, nt = K / BK;
    unsigned voffB[2], vC[2][2], vN[2][2];
#pragma unroll
    for (int i = 0; i < 2; ++i) { int R, C; stage_rc(tid * 16 + i * 8192, R, C); const int Rb = Epi::PERM ? ((R & ~31) + perm32(R & 31)) : R;
        voffB[i] = (unsigned)(Rb * K + C) * 2u; }
#define PG8_GOFF(dst, unit) do { const int t_ = ltid(); _Pragma("unroll") for (int i_ = 0; i_ < 2; ++i_) { int R_, C_; stage_rc(t_ * 16 + i_ * 8192, R_, C_); \
        _Pragma("unroll") for (int h_ = 0; h_ < 2; ++h_) dst[h_][i_] = (unsigned)idx[(unit).pm * 256 + h_ * 128 + R_] * (unsigned)(K * 2) + (unsigned)(C_ * 2); } } while (0)
    const size_t kstep = (size_t)(BK * 2);
    const size_t hstep = (size_t)HALF * K * 2;
    const size_t tstep = 2 * hstep;
    const unsigned ldsw = (unsigned)wid * 1024u;
    const int aoff = lds_byte(wr * 64 + fr, fq * 8), boff = lds_byte(wc * 32 + fr, fq * 8);
#define PG8_SA(b, h) (((b) * 2 + (h)) * HTB)
#define PG8_SB(b, h) ((4 + (b) * 2 + (h)) * HTB)
#define PG8_STAGE(bufoff, gbase, voff) do { _Pragma("unroll") for (int _i = 0; _i < 2; ++_i) \
        __builtin_amdgcn_global_load_lds((const unsigned*)((const char*)(gbase) + (voff)[_i]), (PG8_LAS unsigned*)(lds + (bufoff) + ldsw + _i * 8192), 16, 0, 0); } while (0)
#define PG8_LDA(dst, b, h) do { _Pragma("unroll") for (int m = 0; m < 4; ++m) { dst[m].lo = *(const PG8_LAS i32x4*)(lds + PG8_SA(b, h) + aoff + m * 2048); dst[m].hi = *(const PG8_LAS i32x4*)(lds + PG8_SA(b, h) + aoff + m * 2048 + 1024); } } while (0)
#define PG8_LDB(dst, b, h) do { _Pragma("unroll") for (int n = 0; n < 2; ++n) { dst[n].lo = *(const PG8_LAS i32x4*)(lds + PG8_SB(b, h) + boff + n * 2048); dst[n].hi = *(const PG8_LAS i32x4*)(lds + PG8_SB(b, h) + boff + n * 2048 + 1024); } } while (0)
#define PG8_MMA(ai, bj, At, Bt) do { __builtin_amdgcn_s_setprio(1); _Pragma("unroll") for (int m = 0; m < 4; ++m) _Pragma("unroll") for (int n = 0; n < 2; ++n) \
        asm volatile("v_mfma_scale_f32_16x16x128_f8f6f4 %0, %1, %2, %0, %3, %4 op_sel_hi:[0,0,0]" : "+v"(acc[ai][bj][m][n]) : "v"(Bt[n]), "v"(At[m]), "v"(sclB), "v"(sclA));     \
        __builtin_amdgcn_s_setprio(0); } while (0)
#define PG8_WAIT_V(n) asm volatile("s_waitcnt vmcnt(" #n ")" ::: "memory")
#define PG8_WAIT_L(n) asm volatile("s_waitcnt lgkmcnt(" #n ")" ::: "memory")
#define PG8_BAR __builtin_amdgcn_s_barrier()
#define PG8_SCHED __builtin_amdgcn_sched_barrier(0)
    Unit cur, nxt; int ui = 0;
    if (!S.next(0, cur)) return;
    f32x4 acc[2][2][4][2];
#pragma unroll
    for (int a = 0; a < 2; ++a)
#pragma unroll
        for (int b = 0; b < 2; ++b)
#pragma unroll
            for (int m = 0; m < 4; ++m)
#pragma unroll
                for (int n = 0; n < 2; ++n) acc[a][b][m][n] = (f32x4){0.f, 0.f, 0.f, 0.f};
    i32x8 At[4], B0[2], B1[2];
    int sclB = 122, sclA = 127; asm volatile("" : "+v"(sclB), "+v"(sclA));
    const char* cA = (const char*)g.A; const char* cB = (const char*)g.Bt + (size_t)cur.pn * tstep;
    PG8_GOFF(vC, cur);
    S.a_ready(cur);
    if constexpr (SP2) {
        PG8_STAGE(PG8_SB(0, 0), cB, voffB); PG8_STAGE(PG8_SB(0, 1), cB + hstep, voffB); PG8_STAGE(PG8_SA(0, 0), cA, vC[0]); PG8_STAGE(PG8_SA(0, 1), cA, vC[1]);
        if (wr == 1) PG8_BAR;
        PG8_WAIT_V(2); PG8_BAR;
        PG8_STAGE(PG8_SB(1, 0), cB + kstep, voffB); PG8_STAGE(PG8_SA(1, 0), cA + kstep, vC[0]); PG8_STAGE(PG8_SB(1, 1), cB + hstep + kstep, voffB);
        PG8_WAIT_V(6); PG8_BAR;
    } else {
        PG8_STAGE(PG8_SB(0, 0), cB, voffB); PG8_STAGE(PG8_SA(0, 0), cA, vC[0]); PG8_STAGE(PG8_SB(0, 1), cB + hstep, voffB); PG8_STAGE(PG8_SA(0, 1), cA, vC[1]);
        if (wr == 1) PG8_BAR;
        PG8_WAIT_V(4); PG8_BAR;
        PG8_STAGE(PG8_SB(1, 0), cB + kstep, voffB); PG8_STAGE(PG8_SA(1, 0), cA + kstep, vC[0]); PG8_STAGE(PG8_SB(1, 1), cB + hstep + kstep, voffB);
        PG8_WAIT_V(6); PG8_BAR;
    }
    for (;;) {
        const bool has_next = S.next(ui + 1, nxt);
        const char* nA = cA; const char* nB = has_next ? (const char*)g.Bt + (size_t)nxt.pn * tstep : cB;
        if (has_next) PG8_GOFF(vN, nxt); else { _Pragma("unroll") for (int h_ = 0; h_ < 2; ++h_) _Pragma("unroll") for (int i_ = 0; i_ < 2; ++i_) vN[h_][i_] = vC[h_][i_]; }
#pragma unroll 1
        for (int t = 0; t < nt; t += 2) {
            const bool last = (t == nt - 2);
            const char* a1 = cA + (size_t)(t + 1) * kstep;
            const char* a2 = last ? nA : cA + (size_t)(t + 2) * kstep; const char* b2 = last ? nB : cB + (size_t)(t + 2) * kstep;
            const char* a3 = a2 + kstep; const char* b3 = b2 + kstep;
#define PG8_VSEL(h_) unsigned vsel_[2] = {last ? vN[h_][0] : vC[h_][0], last ? vN[h_][1] : vC[h_][1]}
            if (last && has_next) S.a_ready(nxt);
            if constexpr (SP2) {
            PG8_LDB(B0, 0, 0); PG8_LDB(B1, 0, 1); PG8_SCHED; PG8_LDA(At, 0, 0); PG8_STAGE(PG8_SA(1, 1), a1, vC[1]);
            PG8_WAIT_V(8); PG8_WAIT_L(0); PG8_BAR; PG8_MMA(0, 0, At, B0); PG8_MMA(0, 1, At, B1); PG8_BAR; PG8_SCHED;
            PG8_LDA(At, 0, 1); PG8_STAGE(PG8_SB(0, 0), b2, voffB); PG8_STAGE(PG8_SB(0, 1), b2 + hstep, voffB); { PG8_VSEL(0); PG8_STAGE(PG8_SA(0, 0), a2, vsel_); }
            PG8_WAIT_V(8); PG8_WAIT_L(0); PG8_BAR; PG8_MMA(1, 0, At, B0); PG8_MMA(1, 1, At, B1); PG8_BAR; PG8_SCHED;
            PG8_LDB(B0, 1, 0); PG8_LDB(B1, 1, 1); PG8_SCHED; PG8_LDA(At, 1, 0); { PG8_VSEL(1); PG8_STAGE(PG8_SA(0, 1), a2, vsel_); }
            PG8_WAIT_V(8); PG8_WAIT_L(0); PG8_BAR; PG8_MMA(0, 0, At, B0); PG8_MMA(0, 1, At, B1); PG8_BAR; PG8_SCHED;
            PG8_LDA(At, 1, 1); PG8_STAGE(PG8_SB(1, 0), b3, voffB); PG8_STAGE(PG8_SB(1, 1), b3 + hstep, voffB); { PG8_VSEL(0); PG8_STAGE(PG8_SA(1, 0), a3, vsel_); }
            PG8_WAIT_V(8); PG8_WAIT_L(0); PG8_BAR; PG8_MMA(1, 0, At, B0); PG8_MMA(1, 1, At, B1); PG8_BAR; PG8_SCHED;
            } else {
            PG8_LDB(B0, 0, 0); PG8_SCHED; PG8_LDA(At, 0, 0); PG8_STAGE(PG8_SA(1, 1), a1, vC[1]);
            PG8_WAIT_L(8); PG8_BAR; PG8_WAIT_L(0); PG8_MMA(0, 0, At, B0); PG8_BAR; PG8_SCHED;
            PG8_LDB(B1, 0, 1); PG8_STAGE(PG8_SB(0, 0), b2, voffB);
            PG8_BAR; PG8_WAIT_L(0); PG8_MMA(0, 1, At, B1); PG8_BAR;
            PG8_LDA(At, 0, 1); { PG8_VSEL(0); PG8_STAGE(PG8_SA(0, 0), a2, vsel_); }
            PG8_BAR; PG8_WAIT_L(0); PG8_MMA(1, 0, At, B0); PG8_BAR; PG8_SCHED;
            PG8_STAGE(PG8_SB(0, 1), b2 + hstep, voffB);
            PG8_WAIT_V(6); PG8_BAR; PG8_MMA(1, 1, At, B1); PG8_BAR;
            PG8_LDB(B0, 1, 0); PG8_SCHED; PG8_LDA(At, 1, 0); { PG8_VSEL(1); PG8_STAGE(PG8_SA(0, 1), a2, vsel_); }
            PG8_WAIT_L(8); PG8_BAR; PG8_WAIT_L(0); PG8_MMA(0, 0, At, B0); PG8_BAR; PG8_SCHED;
            PG8_LDB(B1, 1, 1); PG8_STAGE(PG8_SB(1, 0), b3, voffB);
            PG8_BAR; PG8_WAIT_L(0); PG8_MMA(0, 1, At, B1); PG8_BAR;
            PG8_LDA(At, 1, 1); { PG8_VSEL(0); PG8_STAGE(PG8_SA(1, 0), a3, vsel_); }
            PG8_BAR; PG8_WAIT_L(0); PG8_MMA(1, 0, At, B0); PG8_BAR; PG8_SCHED;
            PG8_STAGE(PG8_SB(1, 1), b3 + hstep, voffB);
            PG8_WAIT_V(6); PG8_BAR; PG8_MMA(1, 1, At, B1); PG8_BAR;
            }
        }
        asm volatile("s_nop 15\n\ts_nop 15" ::: "memory");
        if constexpr (ALIGN_EPI) { if (wr == 0) PG8_BAR; }
        if constexpr (!Epi::AFTER_DRAIN) { E(acc, cur, wr, wc, fr, fq); S.done(cur); }
        if (!has_next) break;
#pragma unroll
        for (int a = 0; a < 2; ++a)
#pragma unroll
            for (int b = 0; b < 2; ++b)
#pragma unroll
                for (int m = 0; m < 4; ++m)
#pragma unroll
                    for (int n = 0; n < 2; ++n) acc[a][b][m][n] = (f32x4){0.f, 0.f, 0.f, 0.f};
        cur = nxt; cA = nA; cB = nB; ++ui;
#pragma unroll
        for (int h_ = 0; h_ < 2; ++h_)
#pragma unroll
            for (int i_ = 0; i_ < 2; ++i_) vC[h_][i_] = vN[h_][i_];
        if constexpr (ALIGN_EPI) { if (wr == 1) PG8_BAR; }
    }
    PG8_WAIT_V(0);
    if constexpr (!ALIGN_EPI) { if (wr == 0) PG8_BAR; }
    PG8_BAR;
    if constexpr (Epi::AFTER_DRAIN) { E.fused(acc, cur, wr, wc, fr, fq, lds, wid, lane); S.done(cur); }
#undef PG8_GOFF
#undef PG8_SA
#undef PG8_SB
#undef PG8_STAGE
#undef PG8_LDA
#undef PG8_LDB
#undef PG8_MMA
#undef PG8_WAIT_V
#undef PG8_WAIT_L
#undef PG8_BAR
#undef PG8_SCHED
}
}

namespace pg8 {
struct EpiInproj {
    static constexpr bool PERM = true, AFTER_DRAIN = false;
    EpiBf16<0> plain; const float* gq; const float* gk; float c2, eps; PG8_LAS unsigned char* scratch;
    static __device__ __forceinline__ float sum_fq(float x) {
        auto s = __builtin_amdgcn_permlane16_swap(__float_as_uint(x), __float_as_uint(x), false, false); x = __uint_as_float(s[0]) + __uint_as_float(s[1]);
        auto t = __builtin_amdgcn_permlane32_swap(__float_as_uint(x), __float_as_uint(x), false, false); return __uint_as_float(t[0]) + __uint_as_float(t[1]); }
    __device__ __forceinline__ void operator()(const f32x4 (&acc_)[2][2][4][2], const Unit& u, int wr, int wc, int fr, int fq) const {
        if (u.pn < 4) {
            f32x4 (&acc)[2][2][4][2] = const_cast<f32x4 (&)[2][2][4][2]>(acc_);
            const PG8_LAS unsigned* TAB = (const PG8_LAS unsigned*)scratch; PG8_LAS float* EXQ = (PG8_LAS float*)(scratch + 4096);
            const int rl = wr * 64 + fr;
            float ss[2][2][4];
#pragma unroll
            for (int ai = 0; ai < 2; ++ai)
#pragma unroll
                for (int bj = 0; bj < 2; ++bj)
#pragma unroll
                    for (int m = 0; m < 4; ++m) { const f32x4 a = acc[ai][bj][m][0], b = acc[ai][bj][m][1];
                        ss[ai][bj][m] = sum_fq((a[0] * a[0] + a[1] * a[1]) + (a[2] * a[2] + a[3] * a[3]) + (b[0] * b[0] + b[1] * b[1]) + (b[2] * b[2] + b[3] * b[3]));
                        if (fq == 0) EXQ[(rl + ai * HALF + m * 16) * 8 + bj * 4 + wc] = ss[ai][bj][m]; }
            asm volatile("s_waitcnt lgkmcnt(0)" ::: "memory"); __builtin_amdgcn_s_barrier();
#pragma unroll
            for (int ai = 0; ai < 2; ++ai)
#pragma unroll
                for (int bj = 0; bj < 2; ++bj)
#pragma unroll
                    for (int m = 0; m < 4; ++m) ss[ai][bj][m] += EXQ[(rl + ai * HALF + m * 16) * 8 + bj * 4 + (wc ^ 1)];
            const float* gp = (u.pn < 2 ? gq : gk) + (wc & 1) * 32 + 8 * fq; const f32x4 g0 = *(const f32x4*)gp, g1 = *(const f32x4*)(gp + 4);
            const float scl = u.pn < 2 ? c2 : 1.f;
            const bool lat = u.pm < 128, upper = fq >= 2;
#pragma unroll
            for (int ai = 0; ai < 2; ++ai)
#pragma unroll
                for (int m = 0; m < 4; ++m) {
                    const int t = (u.pm * BM + rl + ai * HALF + m * 16) & 4095, pos = (wc & 1) ? (t & 63) : (t >> 6);
                    const u32x4 t0 = *(const PG8_LAS u32x4*)(TAB + pos * 16 + 8 * (fq & 1)), t1 = *(const PG8_LAS u32x4*)(TAB + pos * 16 + 8 * (fq & 1) + 4);
                    float ca0[4], cb0[4], ca1[4], cb1[4];
#pragma unroll
                    for (int j = 0; j < 4; ++j) { const float c0 = __uint_as_float(t0[j] << 16), s0 = __uint_as_float(t0[j] & 0xffff0000u), c1 = __uint_as_float(t1[j] << 16), s1 = __uint_as_float(t1[j] & 0xffff0000u);
                        ca0[j] = upper ? s0 : c0; cb0[j] = upper ? c0 : -s0; ca1[j] = upper ? s1 : c1; cb1[j] = upper ? c1 : -s1; }
#pragma unroll
                    for (int bj = 0; bj < 2; ++bj) {
                        const float rstd = scl * __builtin_amdgcn_rsqf(ss[ai][bj][m] * (1.f / 64.f) + eps);
                        f32x4 v0 = acc[ai][bj][m][0] * rstd * g0, v1 = acc[ai][bj][m][1] * rstd * g1;
                        if (lat) {
#pragma unroll
                            for (int j = 0; j < 4; ++j) {
                                { auto sw = __builtin_amdgcn_permlane32_swap(__float_as_uint(v0[j]), __float_as_uint(v0[j]), false, false); v0[j] = __builtin_fmaf(ca0[j], __uint_as_float(sw[0]), cb0[j] * __uint_as_float(sw[1])); }
                                { auto sw = __builtin_amdgcn_permlane32_swap(__float_as_uint(v1[j]), __float_as_uint(v1[j]), false, false); v1[j] = __builtin_fmaf(ca1[j], __uint_as_float(sw[0]), cb1[j] * __uint_as_float(sw[1])); } } }
                        acc[ai][bj][m][0] = v0; acc[ai][bj][m][1] = v1; } }
        }
        plain(acc_, u, wr, wc, fr, fq);
    }
};
}

namespace pg8 {
struct EpiRes {
    static constexpr bool PERM = true, AFTER_DRAIN = false;
    const float* x_in; float* out; const float* ctx_in; float* xc; const float* modl; int layer;
    __device__ __forceinline__ void operator()(const f32x4 (&acc)[2][2][4][2], const Unit& u, int wr, int wc, int fr, int fq) const {
        const bool lat = u.pm < 128; const int rowt = lat ? u.pm * BM : (u.pm - 128) * BM;
        const int col0 = u.pn * BM + wc * 32 + 8 * fq;
        const float* g = modl + (size_t)(lat ? (u.pm >> 4) : 8) * 6144 + 2048 + col0;
        f32x4 gv[2][2];
#pragma unroll
        for (int bj = 0; bj < 2; ++bj)
#pragma unroll
            for (int n = 0; n < 2; ++n) gv[bj][n] = *(const f32x4*)(g + bj * HALF + n * 4);
#pragma unroll
        for (int ai = 0; ai < 2; ++ai)
#pragma unroll
            for (int m = 0; m < 4; ++m) { const int row = rowt + ai * HALF + wr * 64 + m * 16 + fr;
#pragma unroll
                for (int bj = 0; bj < 2; ++bj) { const int c = col0 + bj * HALF; f32x4 b0, b1;
                    if (!lat) { const float* bp = ctx_in + (size_t)row * 1024 + c; b0 = *(const f32x4*)bp; b1 = *(const f32x4*)(bp + 4); }
                    else if (layer == 0) { const float* bp = x_in + (size_t)row * 1024 + c; b0 = *(const f32x4*)bp; b1 = *(const f32x4*)(bp + 4); }
                    else { const u32x4 w = *(const u32x4*)((const bf16_t*)(out + (size_t)row * 1024) + c);
                        b0 = (f32x4){__uint_as_float(w.x << 16), __uint_as_float(w.x & 0xffff0000u), __uint_as_float(w.y << 16), __uint_as_float(w.y & 0xffff0000u)};
                        b1 = (f32x4){__uint_as_float(w.z << 16), __uint_as_float(w.z & 0xffff0000u), __uint_as_float(w.w << 16), __uint_as_float(w.w & 0xffff0000u)}; }
                    const f32x4 o0 = b0 + gv[bj][0] * acc[ai][bj][m][0], o1 = b1 + gv[bj][1] * acc[ai][bj][m][1];
                    if (lat) { u32x4 w; w.x = cvt_pk_bf16(o0[0], o0[1]); w.y = cvt_pk_bf16(o0[2], o0[3]); w.z = cvt_pk_bf16(o1[0], o1[1]); w.w = cvt_pk_bf16(o1[2], o1[3]); *(u32x4*)((bf16_t*)(out + (size_t)row * 1024) + c) = w; }
                    else { float* op = xc + (size_t)row * 1024 + c; *(f32x4*)op = o0; *(f32x4*)(op + 4) = o1; } } }
    }
};
__device__ __forceinline__ float silu_f(float x) { return x * __builtin_amdgcn_rcpf(1.f + __builtin_amdgcn_exp2f(-1.4426950408889634f * x)); }
struct EpiSwiglu {
    static constexpr bool PERM = true, AFTER_DRAIN = false, FP8OUT = USE_FP8_MOE2 != 0;
    bf16_t* HID;
    __device__ __forceinline__ void operator()(const f32x4 (&acc)[2][2][4][2], const Unit& u, int wr, int wc, int fr, int fq) const {
        const int row0 = u.pm * BM + wr * 64 + fr, hcol0 = (u.pn & 7) * 128 + wc * 32 + 8 * fq;
#pragma unroll
        for (int ai = 0; ai < 2; ++ai)
#pragma unroll
            for (int m = 0; m < 4; ++m) { bf16_t* rowp = HID + (size_t)(row0 + ai * HALF + m * 16) * 1024 + hcol0;
                const f32x4 g0 = acc[ai][0][m][0], g1 = acc[ai][0][m][1], u0 = acc[ai][1][m][0], u1 = acc[ai][1][m][1];
#define H8(gv, uv) __builtin_amdgcn_fmed3f((gv) * __builtin_amdgcn_rcpf(1.f + __builtin_amdgcn_exp2f(gv)) * ((uv) * (-8.f / 1.4426950408889634f)), -448.f, 448.f)
                if (FP8OUT) { int p0 = __builtin_amdgcn_cvt_pk_fp8_f32(H8(g0[0], u0[0]), H8(g0[1], u0[1]), 0, false); p0 = __builtin_amdgcn_cvt_pk_fp8_f32(H8(g0[2], u0[2]), H8(g0[3], u0[3]), p0, true);
                    int p1 = __builtin_amdgcn_cvt_pk_fp8_f32(H8(g1[0], u1[0]), H8(g1[1], u1[1]), 0, false); p1 = __builtin_amdgcn_cvt_pk_fp8_f32(H8(g1[2], u1[2]), H8(g1[3], u1[3]), p1, true);
                    typedef unsigned u32x2_ __attribute__((ext_vector_type(2))); *(u32x2_*)((unsigned char*)HID + (size_t)(row0 + ai * HALF + m * 16) * 1024 + hcol0) = (u32x2_){(unsigned)p0, (unsigned)p1}; }
                else { u32x4 w; w.x = cvt_pk_bf16(silu_f(g0[0]) * u0[0], silu_f(g0[1]) * u0[1]); w.y = cvt_pk_bf16(silu_f(g0[2]) * u0[2], silu_f(g0[3]) * u0[3]);
                w.z = cvt_pk_bf16(silu_f(g1[0]) * u1[0], silu_f(g1[1]) * u1[1]); w.w = cvt_pk_bf16(silu_f(g1[2]) * u1[2], silu_f(g1[3]) * u1[3]);
                *(u32x4*)rowp = w; } }
    }
};
struct EpiBf16Grp {
    static constexpr bool PERM = true, AFTER_DRAIN = false;
    bf16_t* O; int ldc, ncolt;
    __device__ __forceinline__ void operator()(const f32x4 (&acc)[2][2][4][2], const Unit& u, int wr, int wc, int fr, int fq) const {
        const int row0 = u.pm * BM + wr * 64 + fr, col0 = (u.pn % ncolt) * BM + wc * 32 + 8 * fq;
#pragma unroll
        for (int ai = 0; ai < 2; ++ai)
#pragma unroll
            for (int m = 0; m < 4; ++m) { bf16_t* rowp = O + (size_t)(row0 + ai * HALF + m * 16) * ldc + col0;
#pragma unroll
                for (int bj = 0; bj < 2; ++bj) { const f32x4 v0 = acc[ai][bj][m][0], v1 = acc[ai][bj][m][1];
                    u32x4 w; w.x = cvt_pk_bf16(v0[0], v0[1]); w.y = cvt_pk_bf16(v0[2], v0[3]); w.z = cvt_pk_bf16(v1[0], v1[1]); w.w = cvt_pk_bf16(v1[2], v1[3]);
                    *(u32x4*)(rowp + bj * HALF) = w; } }
    }
};
struct GroupOrder {
    int nMe, nNe, G, c;
    __device__ bool next(int i, Unit& u) const {
        const int vc = (G % 8 == 0) ? (c % 8) * (G / 8) + c / 8 : c;
        const int L = i * G + vc, per = nMe * nNe; if (L >= 16 * per) return false;
        const int e = L / per, rem = L % per; u.pm = e * 17 + rem % nMe; u.pn = e * nNe + rem / nMe; return true;
    }
    __device__ __forceinline__ void a_ready(const Unit&) const {}
    __device__ __forceinline__ void done(const Unit&) const {}
};
}

DEV float bf2f(unsigned u) { return __uint_as_float(u << 16); }
DEV unsigned f2bf(float f) { unsigned u = __float_as_uint(f); return (u + 0x7fffu + ((u >> 16) & 1u)) >> 16; }
typedef float f32x2_t __attribute__((ext_vector_type(2)));
DEV unsigned pk2(float lo, float hi) { f32x2_t v = {lo, hi}; bf16x2_t b = __builtin_convertvector(v, bf16x2_t); return __builtin_bit_cast(unsigned, b); }
DEV float clamp8(float x) { return __builtin_amdgcn_fmed3f(x, -448.f, 448.f); }
DEV unsigned pk_fp8x4(float a0, float a1, float a2, float a3) { int p = __builtin_amdgcn_cvt_pk_fp8_f32(clamp8(a0), clamp8(a1), 0, false); p = __builtin_amdgcn_cvt_pk_fp8_f32(clamp8(a2), clamp8(a3), p, true); return (unsigned)p; }
template <int CTRL> DEV float dppf(float x) { return __builtin_bit_cast(float, __builtin_amdgcn_mov_dpp(__builtin_bit_cast(int, x), CTRL, 0xf, 0xf, true)); }
constexpr int DPP_X1 = 0xB1, DPP_X2 = 0x4E, DPP_X3 = 0x1B, DPP_X7 = 0x141, DPP_X8 = 0x128;
DEV float swap16_sum(float x, float y) { auto s = __builtin_amdgcn_permlane16_swap(__float_as_uint(x), __float_as_uint(y), false, false); return __uint_as_float(s[0]) + __uint_as_float(s[1]); }
DEV float swap32_sum(float x, float y) { auto s = __builtin_amdgcn_permlane32_swap(__float_as_uint(x), __float_as_uint(y), false, false); return __uint_as_float(s[0]) + __uint_as_float(s[1]); }
DEV float swap16_max(float x) { auto s = __builtin_amdgcn_permlane16_swap(__float_as_uint(x), __float_as_uint(x), false, false); return fmaxf(__uint_as_float(s[0]), __uint_as_float(s[1])); }
DEV float swap32_max(float x) { auto s = __builtin_amdgcn_permlane32_swap(__float_as_uint(x), __float_as_uint(x), false, false); return fmaxf(__uint_as_float(s[0]), __uint_as_float(s[1])); }
DEV float xor32_get(float x, bool upper) { auto s = __builtin_amdgcn_permlane32_swap(__float_as_uint(x), __float_as_uint(x), false, false); return __uint_as_float(upper ? s[0] : s[1]); }
DEV float row_sum4(float v) { v += dppf<DPP_X1>(v); v += dppf<DPP_X2>(v); return v; }
DEV float row_sum16(float v) { v = row_sum4(v); v += dppf<DPP_X7>(v); v += dppf<DPP_X8>(v); return v; }
DEV float wave_sum(float v) { v = row_sum16(v); v = swap16_sum(v, v); return swap32_sum(v, v); }
DEV void lds_barrier() { asm volatile("s_waitcnt lgkmcnt(0)\n\ts_barrier" ::: "memory"); }
DEV float sigm(float x) { return 1.f / (1.f + expf(-x)); }
DEV float fsigm(float x) { return __builtin_amdgcn_rcpf(1.f + __builtin_amdgcn_exp2f(-1.4426950408889634f * x)); }
DEV float gelu_tanh(float x) { const float u = 0.7978845608028654f * (x + 0.044715f * x * x * x); return x * fsigm(2.f * u); }
DEV float siluf(float x) { return x / (1.f + expf(-x)); }
DEV float fsiluf(float x) { return x * fsigm(x); }

DEV void ld4bf(const bf16_t* p, float* v) { const u32x2 w = *(const u32x2*)p; v[0] = bf2f(w.x & 0xffffu); v[1] = bf2f(w.x >> 16); v[2] = bf2f(w.y & 0xffffu); v[3] = bf2f(w.y >> 16); }
DEV void st4bf(bf16_t* p, const float* v) { u32x2 w; w.x = pk2(v[0], v[1]); w.y = pk2(v[2], v[3]); *(u32x2*)p = w; }
DEV bf16_t* resrow(const Args& a, int r) { return (bf16_t*)(a.out + (size_t)r * D); }
DEV const float* modp(const Args& a, int l, int rowsel, int chunk) { return (const float*)(a.ws + WS_MOD) + ((size_t)(l * 9 + rowsel) * 6 + chunk) * 1024; }
DEV int modrow(int r) { return r < ML ? (r >> 12) : 8; }
DEV float lam_init(int l) { return l == 0 ? 0.2f : (0.8f - 0.6f * 0.7408182206817179f); }

DEV void p0_mod(const Args& a, float* lds) {
    const int tid = ltid(), lane = tid & 63, wave = tid >> 6;
    const float* c = a.in[1]; const float* cc = a.in[3];
    for (int i = tid; i < 9 * 1024; i += NTHREADS) { const float v = i < 8192 ? c[i] : cc[i - 8192]; lds[i] = siluf(v); }
    __syncthreads();
    float* red = lds + 9 * 1024;
    float* MOD = (float*)(a.ws + WS_MOD);
    for (int item = blockIdx.x; item < 192; item += gridDim.x) {
        const int l = item / 96, cgp = item % 96, col = cgp * 64 + lane;
        const float* w = a.in[4] + (size_t)l * 1024 * 6144 + col;
        float acc[9];
#pragma unroll
        for (int r = 0; r < 9; ++r) acc[r] = 0.f;
#pragma unroll 16
        for (int k = wave * 128; k < wave * 128 + 128; ++k) {
            const float wv = w[(size_t)k * 6144];
#pragma unroll
            for (int r = 0; r < 9; ++r) acc[r] += lds[r * 1024 + k] * wv;
        }
#pragma unroll
        for (int r = 0; r < 9; ++r) red[(wave * 9 + r) * 64 + lane] = acc[r];
        __syncthreads();
        for (int o = tid; o < 576; o += NTHREADS) {
            const int r = o >> 6, cl = o & 63; float s = 0.f;
#pragma unroll
            for (int w8 = 0; w8 < 8; ++w8) s += red[(w8 * 9 + r) * 64 + cl];
            MOD[(size_t)(l * 9 + r) * 6144 + cgp * 64 + cl] = s + a.in[5][l * 6144 + cgp * 64 + cl];
        }
        __syncthreads();
    }
}

template <int MODE, bool COMB = true> DEV void p1_norm(const Args& a) {
    const int tid = ltid(), lane = tid & 63, wave = tid >> 6;
    const int gw = blockIdx.x * NWAVES + wave, NGW = gridDim.x * NWAVES;
    const int l = MODE == 0 ? 0 : 1;
    const int lp = MODE == 2 ? 1 : 0;
    bf16_t* XN = (bf16_t*)(a.ws + WS_XN);
    const int* SEL = (const int*)(a.ws + WS_SEL); const float* AFF = (const float*)(a.ws + WS_AFF); const bf16_t* Y2 = (const bf16_t*)(a.ws + WS_Y2);
    float* XC = (float*)(a.ws + WS_XC);
    const int nrows = MODE == 2 ? ML : M;
    constexpr bool CMB = (MODE != 0) && COMB;
    f32x4 v[4], vn[4]; int mysel = -1, nsel = -1;
#define P1_SRC(rr) (MODE == 0 ? ((rr) < ML ? a.in[0] + (size_t)(rr) * D : a.in[2] + (size_t)((rr) - ML) * D) : ((rr) < ML ? (const float*)a.out + (size_t)(rr) * D : (const float*)XC + (size_t)((rr) - ML) * D))
#define P1_LOAD(dst, sel, rr) do { const int r_ = (rr); \
        if (MODE != 0 && r_ < ML) { const bf16_t* s_ = resrow(a, r_); _Pragma("unroll") for (int j = 0; j < 4; ++j) { float t_[4]; ld4bf(s_ + 256 * j + 4 * lane, t_); dst[j] = (f32x4){t_[0], t_[1], t_[2], t_[3]}; } } \
        else { const float* s_ = P1_SRC(r_); _Pragma("unroll") for (int j = 0; j < 4; ++j) dst[j] = *(const f32x4*)(s_ + 256 * j + 4 * lane); } \
        if (CMB) sel = SEL[(size_t)r_ * 16 + (lane & 15)]; } while (0)
    if (gw < nrows) P1_LOAD(v, mysel, gw);
    for (int r = gw; r < nrows; r += NGW) {
        if (r + NGW < nrows) P1_LOAD(vn, nsel, r + NGW);
        if (CMB) {
            float* dst = r < ML ? a.out + (size_t)r * D : XC + (size_t)(r - ML) * D;
            unsigned m = (unsigned)(__ballot(mysel >= 0) & 0xffffull);
            f32x4 acc[4];
#pragma unroll
            for (int j = 0; j < 4; ++j) acc[j] = (f32x4){0.f, 0.f, 0.f, 0.f};
            while (m) {
                int ee[4]; u32x2 w[4][4]; float af[4];
#pragma unroll
                for (int i = 0; i < 4; ++i) { if (m) { ee[i] = __builtin_ctz(m); m &= m - 1u; } else ee[i] = -1; }
#pragma unroll
                for (int i = 0; i < 4; ++i) if (ee[i] >= 0) { const int s = __builtin_amdgcn_readlane(mysel, ee[i]); af[i] = AFF[ee[i] * SLOTS + s]; const bf16_t* yr = Y2 + ((size_t)ee[i] * SLOTS + s) * D;
#pragma unroll
                    for (int j = 0; j < 4; ++j) w[i][j] = *(const u32x2*)(yr + 256 * j + 4 * lane); }
#pragma unroll
                for (int i = 0; i < 4; ++i) if (ee[i] >= 0) {
#pragma unroll
                    for (int j = 0; j < 4; ++j) { acc[j].x += af[i] * bf2f(w[i][j].x & 0xffffu); acc[j].y += af[i] * bf2f(w[i][j].x >> 16); acc[j].z += af[i] * bf2f(w[i][j].y & 0xffffu); acc[j].w += af[i] * bf2f(w[i][j].y >> 16); } }
            }
            const float* g2 = modp(a, lp, modrow(r), 5);
#pragma unroll
            for (int j = 0; j < 4; ++j) { const f32x4 g = *(const f32x4*)(g2 + 256 * j + 4 * lane); v[j] += g * acc[j];
                if (MODE == 1 && r < ML) { float t_[4] = {v[j].x, v[j].y, v[j].z, v[j].w}; st4bf(resrow(a, r) + 256 * j + 4 * lane, t_); }
                else *(f32x4*)(dst + 256 * j + 4 * lane) = v[j]; }
        }
        if (MODE != 2) {
            float ss = 0.f;
#pragma unroll
            for (int j = 0; j < 4; ++j) ss += (v[j].x * v[j].x + v[j].y * v[j].y) + (v[j].z * v[j].z + v[j].w * v[j].w);
            const float rstd = __builtin_amdgcn_rsqf(wave_sum(ss) * (1.f / D) + EPS);
            const float* g = a.in[6] + l * D; const float* sh = modp(a, l, modrow(r), 0); const float* sc = modp(a, l, modrow(r), 1);
#pragma unroll
            for (int j = 0; j < 4; ++j) {
                const int c0 = 256 * j + 4 * lane; const f32x4 gg = *(const f32x4*)(g + c0), s1 = *(const f32x4*)(sc + c0), s0 = *(const f32x4*)(sh + c0);
                const f32x4 y = v[j] * rstd * gg * (1.f + s1) + s0; float t[4] = {y.x, y.y, y.z, y.w}; st4bf(XN + (size_t)r * D + c0, t);
            }
        }
#pragma unroll
        for (int j = 0; j < 4; ++j) v[j] = vn[j];
        mysel = nsel;
    }
#undef P1_SRC
#undef P1_LOAD
}

DEV void transpose_item(const float* W, int N, int K, bf16_t* WT, int k0, int n0, int drow0, float* scr, int lane) {
    float t32[32];
#pragma unroll
    for (int i = 0; i < 32; ++i) t32[i] = W[(size_t)(k0 + 2 * i + (lane >> 5)) * N + n0 + (lane & 31)];
#pragma unroll
    for (int i = 0; i < 32; ++i) scr[(2 * i + (lane >> 5)) * 33 + (lane & 31)] = t32[i];
    const int c = lane & 7;
#pragma unroll
    for (int j = 0; j < 4; ++j) { const int n = (lane >> 3) + 8 * j; const float* s = scr + (8 * c) * 33 + n;
        u32x4 o; o.x = pk2(s[0 * 33], s[1 * 33]); o.y = pk2(s[2 * 33], s[3 * 33]); o.z = pk2(s[4 * 33], s[5 * 33]); o.w = pk2(s[6 * 33], s[7 * 33]);
        *(u32x4*)(WT + (size_t)(drow0 + n) * K + k0 + 8 * c) = o; }
}
DEV void transpose_item8(const float* W, int N, unsigned char* WT8, int k0, int n0, int drow0, float* scr, int lane, float sc = 32.f) {
    float t32[32];
#pragma unroll
    for (int i = 0; i < 32; ++i) t32[i] = W[(size_t)(k0 + 2 * i + (lane >> 5)) * N + n0 + (lane & 31)];
#pragma unroll
    for (int i = 0; i < 32; ++i) scr[(2 * i + (lane >> 5)) * 33 + (lane & 31)] = t32[i];
    const int c = lane & 7;
#pragma unroll
    for (int j = 0; j < 4; ++j) { const int n = (lane >> 3) + 8 * j; const float* s = scr + (8 * c) * 33 + n;
        u32x2 o; o.x = pk_fp8x4(s[0 * 33] * sc, s[1 * 33] * sc, s[2 * 33] * sc, s[3 * 33] * sc); o.y = pk_fp8x4(s[4 * 33] * sc, s[5 * 33] * sc, s[6 * 33] * sc, s[7 * 33] * sc);
        *(u32x2*)(WT8 + (size_t)(drow0 + n) * 1024 + k0 + 8 * c) = o; }
}
DEV void p1_weights(const Args& a, int l, float* lds) {
    const int tid = ltid(), lane = tid & 63, wave = tid >> 6;
    float* scr = lds + wave * (64 * 33);
    const int gw = blockIdx.x * NWAVES + wave, NGW = gridDim.x * NWAVES;
    bf16_t* WT = (bf16_t*)(a.ws + WS_WT);
    for (int i = blockIdx.x * NTHREADS + tid; i < 8192; i += gridDim.x * NTHREADS) {
        const int ln = i & 63, ks = (i >> 6) & 3, nt = (i >> 8) & 1, mat = i >> 9;
        const float* p = a.in[18] + ((size_t)(l * 16 + mat) * 64 + 16 * ks + 8 * (ln >> 5)) * 64 + nt * 32 + (ln & 31);
        constexpr float NL = -1.4426950408889634f;
        u32x4 x; x.x = pk2(NL * p[0], NL * p[64]); x.y = pk2(NL * p[128], NL * p[192]); x.z = pk2(NL * p[256], NL * p[320]); x.w = pk2(NL * p[384], NL * p[448]);
        *(u32x4*)(a.ws + WS_LRUW + (size_t)i * 16) = x; }
    constexpr int I_IN = 16 * 96, I_OUT = 16 * 32, I_E = 16 * 32;
    constexpr int NITEMS = I_IN + I_OUT + 16 * 3 * I_E;
    for (int it = gw; it < NITEMS; it += NGW) {
        int r = it;
        if (r < I_IN) { const int kb = r / 96, nb = r % 96; transpose_item(a.in[8] + (size_t)l * 1024 * 3072, 3072, 1024, WT + WT_IN / 2, 64 * kb, 32 * nb, 32 * nb, scr, lane); continue; } r -= I_IN;
        if (r < I_OUT) { const int kb = r / 32, nb = r % 32; transpose_item(a.in[9] + (size_t)l * 1024 * 1024, 1024, 1024, WT + WT_OUT / 2, 64 * kb, 32 * nb, 32 * nb, scr, lane); continue; } r -= I_OUT;
        const int e = r / (3 * I_E), q = (r / I_E) % 3, rr = r % I_E, kb = rr / 32, nb = rr % 32, n0 = 32 * nb;
        const size_t eoff = ((size_t)l * 16 + e) * 1024 * 1024;
        if (q < 2 && USE_FP8_MOE1) transpose_item8((q == 0 ? a.in[23] : a.in[24]) + eoff, 1024, (unsigned char*)(WT + WT_GU / 2) + (size_t)e * 2048 * 1024, 64 * kb, n0, (n0 >> 7) * 256 + q * 128 + (n0 & 127), scr, lane, q == 0 ? -32.f * 1.4426950408889634f : 32.f);
        else if (q == 0) transpose_item(a.in[23] + eoff, 1024, 1024, WT + WT_GU / 2 + (size_t)e * 2048 * 1024, 64 * kb, n0, (n0 >> 7) * 256 + (n0 & 127), scr, lane);
        else if (q == 1) transpose_item(a.in[24] + eoff, 1024, 1024, WT + WT_GU / 2 + (size_t)e * 2048 * 1024, 64 * kb, n0, (n0 >> 7) * 256 + 128 + (n0 & 127), scr, lane);
        else if (USE_FP8_MOE2) transpose_item8(a.in[25] + eoff, 1024, (unsigned char*)(WT + WT_DN / 2) + (size_t)e * 1024 * 1024, 64 * kb, n0, n0, scr, lane);
        else transpose_item(a.in[25] + eoff, 1024, 1024, WT + WT_DN / 2 + (size_t)e * 1024 * 1024, 64 * kb, n0, n0, scr, lane);
    }
}

template <bool DUAL, class EPI> DEV void sgemm_tile(const bf16_t* A, const float* B, const float* B2, int ldb, float* lds, EPI epi) {
    const int tid = ltid(), tx = tid & 15, ty = tid >> 4;
    float* As = lds;
    float* Bs = lds + 16 * 132;
    float* Bs2 = Bs + 16 * 64;
    float acc[4][4], acc2[4][4];
#pragma unroll
    for (int i = 0; i < 4; ++i)
#pragma unroll
        for (int j = 0; j < 4; ++j) { acc[i][j] = 0.f; acc2[i][j] = 0.f; }
    for (int k0 = 0; k0 < 1024; k0 += 16) {
        { const int r = tid >> 2, kq = (tid & 3) * 4; float t[4]; ld4bf(A + (size_t)r * 1024 + k0 + kq, t);
#pragma unroll
            for (int j = 0; j < 4; ++j) As[(kq + j) * 132 + r] = t[j]; }
        if (tid < 256) { const int kk = tid >> 4, c4 = (tid & 15) * 4; *(f32x4*)(Bs + kk * 64 + c4) = *(const f32x4*)(B + (size_t)(k0 + kk) * ldb + c4); }
        else if (DUAL) { const int t2 = tid - 256, kk = t2 >> 4, c4 = (t2 & 15) * 4; *(f32x4*)(Bs2 + kk * 64 + c4) = *(const f32x4*)(B2 + (size_t)(k0 + kk) * ldb + c4); }
        __syncthreads();
#pragma unroll
        for (int kk = 0; kk < 16; ++kk) {
            const f32x4 av = *(const f32x4*)(As + kk * 132 + ty * 4), bv = *(const f32x4*)(Bs + kk * 64 + tx * 4);
            const float aa[4] = {av.x, av.y, av.z, av.w}, bb[4] = {bv.x, bv.y, bv.z, bv.w};
#pragma unroll
            for (int i = 0; i < 4; ++i)
#pragma unroll
                for (int j = 0; j < 4; ++j) acc[i][j] += aa[i] * bb[j];
            if (DUAL) { const f32x4 b2 = *(const f32x4*)(Bs2 + kk * 64 + tx * 4); const float b2b[4] = {b2.x, b2.y, b2.z, b2.w};
#pragma unroll
                for (int i = 0; i < 4; ++i)
#pragma unroll
                    for (int j = 0; j < 4; ++j) acc2[i][j] += aa[i] * b2b[j]; }
        }
        __syncthreads();
    }
#pragma unroll
    for (int i = 0; i < 4; ++i)
#pragma unroll
        for (int j = 0; j < 4; ++j) epi(ty * 4 + i, tx * 4 + j, acc[i][j], acc2[i][j]);
}

DEV void p2_inproj_simple(const Args& a, int l, float* lds) {
    const bf16_t* XN = (const bf16_t*)(a.ws + WS_XN); bf16_t* Y = (bf16_t*)(a.ws + WS_Y);
    const float* W = a.in[8] + (size_t)l * 1024 * 3072;
    const int ntm = M / 128, ntn = 3072 / 64;
    for (int it = blockIdx.x; it < ntm * ntn; it += gridDim.x) {
        const int tm = it / ntn, tn = it % ntn, row0 = tm * 128, col0 = tn * 64;
        sgemm_tile<false>(XN + (size_t)row0 * 1024, W + col0, nullptr, 3072, lds, [&](int i, int j, float v, float) {
            const int col = col0 + j; Y[(size_t)(col >> 8) * YARR + (size_t)(row0 + i) * 256 + (col & 255)] = (bf16_t)f2bf(v); });
    }
}

DEV void p6_outproj_simple(const Args& a, int l, float* lds) {
    const bf16_t* MIX = (const bf16_t*)(a.ws + WS_MIX); const float* W = a.in[9] + (size_t)l * 1024 * 1024;
    const int nrows = l == 0 ? M : ML, ntm = nrows / 128, ntn = 1024 / 64;
    for (int it = blockIdx.x; it < ntm * ntn; it += gridDim.x) {
        const int tm = it / ntn, tn = it % ntn, row0 = tm * 128, col0 = tn * 64;
        const float* g1 = modp(a, l, modrow(row0), 2);
        const float* base; float* dst;
        if (row0 < ML) { base = (l == 0 ? a.in[0] : a.out) + (size_t)row0 * D; dst = a.out + (size_t)row0 * D; }
        else { base = a.in[2] + (size_t)(row0 - ML) * D; dst = (float*)(a.ws + WS_XC) + (size_t)(row0 - ML) * D; }
        sgemm_tile<false>(MIX + (size_t)row0 * 1024, W + col0, nullptr, 1024, lds, [&](int i, int j, float v, float) {
            const int col = col0 + j; dst[(size_t)i * D + col] = base[(size_t)i * D + col] + g1[col] * v; });
    }
}

DEV void p9_moe1_simple(const Args& a, int l, float* lds) {
    const bf16_t* XG = (const bf16_t*)(a.ws + WS_XG); bf16_t* HID = (bf16_t*)(a.ws + WS_HID);
    const int rows_e = l == 0 ? SLOTS : NB * CAPL, ntm = rows_e / 128, ntn = 1024 / 64;
    for (int it = blockIdx.x; it < 16 * ntm * ntn; it += gridDim.x) {
        const int e = it / (ntm * ntn), rem = it % (ntm * ntn), tm = rem / ntn, tn = rem % ntn, row0 = tm * 128, col0 = tn * 64;
        const size_t eoff = ((size_t)l * 16 + e) * 1024 * 1024;
        bf16_t* hp = HID + ((size_t)e * SLOTS + row0) * 1024;
        sgemm_tile<true>(XG + ((size_t)e * SLOTS + row0) * 1024, a.in[23] + eoff + col0, a.in[24] + eoff + col0, 1024, lds, [&](int i, int j, float g, float u) {
            hp[(size_t)i * 1024 + col0 + j] = (bf16_t)f2bf(siluf(g) * u); });
    }
}

DEV void p10_moe2_simple(const Args& a, int l, float* lds) {
    const bf16_t* HID = (const bf16_t*)(a.ws + WS_HID); bf16_t* Y2 = (bf16_t*)(a.ws + WS_Y2);
    const int rows_e = l == 0 ? SLOTS : NB * CAPL, ntm = rows_e / 128, ntn = 1024 / 64;
    for (int it = blockIdx.x; it < 16 * ntm * ntn; it += gridDim.x) {
        const int e = it / (ntm * ntn), rem = it % (ntm * ntn), tm = rem / ntn, tn = rem % ntn, row0 = tm * 128, col0 = tn * 64;
        const size_t eoff = ((size_t)l * 16 + e) * 1024 * 1024;
        bf16_t* yp = Y2 + ((size_t)e * SLOTS + row0) * 1024;
        sgemm_tile<false>(HID + ((size_t)e * SLOTS + row0) * 1024, a.in[25] + eoff + col0, nullptr, 1024, lds, [&](int i, int j, float v, float) {
            yp[(size_t)i * 1024 + col0 + j] = (bf16_t)f2bf(v); });
    }
}


#define LDS3(p) ((__attribute__((address_space(3))) unsigned char*)(p))
DEV void p2_inproj_mfma(const Args& a, int l, unsigned char* lds_raw) {
    { unsigned* TAB = (unsigned*)(lds_raw + pg8::STAGE_BYTES);
      for (int i = ltid(); i < 1024; i += NTHREADS) { const float inv = exp2f(-(float)(i & 15) * (13.287712379549449f / 16.f)); float sn, cs; sincosf((float)(i >> 4) * inv, &sn, &cs); TAB[i] = f2bf(cs) | (f2bf(sn) << 16); }
      __syncthreads(); }
    pg8::Gemm g{(const bf16_t*)(a.ws + WS_XN), (const bf16_t*)(a.ws + WS_WT + WT_IN), M, 3072, 1024}; pg8::StaticOrder S; S.init(M, 3072, gridDim.x, blockIdx.x);
    pg8::EpiInproj E{{(bf16_t*)(a.ws + WS_Y), 256, nullptr, 256, YARR, 1.f}, a.in[10] + l * 64, a.in[11] + l * 64, C2, EPS, LDS3(lds_raw) + pg8::STAGE_BYTES};
    pg8::gemm_phase<pg8::EpiInproj, pg8::StaticOrder, true, true>(LDS3(lds_raw), g, S, E);
}
DEV void p6_outproj_mfma(const Args& a, int l, unsigned char* lds_raw) {
    const int nrows = l == 0 ? M : ML;
    pg8::Gemm g{(const bf16_t*)(a.ws + WS_MIX), (const bf16_t*)(a.ws + WS_WT + WT_OUT), nrows, 1024, 1024}; pg8::StaticOrder S; S.init(nrows, 1024, gridDim.x, blockIdx.x);
    pg8::EpiRes E{a.in[0], a.out, a.in[2], (float*)(a.ws + WS_XC), (const float*)(a.ws + WS_MOD) + (size_t)l * 9 * 6144, l};
    pg8::gemm_phase<pg8::EpiRes, pg8::StaticOrder, true, true>(LDS3(lds_raw), g, S, E);
}
DEV void p9_moe1_mfma(const Args& a, int l, unsigned char* lds_raw) {
    pg8::Gemm g{(const bf16_t*)(a.ws + WS_XN), (const bf16_t*)(a.ws + WS_WT + WT_GU), 16 * SLOTS, 16 * 2048, 512};
    pg8::GroupOrder S{l == 0 ? 17 : 16, 8, (int)gridDim.x, (int)blockIdx.x};
    pg8::EpiSwiglu E{(bf16_t*)(a.ws + WS_HID)};
    pg8::gemm_phase_gather<pg8::EpiSwiglu, pg8::GroupOrder, true, true>(LDS3(lds_raw), g, (const int*)(a.ws + WS_IDX), S, E);
}
DEV void p10_moe2_mfma(const Args& a, int l, unsigned char* lds_raw) {
    pg8::Gemm g{(const bf16_t*)(a.ws + WS_HID), (const bf16_t*)(a.ws + WS_WT + WT_DN), 16 * SLOTS, 16 * 1024, USE_FP8_MOE2 ? 512 : 1024};
    pg8::GroupOrder S{l == 0 ? 17 : 16, 4, (int)gridDim.x, (int)blockIdx.x};
    pg8::EpiBf16Grp E{(bf16_t*)(a.ws + WS_Y2), 1024, 4};
    if (USE_FP8_MOE2) pg8::gemm_phase_fp8<pg8::EpiBf16Grp, pg8::GroupOrder, true>(LDS3(lds_raw), g, S, E, 122, 124);
    else pg8::gemm_phase<pg8::EpiBf16Grp, pg8::GroupOrder, true, true>(LDS3(lds_raw), g, S, E);
}
DEV void p3_qknorm(const Args& a, int l, float* ldsf) {
    const int tid = ltid(), lane = tid & 63, wave = tid >> 6;
    const int gw = blockIdx.x * NWAVES + wave, NGW = gridDim.x * NWAVES;
    bf16_t* Y = (bf16_t*)(a.ws + WS_Y);
    const int d0 = (lane & 15) * 4;
    float* TC = ldsf; float* TS = ldsf + 1024;
    for (int i = tid; i < 1024; i += NTHREADS) { const float inv = exp2f(-(float)(i & 15) * (13.287712379549449f / 16.f)); float sn, cs; sincosf((float)(i >> 4) * inv, &sn, &cs); TC[i] = cs; TS[i] = sn; }
    __syncthreads();
    u32x2 w[4], wn[4];
#define QK_LOAD(dst, rr) do { _Pragma("unroll") for (int arr = 0; arr < 4; ++arr) dst[arr] = *(const u32x2*)(Y + (size_t)arr * YARR + (size_t)(rr) * 256 + lane * 4); } while (0)
    if (gw < M) QK_LOAD(w, gw);
    float gq[4], gk[4];
#pragma unroll
    for (int j = 0; j < 4; ++j) { gq[j] = a.in[10][l * 64 + d0 + j]; gk[j] = a.in[11][l * 64 + d0 + j]; }
    for (int r = gw; r < M; r += NGW) {
        if (r + NGW < M) QK_LOAD(wn, r + NGW);
        f32x4 c4 = (f32x4){1.f, 1.f, 1.f, 1.f}, s4 = (f32x4){0.f, 0.f, 0.f, 0.f};
        if (r < ML) { const int t = r & 4095, pos = ((lane & 15) < 8) ? (t >> 6) : (t & 63); c4 = *(const f32x4*)(TC + pos * 16 + (d0 & 15)); s4 = *(const f32x4*)(TS + pos * 16 + (d0 & 15)); }
        const float cs[4] = {c4.x, c4.y, c4.z, c4.w}, sn[4] = {s4.x, s4.y, s4.z, s4.w};
        const bool first = (lane & 4) == 0;
#pragma unroll
        for (int arr = 0; arr < 4; ++arr) {
            float v[4] = {bf2f(w[arr].x & 0xffffu), bf2f(w[arr].x >> 16), bf2f(w[arr].y & 0xffffu), bf2f(w[arr].y >> 16)};
            float ss = v[0] * v[0] + v[1] * v[1] + v[2] * v[2] + v[3] * v[3];
            ss = row_sum16(ss);
            const float rstd = 1.0f / sqrtf(ss * (1.f / 64.f) + EPS) * (arr < 2 ? C2 : 1.f);
#pragma unroll
            for (int j = 0; j < 4; ++j) v[j] *= rstd * (arr < 2 ? gq[j] : gk[j]);
            if (r < ML) {
#pragma unroll
                for (int j = 0; j < 4; ++j) { const float pv = dppf<DPP_X3>(dppf<DPP_X7>(v[j])); v[j] = first ? (v[j] * cs[j] - pv * sn[j]) : (pv * sn[j] + v[j] * cs[j]); }
            }
            st4bf(Y + (size_t)arr * YARR + (size_t)r * 256 + lane * 4, v);
        }
#pragma unroll
        for (int arr = 0; arr < 4; ++arr) w[arr] = wn[arr];
    }
#undef QK_LOAD
}

DEV int ret_row0(int b, int c) { return c < 2 ? ML + b * 256 + c * 128 : b * 4096 + (c - 2) * 128; }
DEV void p3_retU(const Args& a, int l, float* lds) {
    const int tid = ltid();
    float* Ks = lds; float* Vs = lds + 128 * 64;
    const bf16_t* Y = (const bf16_t*)(a.ws + WS_Y); float* RS = (float*)(a.ws + WS_RETS);
    for (int it = blockIdx.x; it < NB * 4 * RET_CH; it += gridDim.x) {
        const int c = it % RET_CH, bh = it / RET_CH, h = bh & 3, b = bh >> 2, row0 = ret_row0(b, c);
        for (int i = tid; i < 128 * 16; i += NTHREADS) { const int m = i >> 4, q4 = (i & 15) * 4;
            ld4bf(Y + 7 * YARR + (size_t)(row0 + m) * 256 + h * 64 + q4, Ks + m * 64 + q4); ld4bf(Y + 8 * YARR + (size_t)(row0 + m) * 256 + h * 64 + q4, Vs + m * 64 + q4); }
        __syncthreads();
        const float lgf = a.in[14][l * 8 + h], lgb = a.in[14][l * 8 + 4 + h];
        const int d = tid >> 3, v0 = (tid & 7) * 8;
        float af[8], ab[8];
#pragma unroll
        for (int j = 0; j < 8; ++j) { af[j] = 0.f; ab[j] = 0.f; }
        for (int m = 0; m < 128; ++m) {
            const float kk = Ks[m * 64 + d] * 0.125f, wf = kk * expf(lgf * (float)(127 - m)), wb = kk * expf(lgb * (float)m);
#pragma unroll
            for (int j = 0; j < 8; ++j) { const float vv = Vs[m * 64 + v0 + j]; af[j] += wf * vv; ab[j] += wb * vv; }
        }
        float* o = RS + ((size_t)(bh * RET_CH + c) * 2) * 4096 + d * 64 + v0;
#pragma unroll
        for (int j = 0; j < 8; ++j) { o[j] = af[j]; o[4096 + j] = ab[j]; }
        __syncthreads();
    }
}

constexpr int UBP_ = 132;
constexpr float LOG2E_F = 1.4426950408889634f;
DEV void lru_fetch(const Args& a, int b, int c, int tid, u32x2 (&pre)[5]) {
    const bf16_t* YX = (const bf16_t*)(a.ws + WS_Y) + 10 * YARR;
    const int seqlen = c < 8 ? 256 : 4096, t0 = c < 8 ? c * 32 : (c - 8) * 32, rowbase = c < 8 ? ML + b * 256 : b * 4096;
#pragma unroll
    for (int q = 0; q < 5; ++q) { const int i = tid + q * NTHREADS, ri = i >> 6, c4 = (i & 63) * 4, ts = t0 - 2 + ri; pre[q] = (u32x2){0u, 0u};
        if (i < 35 * 64 && ts >= 0 && ts < seqlen) pre[q] = *(const u32x2*)(YX + (size_t)(rowbase + ts) * 256 + c4); }
}
constexpr int LRU_CW = 30000;
DEV void lru_conv_init(const Args& a, int l, int tid, float* lds) {
    for (int i = tid; i < 1280; i += NTHREADS) lds[LRU_CW + i] = i < 1024 ? a.in[16][l * 1024 + i] : a.in[17][l * 256 + i - 1024];
}
DEV void lru_load_u(const u32x2 (&pre)[5], float* Xs, float* Us, unsigned* UB) {
    const int tid = ltid();
#pragma unroll
    for (int q = 0; q < 5; ++q) { const int i = tid + q * NTHREADS, ri = i >> 6, c4 = (i & 63) * 4;
        if (i < 35 * 64) *(f32x4*)(Xs + ri * 256 + c4) = (f32x4){bf2f(pre[q].x & 0xffffu), bf2f(pre[q].x >> 16), bf2f(pre[q].y & 0xffffu), bf2f(pre[q].y >> 16)}; }
    lds_barrier();
    const int cp = tid & 127, q = tid >> 7;
    f32x2_t cw[5];
#pragma unroll
    for (int k = 0; k < 5; ++k) cw[k] = *(const f32x2_t*)(Xs + LRU_CW + k * 256 + 2 * cp);
#pragma unroll
    for (int hf = 0; hf < 2; ++hf) { f32x2_t xr[7];
#pragma unroll
        for (int i = 0; i < 7; ++i) xr[i] = *(const f32x2_t*)(Xs + (q * 8 + hf * 4 + i) * 256 + 2 * cp);
#pragma unroll
        for (int t = 0; t < 4; ++t) { const int tt = q * 8 + hf * 4 + t;
            const float u0 = cw[4].x + cw[0].x * xr[t].x + cw[1].x * xr[t + 1].x + cw[2].x * xr[t + 2].x + cw[3].x * xr[t + 3].x;
            const float u1 = cw[4].y + cw[0].y * xr[t].y + cw[1].y * xr[t + 1].y + cw[2].y * xr[t + 2].y + cw[3].y * xr[t + 3].y;
            *(f32x2_t*)(Us + tt * 256 + 2 * cp) = (f32x2_t){u0, u1}; UB[tt * UBP_ + cp] = pk2(u0, u1); } }
    lds_barrier();
}
struct LruGate { unsigned wr[32], wi[32]; float br, bi, cl; };
DEV void lru_gate_init(const Args& a, int l, int dir, int ch, LruGate& G) {
    const int blk = ch >> 6, cc = ch & 63;
    const float* w = a.in[18] + ((size_t)(((l * 2 + dir) * 2 + 0) * 4 + blk) * 64) * 64 + cc;
    const float* w2 = a.in[18] + ((size_t)(((l * 2 + dir) * 2 + 1) * 4 + blk) * 64) * 64 + cc;
#pragma unroll
    for (int c = 0; c < 32; ++c) { G.wr[c] = pk2(w[(2 * c) * 64], w[(2 * c + 1) * 64]); G.wi[c] = pk2(w2[(2 * c) * 64], w2[(2 * c + 1) * 64]); }
    G.br = a.in[19][((l * 2 + dir) * 2 + 0) * 256 + ch]; G.bi = a.in[19][((l * 2 + dir) * 2 + 1) * 256 + ch];
    G.cl = -8.f * log1pf(expf(-a.in[20][(l * 2 + dir) * 256 + ch]));
}
DEV void lru_ab(const LruGate& G, const float* Us, const unsigned* UB, int tt, int ch, float& aa, float& bb) {
    const unsigned* u = UB + tt * UBP_ + ((ch >> 6) << 5);
    float ur = G.br, ui = G.bi, ur2 = 0.f, ui2 = 0.f;
#pragma unroll
    for (int c4 = 0; c4 < 8; ++c4) { const u32x4 x = *(const u32x4*)(u + c4 * 4);
        ur = dot2bf(G.wr[4 * c4], x.x, ur); ur2 = dot2bf(G.wr[4 * c4 + 1], x.y, ur2); ur = dot2bf(G.wr[4 * c4 + 2], x.z, ur); ur2 = dot2bf(G.wr[4 * c4 + 3], x.w, ur2);
        ui = dot2bf(G.wi[4 * c4], x.x, ui); ui2 = dot2bf(G.wi[4 * c4 + 1], x.y, ui2); ui = dot2bf(G.wi[4 * c4 + 2], x.z, ui); ui2 = dot2bf(G.wi[4 * c4 + 3], x.w, ui2); }

    const float la = G.cl * fsigm(ur + ur2); aa = __builtin_amdgcn_exp2f(1.4426950408889634f * la); bb = __builtin_amdgcn_sqrtf(fmaxf(1.f - aa * aa, 0.f)) * fsigm(ui + ui2) * Us[tt * 256 + ch];

}

DEV void p3_lru_agg(const Args& a, int l, float* lds) {
    const int tid = ltid(), ch = tid & 255, dir = tid >> 8;
    float* Xs = lds; float* Us = lds + 35 * 256; unsigned* UB = (unsigned*)(Us + 32 * 256);
    float* AGG = (float*)(a.ws + WS_LAGG);
    LruGate G; lru_gate_init(a, l, dir, ch, G);
    for (int it = blockIdx.x; it < NB * LRU_CH; it += gridDim.x) {
        const int b = it / LRU_CH, c = it % LRU_CH;
        { u32x2 pre_[5]; lru_conv_init(a, l, tid, lds); lru_fetch(a, b, c, tid, pre_); lru_load_u(pre_, Xs, Us, UB); }
        float P = 1.f, H = 0.f;
#pragma unroll 4
        for (int tt = 0; tt < 32; ++tt) { float aa, bb; lru_ab(G, Us, UB, tt, ch, aa, bb); H = dir == 0 ? aa * H + bb : H + P * bb; P *= aa; }
        float* o = AGG + ((size_t)(b * LRU_CH + c) * 2 + dir) * 512 + ch; o[0] = P; o[256] = H;
        __syncthreads();
    }
}


constexpr int UBP = 132;
struct LruW { bf16x8_t w[2][2][4]; float br[2], bi[2], cl[2]; };
DEV void lru_w_init(const Args& a, int l, int dir, int blk, int r32, int hi, LruW& W) {
#pragma unroll
    for (int g = 0; g < 2; ++g)
#pragma unroll
        for (int nt = 0; nt < 2; ++nt) {
#pragma unroll
            for (int ks = 0; ks < 4; ++ks) W.w[g][nt][ks] = *(const bf16x8_t*)(a.ws + WS_LRUW + ((size_t)(((((dir * 2 + g) * 4 + blk) * 2 + nt) * 4 + ks) * 64) + hi * 32 + r32) * 16); }
#pragma unroll
    for (int nt = 0; nt < 2; ++nt) { const int ch = blk * 64 + nt * 32 + r32;
        W.br[nt] = -1.4426950408889634f * a.in[19][((l * 2 + dir) * 2 + 0) * 256 + ch]; W.bi[nt] = -1.4426950408889634f * a.in[19][((l * 2 + dir) * 2 + 1) * 256 + ch];
        W.cl[nt] = -8.f * LOG2E_F * log1pf(expf(-a.in[20][(l * 2 + dir) * 256 + ch])); }
}
DEV void lru_ufrags(const unsigned* UB, int blk, int r32, int hi, bf16x8_t (&uf)[4]) {
#pragma unroll
    for (int ks = 0; ks < 4; ++ks) uf[ks] = *(const bf16x8_t*)((const unsigned char*)UB + r32 * (UBP * 4) + (blk * 64 + 16 * ks + 8 * hi) * 2);
}
DEV void lru_ab_nt(const LruW& W, const bf16x8_t (&uf)[4], const float* Us, int blk, int r32, int hi, int nt, f32x16& A, f32x16& B) {
    f32x16 gr, gi;
#pragma unroll
    for (int r = 0; r < 16; ++r) { gr[r] = W.br[nt]; gi[r] = W.bi[nt]; }
#pragma unroll
    for (int ks = 0; ks < 4; ++ks) { gr = __builtin_amdgcn_mfma_f32_32x32x16_bf16(uf[ks], W.w[0][nt][ks], gr, 0, 0, 0); gi = __builtin_amdgcn_mfma_f32_32x32x16_bf16(uf[ks], W.w[1][nt][ks], gi, 0, 0, 0); }
#pragma unroll
    for (int r = 0; r < 16; ++r) { const float aa = __builtin_amdgcn_exp2f(W.cl[nt] * __builtin_amdgcn_rcpf(1.f + __builtin_amdgcn_exp2f(gr[r])));
        A[r] = aa; B[r] = __builtin_amdgcn_sqrtf(fmaxf(1.f - aa * aa, 0.f)) * __builtin_amdgcn_rcpf(1.f + __builtin_amdgcn_exp2f(gi[r])) * Us[crow16(r, hi) * 256 + blk * 64 + nt * 32 + r32]; }
}
template <bool FWD> DEV void lru_segs(const f32x16& A, const f32x16& B, float (&Am)[4], float (&Bm)[4]) {
#pragma unroll
    for (int s = 0; s < 4; ++s) { float pa = 1.f, pb = 0.f;
#pragma unroll
        for (int i = 0; i < 4; ++i) { const int r = 4 * s + (FWD ? i : 3 - i); pb = A[r] * pb + B[r]; pa *= A[r]; }
        Am[s] = pa; Bm[s] = pb; }
}
template <bool FWD> DEV float lru_walk(const float (&Am)[4], const float (&Bm)[4], int hi, float h, float (&start)[4]) {
#pragma unroll
    for (int q = 0; q < 4; ++q) { const int s = FWD ? q : 3 - q;
        const auto sa = __builtin_amdgcn_permlane32_swap(__float_as_uint(Am[s]), __float_as_uint(Am[s]), false, false), sb = __builtin_amdgcn_permlane32_swap(__float_as_uint(Bm[s]), __float_as_uint(Bm[s]), false, false);
        const float Ae = __uint_as_float(sa[0]), Be = __uint_as_float(sb[0]), Ao = __uint_as_float(sa[1]), Bo = __uint_as_float(sb[1]);
        if (FWD) { const float h1 = Ae * h + Be; start[s] = hi ? h1 : h; h = Ao * h1 + Bo; }
        else { const float h1 = Ao * h + Bo; start[s] = hi ? h : h1; h = Ae * h1 + Be; } }
    return h;
}
DEV void p3_lru_agg_mfma(const Args& a, int l, float* lds) {
    const int tid = ltid(), lane = tid & 63, wave = __builtin_amdgcn_readfirstlane(tid >> 6), r32 = lane & 31, hi = lane >> 5, dir = wave >> 2, blk = wave & 3;
    float* Xs = lds; float* Us = lds + 35 * 256; unsigned* UB = (unsigned*)(Us + 32 * 256);
    float* AGG = (float*)(a.ws + WS_LAGG);
    LruW W; lru_w_init(a, l, dir, blk, r32, hi, W);
    lru_conv_init(a, l, tid, lds);
    u32x2 pre[5];
    const int vb = (blockIdx.x + 64) % gridDim.x;
    if (vb < NB * LRU_CH) lru_fetch(a, vb / LRU_CH, vb % LRU_CH, tid, pre);
    for (int it = vb; it < NB * LRU_CH; it += gridDim.x) {
        const int b = it / LRU_CH, c = it % LRU_CH;
        lru_load_u(pre, Xs, Us, UB);
        if (it + (int)gridDim.x < NB * LRU_CH) lru_fetch(a, (it + gridDim.x) / LRU_CH, (it + gridDim.x) % LRU_CH, tid, pre);
        bf16x8_t uf[4]; lru_ufrags(UB, blk, r32, hi, uf);
#pragma unroll
        for (int nt = 0; nt < 2; ++nt) { float Am[4], Bm[4], st[4]; float h, P; f32x16 A, B; lru_ab_nt(W, uf, Us, blk, r32, hi, nt, A, B);
            if (dir == 0) { lru_segs<true>(A, B, Am, Bm); h = lru_walk<true>(Am, Bm, hi, 0.f, st); } else { lru_segs<false>(A, B, Am, Bm); h = lru_walk<false>(Am, Bm, hi, 0.f, st); }
            P = Am[0] * Am[1] * Am[2] * Am[3]; { const auto sp = __builtin_amdgcn_permlane32_swap(__float_as_uint(P), __float_as_uint(P), false, false); P = __uint_as_float(sp[0]) * __uint_as_float(sp[1]); }
            if (hi == 0) { float* o = AGG + ((size_t)(b * LRU_CH + c) * 2 + dir) * 512 + blk * 64 + nt * 32 + r32; o[0] = P; o[256] = h; } }
        lds_barrier();
    }
}
DEV void p5_lru_out_mfma(const Args& a, int l, float* lds) {
    const int tid = ltid(), lane = tid & 63, wave = __builtin_amdgcn_readfirstlane(tid >> 6), r32 = lane & 31, hi = lane >> 5, dir = wave >> 2, blk = wave & 3;
    float* Xs = lds; float* Us = lds + 35 * 256; float* HF = Us + 32 * 256; float* HB = Xs; unsigned* UB = (unsigned*)(HF + 32 * 256);
    const float* CAR = (const float*)(a.ws + WS_LCAR); bf16_t* MIX = (bf16_t*)(a.ws + WS_MIX); const bf16_t* YG = (const bf16_t*)(a.ws + WS_Y) + 11 * YARR;
    LruW W; lru_w_init(a, l, dir, blk, r32, hi, W);
    lru_conv_init(a, l, tid, lds);
    const f32x4 ng = *(const f32x4*)(a.in[21] + l * 256 + lane * 4);
    const int c_lo = l == 0 ? 0 : 8;
    u32x2 pre[5];
    const int vb = (blockIdx.x + 192) % gridDim.x;
    if (vb < NB * (LRU_CH - c_lo)) lru_fetch(a, vb / (LRU_CH - c_lo), c_lo + vb % (LRU_CH - c_lo), tid, pre);
    for (int it = vb; it < NB * (LRU_CH - c_lo); it += gridDim.x) {
        const int b = it / (LRU_CH - c_lo), c = c_lo + it % (LRU_CH - c_lo);
        const int rowbase = c < 8 ? ML + b * 256 + c * 32 : b * 4096 + (c - 8) * 32;
        u32x2 gq[4]; float h0v[2];
#pragma unroll
        for (int q = 0; q < 4; ++q) gq[q] = *(const u32x2*)(YG + (size_t)(rowbase + (tid >> 6) * 4 + q) * 256 + lane * 4);
#pragma unroll
        for (int nt = 0; nt < 2; ++nt) h0v[nt] = CAR[((size_t)(b * LRU_CH + c) * 2 + dir) * 256 + blk * 64 + nt * 32 + r32];
        lru_load_u(pre, Xs, Us, UB);
        { const int itn = it + gridDim.x; if (itn < NB * (LRU_CH - c_lo)) lru_fetch(a, itn / (LRU_CH - c_lo), c_lo + itn % (LRU_CH - c_lo), tid, pre); }
        bf16x8_t uf[4]; lru_ufrags(UB, blk, r32, hi, uf);
        float* H = dir == 0 ? HF : HB;
#pragma unroll
        for (int nt = 0; nt < 2; ++nt) { const int ch = blk * 64 + nt * 32 + r32; float Am[4], Bm[4], st[4]; f32x16 An, Bn; lru_ab_nt(W, uf, Us, blk, r32, hi, nt, An, Bn);
            const float h0 = h0v[nt];
            if (dir == 0) { lru_segs<true>(An, Bn, Am, Bm); lru_walk<true>(Am, Bm, hi, h0, st);
#pragma unroll
                for (int s = 0; s < 4; ++s) { float h = st[s];
#pragma unroll
                    for (int i = 0; i < 4; ++i) { const int r = 4 * s + i; h = An[r] * h + Bn[r]; H[crow16(r, hi) * 256 + ch] = h; } } }
            else { lru_segs<false>(An, Bn, Am, Bm); lru_walk<false>(Am, Bm, hi, h0, st);
#pragma unroll
                for (int s = 0; s < 4; ++s) { float h = st[s];
#pragma unroll
                    for (int i = 3; i >= 0; --i) { const int r = 4 * s + i; h = An[r] * h + Bn[r]; H[crow16(r, hi) * 256 + ch] = h; } } } }
        lds_barrier();
#pragma unroll
        for (int q = 0; q < 4; ++q) {
            const int tt = (tid >> 6) * 4 + q, row = rowbase + tt;
            const float g[4] = {bf2f(gq[q].x & 0xffffu), bf2f(gq[q].x >> 16), bf2f(gq[q].y & 0xffffu), bf2f(gq[q].y >> 16)};
            const f32x4 hf = *(const f32x4*)(HF + tt * 256 + lane * 4), hb = *(const f32x4*)(HB + tt * 256 + lane * 4);
            float y[4] = {(hf.x + hb.x) * gelu_tanh(g[0]), (hf.y + hb.y) * gelu_tanh(g[1]), (hf.z + hb.z) * gelu_tanh(g[2]), (hf.w + hb.w) * gelu_tanh(g[3])};
            const float rstd = __builtin_amdgcn_rsqf(wave_sum(y[0] * y[0] + y[1] * y[1] + y[2] * y[2] + y[3] * y[3]) * (1.f / 256.f) + EPS);
            y[0] *= rstd * ng.x; y[1] *= rstd * ng.y; y[2] *= rstd * ng.z; y[3] *= rstd * ng.w;
            st4bf(MIX + (size_t)row * D + 768 + lane * 4, y);
        }
        lds_barrier();
    }
}
DEV void p4_lru_carry(const Args& a, float* lds) {
    const int tid = ltid(), j = tid & 15, part = tid >> 4;
    float* SA = lds; float* SH = lds + 272; float* SC = lds + 544;
    for (int g = blockIdx.x; g < NB * 2 * 256 / 16; g += gridDim.x) {
        const int cid = g * 16 + j, ch = cid & 255, dir = (cid >> 8) & 1, b = cid >> 9;
        const float* AGG = (const float*)(a.ws + WS_LAGG) + ((size_t)b * LRU_CH * 2 + dir) * 512 + ch;
        float* CAR = (float*)(a.ws + WS_LCAR) + ((size_t)b * LRU_CH * 2 + dir) * 256 + ch;
        float A8[8], H8[8]; int cc[8];
        if (part < 17) {
#pragma unroll
            for (int i = 0; i < 8; ++i) { const int k = part * 8 + i; cc[i] = dir == 0 ? k : (k < 8 ? 7 - k : LRU_CH - 1 - (k - 8)); A8[i] = AGG[(size_t)cc[i] * 1024]; H8[i] = AGG[(size_t)cc[i] * 1024 + 256]; }
            float Ac = 1.f, Hc = 0.f;
#pragma unroll
            for (int i = 0; i < 8; ++i) { Hc = A8[i] * Hc + H8[i]; Ac *= A8[i]; }
            SA[part * 16 + j] = Ac; SH[part * 16 + j] = Hc;
        }
        __syncthreads();
        if (tid < 16) { float carry = 0.f;
#pragma unroll
            for (int p = 0; p < 17; ++p) { SC[p * 16 + tid] = carry; carry = SA[p * 16 + tid] * carry + SH[p * 16 + tid]; } }
        __syncthreads();
        if (part < 17) { float carry = SC[part * 16 + j];
#pragma unroll
            for (int i = 0; i < 8; ++i) { CAR[(size_t)cc[i] * 512] = carry; carry = A8[i] * carry + H8[i]; } }
        __syncthreads();
    }
}

DEV void p5_lru_out(const Args& a, int l, float* lds) {
    const int tid = ltid(), ch = tid & 255, dir = tid >> 8, lane = tid & 63, wave = tid >> 6;
    float* Xs = lds; float* Us = lds + 35 * 256; float* HF = Us + 32 * 256; float* HB = Xs ; unsigned* UB = (unsigned*)(HF + 32 * 256);
    const float* CAR = (const float*)(a.ws + WS_LCAR); bf16_t* MIX = (bf16_t*)(a.ws + WS_MIX); const bf16_t* YG = (const bf16_t*)(a.ws + WS_Y) + 11 * YARR;
    LruGate G; lru_gate_init(a, l, dir, ch, G);
    const int c_lo = l == 0 ? 0 : 8;
    for (int it = blockIdx.x; it < NB * (LRU_CH - c_lo); it += gridDim.x) {
        const int b = it / (LRU_CH - c_lo), c = c_lo + it % (LRU_CH - c_lo);
        { u32x2 pre_[5]; lru_conv_init(a, l, tid, lds); lru_fetch(a, b, c, tid, pre_); lru_load_u(pre_, Xs, Us, UB); }

        float h = CAR[((size_t)(b * LRU_CH + c) * 2 + dir) * 256 + ch];

        if (dir == 0) {
#pragma unroll 4
            for (int tt = 0; tt < 32; ++tt) { float aa, bb; lru_ab(G, Us, UB, tt, ch, aa, bb); h = aa * h + bb; HF[tt * 256 + ch] = h; } }
        else {
#pragma unroll 4
            for (int tt = 31; tt >= 0; --tt) { float aa, bb; lru_ab(G, Us, UB, tt, ch, aa, bb); h = aa * h + bb; HB[tt * 256 + ch] = h; } }

        __syncthreads();
        const int rowbase = c < 8 ? ML + b * 256 + c * 32 : b * 4096 + (c - 8) * 32;

        const f32x4 ng = *(const f32x4*)(a.in[21] + l * 256 + lane * 4);

#pragma unroll
        for (int q = 0; q < 4; ++q) {
            const int tt = wave * 4 + q, row = rowbase + tt;
            float g[4]; ld4bf(YG + (size_t)row * 256 + lane * 4, g);
            const f32x4 hf = *(const f32x4*)(HF + tt * 256 + lane * 4), hb = *(const f32x4*)(HB + tt * 256 + lane * 4);
            float y[4] = {(hf.x + hb.x) * gelu_tanh(g[0]), (hf.y + hb.y) * gelu_tanh(g[1]), (hf.z + hb.z) * gelu_tanh(g[2]), (hf.w + hb.w) * gelu_tanh(g[3])};
            const float rstd = __builtin_amdgcn_rsqf(wave_sum(y[0] * y[0] + y[1] * y[1] + y[2] * y[2] + y[3] * y[3]) * (1.f / 256.f) + EPS);
            y[0] *= rstd * ng.x; y[1] *= rstd * ng.y; y[2] *= rstd * ng.z; y[3] *= rstd * ng.w;
            st4bf(MIX + (size_t)row * D + 768 + lane * 4, y);
        }
        __syncthreads();
    }
}


constexpr float LOG2E = 1.4426950408889634f;
DEV void p3_ret_prep(const Args& a, int l, unsigned char* lds) {
    const int tid = ltid(), lane = tid & 63, wave = __builtin_amdgcn_readfirstlane(tid >> 6), r32 = lane & 31, hi = lane >> 5, dir = wave >> 2, vt = (wave >> 1) & 1, dt = wave & 1;
    const bf16_t* Y = (const bf16_t*)(a.ws + WS_Y); bf16_t* RVT = (bf16_t*)(a.ws + WS_RVT); float* RS = (float*)(a.ws + WS_RETS);
    constexpr int ROWB = 272, TILE = 64 * ROWB, STG = 3 * TILE;
    bf16_t* Lk = (bf16_t*)(lds + STG); bf16_t* Lv = Lk + 128 * 72;
    u32x4 pre[4];
#define RP_FETCH(itx) do { const int c_ = (itx) % RET_CH, bh_ = (itx) / RET_CH, h_ = bh_ & 3, b_ = bh_ >> 2, row0_ = ret_row0(b_, c_); \
        _Pragma("unroll") for (int q = 0; q < 4; ++q) { const int i = tid + q * NTHREADS, arr = i >> 10, kr = (i >> 3) & 127, c8 = (i & 7) * 8; \
            pre[q] = *(const u32x4*)(Y + (size_t)(7 + arr) * YARR + (size_t)(row0_ + kr) * 256 + h_ * 64 + c8); } } while (0)
    const int vb = (blockIdx.x + 128) % gridDim.x;
    if (vb < NB * 4 * RET_CH) RP_FETCH(vb);
    for (int it = vb; it < NB * 4 * RET_CH; it += gridDim.x) {
        const int c = it % RET_CH, bh = it / RET_CH, h = bh & 3;
#pragma unroll
        for (int q = 0; q < 4; ++q) { const int i = tid + q * NTHREADS, arr = i >> 10, kr = (i >> 3) & 127, c8 = (i & 7) * 8; *(u32x4*)((arr ? Lv : Lk) + kr * 72 + c8) = pre[q]; }
        __syncthreads();
        if (it + (int)gridDim.x < NB * 4 * RET_CH) RP_FETCH(it + gridDim.x);
        { const int dd = tid >> 2, col = dd & 63; const bool isk = dd >= 64;
            const float lgf = a.in[14][l * 8 + h] * LOG2E, lgb = a.in[14][l * 8 + 4 + h] * LOG2E;
            const bf16_t* L = isk ? Lk : Lv;
#pragma unroll
            for (int gg = 0; gg < 2; ++gg) { const int g = (tid & 3) + 4 * gg; unsigned w[8], wb[8];
#pragma unroll
                for (int p2 = 0; p2 < 8; ++p2) { const int p = 2 * p2, ml = g * 16 + 8 * ((p & 7) >> 2) + 4 * (p >> 3) + (p & 3);
                    const unsigned x0 = L[ml * 72 + col], x1 = L[(ml + 1) * 72 + col];
                    if (isk) { const float f0 = bf2f(x0) * 0.125f, f1 = bf2f(x1) * 0.125f;
                        w[p2] = pk2(f0 * __builtin_amdgcn_exp2f(lgf * (float)(127 - ml)), f1 * __builtin_amdgcn_exp2f(lgf * (float)(126 - ml)));
                        wb[p2] = pk2(f0 * __builtin_amdgcn_exp2f(lgb * (float)ml), f1 * __builtin_amdgcn_exp2f(lgb * (float)(ml + 1))); }
                    else { w[p2] = x0 | (x1 << 16); wb[p2] = 0u; } }
                unsigned char* i0 = lds + (isk ? TILE : 0) + col * ROWB + g * 32;
                *(u32x4*)i0 = (u32x4){w[0], w[1], w[2], w[3]}; *(u32x4*)(i0 + 16) = (u32x4){w[4], w[5], w[6], w[7]};
                if (isk) { *(u32x4*)(i0 + TILE) = (u32x4){wb[0], wb[1], wb[2], wb[3]}; *(u32x4*)(i0 + TILE + 16) = (u32x4){wb[4], wb[5], wb[6], wb[7]}; }
                else { bf16_t* d0 = RVT + ((size_t)bh * 64 + col) * 4352 + c * 128 + g * 16; *(u32x4*)d0 = (u32x4){w[0], w[1], w[2], w[3]}; *(u32x4*)(d0 + 8) = (u32x4){w[4], w[5], w[6], w[7]}; } } }
        lds_barrier();
        f32x16 acc;
#pragma unroll
        for (int r = 0; r < 16; ++r) acc[r] = 0.f;
#pragma unroll
        for (int ks = 0; ks < 8; ++ks) {
            const bf16x8_t af = *(const bf16x8_t*)(lds + (vt * 32 + r32) * ROWB + ks * 32 + hi * 16);
            const bf16x8_t bf = *(const bf16x8_t*)(lds + (1 + dir) * TILE + (dt * 32 + r32) * ROWB + ks * 32 + hi * 16);
            acc = __builtin_amdgcn_mfma_f32_32x32x16_bf16(af, bf, acc, 0, 0, 0);
        }
        float* o = RS + ((size_t)(bh * RET_CH + c) * 2 + dir) * 4096 + dt * 32 + r32;
#pragma unroll
        for (int r = 0; r < 16; ++r) o[(vt * 32 + crow16(r, hi)) * 64] = acc[r];
        lds_barrier();
    }
}
DEV void p5_ret_out_mfma(const Args& a, int l, unsigned char* lds) {
    const int tid = ltid(), lane = tid & 63, wave = __builtin_amdgcn_readfirstlane(tid >> 6), r32 = lane & 31, hi = lane >> 5, nt = wave & 3, vt = wave >> 2;
    const bf16_t* Y = (const bf16_t*)(a.ws + WS_Y); const bf16_t* RVT = (const bf16_t*)(a.ws + WS_RVT); const float* RS = (const float*)(a.ws + WS_RETS); bf16_t* MIX = (bf16_t*)(a.ws + WS_MIX);
    constexpr int QROW = 144, QT = 128 * QROW, VROW = 272, VT_ = 64 * VROW;
    const int c_lo = l == 0 ? 0 : 2, ncs = RET_CH - c_lo;
    u32x4 pre[6];
#define RO_FETCH(itx) do { const int c_ = c_lo + (itx) % ncs, bh_ = (itx) / ncs, h_ = bh_ & 3, b_ = bh_ >> 2, row0_ = ret_row0(b_, c_); \
        _Pragma("unroll") for (int q = 0; q < 4; ++q) { const int i = tid + q * NTHREADS, arr = i >> 10, row = (i >> 3) & 127, c16 = i & 7; \
            pre[q] = *(const u32x4*)(Y + (size_t)(6 + arr) * YARR + (size_t)(row0_ + row) * 256 + h_ * 64 + c16 * 8); } \
        _Pragma("unroll") for (int q = 0; q < 2; ++q) { const int i = tid + q * NTHREADS, row = i >> 4, c16 = i & 15; \
            pre[4 + q] = *(const u32x4*)(RVT + ((size_t)bh_ * 64 + row) * 4352 + c_ * 128 + c16 * 8); } } while (0)
    if ((int)blockIdx.x < NB * 4 * ncs) RO_FETCH(blockIdx.x);
    for (int it = blockIdx.x; it < NB * 4 * ncs; it += gridDim.x) {
        const int c = c_lo + it % ncs, bh = it / ncs, h = bh & 3, b = bh >> 2, row0 = ret_row0(b, c);
#pragma unroll
        for (int q = 0; q < 4; ++q) { const int i = tid + q * NTHREADS, arr = i >> 10, row = (i >> 3) & 127, c16 = i & 7; *(u32x4*)(lds + arr * QT + row * QROW + c16 * 16) = pre[q]; }
#pragma unroll
        for (int q = 0; q < 2; ++q) { const int i = tid + q * NTHREADS, row = i >> 4, c16 = i & 15; *(u32x4*)(lds + 2 * QT + row * VROW + c16 * 16) = pre[4 + q]; }
        bf16x8_t sfr[4], sbr[4]; u32x4 gq[2];
        { const bf16_t* Sf = (const bf16_t*)(a.ws + WS_XN) + ((size_t)(bh * RET_CH + c) * 2) * 4096 + (vt * 32 + r32) * 64 + hi * 8;
#pragma unroll
            for (int ks = 0; ks < 4; ++ks) { sfr[ks] = *(const bf16x8_t*)(Sf + ks * 16); sbr[ks] = *(const bf16x8_t*)(Sf + 4096 + ks * 16); }
            const bf16_t* gp = Y + 9 * YARR + (size_t)(row0 + (tid >> 2)) * 256 + h * 64 + (tid & 3) * 16; gq[0] = *(const u32x4*)gp; gq[1] = *(const u32x4*)(gp + 8); }
        __syncthreads();
        if (it + (int)gridDim.x < NB * 4 * ncs) RO_FETCH(it + gridDim.x);
        const float lgf = a.in[14][l * 8 + h] * LOG2E, lgb = a.in[14][l * 8 + 4 + h] * LOG2E;
        bf16x8_t qf[4];
#pragma unroll
        for (int ks = 0; ks < 4; ++ks) qf[ks] = *(const bf16x8_t*)(lds + (nt * 32 + r32) * QROW + ks * 32 + hi * 16);
        f32x16 o;
#pragma unroll
        for (int r = 0; r < 16; ++r) o[r] = 0.f;
        const int n_l = nt * 32 + r32;
#pragma unroll 1
        for (int mt = 0; mt < 4; ++mt) {
            f32x16 x;
#pragma unroll
            for (int r = 0; r < 16; ++r) x[r] = 0.f;
#pragma unroll
            for (int ks = 0; ks < 4; ++ks) { const bf16x8_t kf = *(const bf16x8_t*)(lds + QT + (mt * 32 + r32) * QROW + ks * 32 + hi * 16); x = __builtin_amdgcn_mfma_f32_32x32x16_bf16(kf, qf[ks], x, 0, 0, 0); }
#pragma unroll
            for (int r = 0; r < 16; ++r) { const int m = mt * 32 + crow16(r, hi), df = n_l - m;
                x[r] *= 0.125f * __builtin_amdgcn_exp2f(df >= 0 ? lgf * (float)df : lgb * (float)(-df)); }
#pragma unroll
            for (int sp = 0; sp < 2; ++sp) { u32x4 w; w.x = pk2(x[8 * sp], x[8 * sp + 1]); w.y = pk2(x[8 * sp + 2], x[8 * sp + 3]); w.z = pk2(x[8 * sp + 4], x[8 * sp + 5]); w.w = pk2(x[8 * sp + 6], x[8 * sp + 7]);
                const bf16x8_t vf = *(const bf16x8_t*)(lds + 2 * QT + (vt * 32 + r32) * VROW + (mt * 2 + sp) * 32 + hi * 16);
                o = __builtin_amdgcn_mfma_f32_32x32x16_bf16(__builtin_bit_cast(bf16x8_t, w), vf, o, 0, 0, 0); }
        }
        f32x16 of, ob;
#pragma unroll
        for (int r = 0; r < 16; ++r) { of[r] = 0.f; ob[r] = 0.f; }
#pragma unroll
        for (int ks = 0; ks < 4; ++ks) {
            of = __builtin_amdgcn_mfma_f32_32x32x16_bf16(qf[ks], sfr[ks], of, 0, 0, 0);
            ob = __builtin_amdgcn_mfma_f32_32x32x16_bf16(qf[ks], sbr[ks], ob, 0, 0, 0);
        }
        __syncthreads();
        float* OT = (float*)lds;
#pragma unroll
        for (int r = 0; r < 16; ++r) { const int n = nt * 32 + crow16(r, hi);
            OT[n * 64 + vt * 32 + r32] = o[r] + __builtin_amdgcn_exp2f(lgf * (float)(n + 1)) * of[r] + __builtin_amdgcn_exp2f(lgb * (float)(128 - n)) * ob[r]; }
        __syncthreads();
        { const int n = tid >> 2, v0 = (tid & 3) * 16; float ov[16]; float ss = 0.f;
#pragma unroll
            for (int j4 = 0; j4 < 4; ++j4) { const f32x4 x = *(const f32x4*)(OT + n * 64 + v0 + j4 * 4); ov[j4 * 4] = x.x; ov[j4 * 4 + 1] = x.y; ov[j4 * 4 + 2] = x.z; ov[j4 * 4 + 3] = x.w; ss += (x.x * x.x + x.y * x.y) + (x.z * x.z + x.w * x.w); }
            ss = row_sum4(ss);
            const float rstd = __builtin_amdgcn_rsqf(ss * (1.f / 64.f) + EPS);
            const size_t row = (size_t)(row0 + n); const float* ng = a.in[15] + l * 64 + v0;
            bf16_t* mp = MIX + row * D + 512 + h * 64 + v0;
#pragma unroll
            for (int j4 = 0; j4 < 4; ++j4) { const unsigned g0 = gq[j4 >> 1][(j4 & 1) * 2], g1 = gq[j4 >> 1][(j4 & 1) * 2 + 1]; const float g[4] = {bf2f(g0 & 0xffffu), bf2f(g0 >> 16), bf2f(g1 & 0xffffu), bf2f(g1 >> 16)}; float y[4];
#pragma unroll
                for (int j = 0; j < 4; ++j) y[j] = ov[j4 * 4 + j] * rstd * ng[j4 * 4 + j] * fsiluf(g[j]);
                st4bf(mp + j4 * 4, y); } }
        __syncthreads();
    }
}
DEV void p5_ret_out_dma(const Args& a, int l, unsigned char* lds_) {
    typedef __attribute__((address_space(3))) unsigned char* lptr;
    lptr lds = (lptr)lds_;
    const int tid = ltid(), lane = tid & 63, wave = __builtin_amdgcn_readfirstlane(tid >> 6), r32 = lane & 31, hi = lane >> 5, nt = wave & 3, vt = wave >> 2;
    const bf16_t* Y = (const bf16_t*)(a.ws + WS_Y); const bf16_t* RVT = (const bf16_t*)(a.ws + WS_RVT); bf16_t* MIX = (bf16_t*)(a.ws + WS_MIX);
    constexpr int RB = 65536, KOFF = 16384, VOFF = 32768, GOFF = 49152;
    const int c_lo = l == 0 ? 0 : 2, ncs = RET_CH - c_lo, nitems = NB * 4 * ncs;
#define RD_ISSUE(itx, bufb) do { const int c_ = c_lo + (itx) % ncs, bh_ = (itx) / ncs, h_ = bh_ & 3, b_ = bh_ >> 2, row0_ = ret_row0(b_, c_); \
        _Pragma("unroll") for (int i_ = 0; i_ < 2; ++i_) { const int P_ = (wave * 2 + i_) * 64 + lane; \
            { const int row_ = P_ >> 3, cs_ = (P_ & 7) ^ ((row_ >> 1) & 7); const bf16_t* src_ = Y + (size_t)6 * YARR + (size_t)(row0_ + row_) * 256 + h_ * 64 + cs_ * 8; \
              __builtin_amdgcn_global_load_lds((const unsigned*)src_, (__attribute__((address_space(3))) unsigned*)(lds + (bufb) + (wave * 2 + i_) * 1024), 16, 0, 0); \
              __builtin_amdgcn_global_load_lds((const unsigned*)(src_ + YARR), (__attribute__((address_space(3))) unsigned*)(lds + (bufb) + KOFF + (wave * 2 + i_) * 1024), 16, 0, 0); \
              __builtin_amdgcn_global_load_lds((const unsigned*)(Y + (size_t)9 * YARR + (size_t)(row0_ + row_) * 256 + h_ * 64 + (P_ & 7) * 8), (__attribute__((address_space(3))) unsigned*)(lds + (bufb) + GOFF + (wave * 2 + i_) * 1024), 16, 0, 0); } \
            { const int row_ = P_ >> 4, cs_ = (P_ & 15) ^ (row_ & 15); const bf16_t* src_ = RVT + ((size_t)bh_ * 64 + row_) * 4352 + c_ * 128 + cs_ * 8; \
              __builtin_amdgcn_global_load_lds((const unsigned*)src_, (__attribute__((address_space(3))) unsigned*)(lds + (bufb) + VOFF + (wave * 2 + i_) * 1024), 16, 0, 0); } } } while (0)
    __attribute__((address_space(3))) float* NG = (__attribute__((address_space(3))) float*)(lds + 2 * RB);
    if (tid < 64) NG[tid] = a.in[15][l * 64 + tid];
    bf16x8_t sfr[4], sbr[4];
#define RD_STATE(itx) do { const int c_ = c_lo + (itx) % ncs, bh_ = (itx) / ncs, h_ = bh_ & 3, b_ = bh_ >> 2, row0_ = ret_row0(b_, c_); \
        const bf16_t* Sf_ = (const bf16_t*)(a.ws + WS_XN) + ((size_t)(bh_ * RET_CH + c_) * 2) * 4096 + (vt * 32 + r32) * 64 + hi * 8; \
        _Pragma("unroll") for (int ks = 0; ks < 4; ++ks) { sfr[ks] = *(const bf16x8_t*)(Sf_ + ks * 16); sbr[ks] = *(const bf16x8_t*)(Sf_ + 4096 + ks * 16); } \
        } while (0)
    int it = blockIdx.x, par = 0;
    if (it < nitems) { RD_STATE(it); RD_ISSUE(it, 0); }
    for (; it < nitems; it += gridDim.x, par ^= 1) {
        const int buf = par * RB;
        const int c = c_lo + it % ncs, bh = it / ncs, h = bh & 3, b = bh >> 2, row0 = ret_row0(b, c);
        const float lgf = a.in[14][l * 8 + h] * LOG2E, lgb = a.in[14][l * 8 + 4 + h] * LOG2E;
        __builtin_amdgcn_s_waitcnt(0x0F70);
        __syncthreads();
        typedef const __attribute__((address_space(3))) bf16x8_t* fptr;
        bf16x8_t qf[4];
        { const int R = nt * 32 + r32, sw = (R >> 1) & 7;
#pragma unroll
            for (int ks = 0; ks < 4; ++ks) qf[ks] = *(fptr)(lds + buf + R * 128 + (((ks * 2 + hi) ^ sw) * 16)); }
        f32x16 of, ob;
#pragma unroll
        for (int r = 0; r < 16; ++r) { of[r] = 0.f; ob[r] = 0.f; }
#pragma unroll
        for (int ks = 0; ks < 4; ++ks) {
            of = __builtin_amdgcn_mfma_f32_32x32x16_bf16(qf[ks], sfr[ks], of, 0, 0, 0);
            ob = __builtin_amdgcn_mfma_f32_32x32x16_bf16(qf[ks], sbr[ks], ob, 0, 0, 0);
        }
        asm volatile("" : "+v"(of), "+v"(ob));
        __builtin_amdgcn_sched_barrier(0);
        { const int itn = it + (int)gridDim.x < nitems ? it + (int)gridDim.x : it;
          RD_STATE(itn); RD_ISSUE(itn, RB - buf); }
        __builtin_amdgcn_sched_barrier(0);
        f32x16 o;
#pragma unroll
        for (int r = 0; r < 16; ++r) o[r] = 0.f;
        const int n_l = nt * 32 + r32;
        const int Rv = vt * 32 + r32, swv = Rv & 15;
#pragma unroll 1
        for (int mt = 0; mt < 4; ++mt) {
            f32x16 x;
#pragma unroll
            for (int r = 0; r < 16; ++r) x[r] = 0.f;
            const int Rk = mt * 32 + r32, swk = (Rk >> 1) & 7;
#pragma unroll
            for (int ks = 0; ks < 4; ++ks) { const bf16x8_t kf = *(fptr)(lds + buf + KOFF + Rk * 128 + (((ks * 2 + hi) ^ swk) * 16)); x = __builtin_amdgcn_mfma_f32_32x32x16_bf16(kf, qf[ks], x, 0, 0, 0); }
#pragma unroll
            for (int r = 0; r < 16; ++r) { const int m = mt * 32 + crow16(r, hi), df = n_l - m;
                x[r] *= 0.125f * __builtin_amdgcn_exp2f(df >= 0 ? lgf * (float)df : lgb * (float)(-df)); }
#pragma unroll
            for (int sp = 0; sp < 2; ++sp) { u32x4 w; w.x = pk2(x[8 * sp], x[8 * sp + 1]); w.y = pk2(x[8 * sp + 2], x[8 * sp + 3]); w.z = pk2(x[8 * sp + 4], x[8 * sp + 5]); w.w = pk2(x[8 * sp + 6], x[8 * sp + 7]);
                const bf16x8_t vf = *(fptr)(lds + buf + VOFF + Rv * 256 + ((((mt * 2 + sp) * 2 + hi) ^ swv) * 16));
                o = __builtin_amdgcn_mfma_f32_32x32x16_bf16(__builtin_bit_cast(bf16x8_t, w), vf, o, 0, 0, 0); }
        }
        asm volatile("s_waitcnt lgkmcnt(0)\n\ts_barrier" ::: "memory");
        __attribute__((address_space(3))) float* OT = (__attribute__((address_space(3))) float*)(lds + buf);
#pragma unroll
        for (int r = 0; r < 16; ++r) { const int n = nt * 32 + crow16(r, hi);
            OT[n * 64 + vt * 32 + r32] = o[r] + __builtin_amdgcn_exp2f(lgf * (float)(n + 1)) * of[r] + __builtin_amdgcn_exp2f(lgb * (float)(128 - n)) * ob[r]; }
        asm volatile("s_waitcnt lgkmcnt(0)\n\ts_barrier" ::: "memory");
        { const int n = tid >> 2, v0 = (tid & 3) * 16; float ov[16]; float ss = 0.f;
#pragma unroll
            for (int j4 = 0; j4 < 4; ++j4) { const f32x4 x = *(const __attribute__((address_space(3))) f32x4*)(OT + n * 64 + v0 + j4 * 4); ov[j4 * 4] = x.x; ov[j4 * 4 + 1] = x.y; ov[j4 * 4 + 2] = x.z; ov[j4 * 4 + 3] = x.w; ss += (x.x * x.x + x.y * x.y) + (x.z * x.z + x.w * x.w); }
            ss = row_sum4(ss);
            const float rstd = __builtin_amdgcn_rsqf(ss * (1.f / 64.f) + EPS);
            const size_t row = (size_t)(row0 + n); const __attribute__((address_space(3))) float* ng = NG + v0;
            bf16_t* mp = MIX + row * D + 512 + h * 64 + v0;
            const u32x4 gq0 = *(const __attribute__((address_space(3))) u32x4*)(lds + buf + GOFF + n * 128 + v0 * 2), gq1 = *(const __attribute__((address_space(3))) u32x4*)(lds + buf + GOFF + n * 128 + v0 * 2 + 16);
#pragma unroll
            for (int j4 = 0; j4 < 4; ++j4) { const unsigned g0 = (j4 < 2 ? gq0 : gq1)[(j4 & 1) * 2], g1 = (j4 < 2 ? gq0 : gq1)[(j4 & 1) * 2 + 1]; const float g[4] = {bf2f(g0 & 0xffffu), bf2f(g0 >> 16), bf2f(g1 & 0xffffu), bf2f(g1 >> 16)}; float y[4];
#pragma unroll
                for (int j = 0; j < 4; ++j) y[j] = ov[j4 * 4 + j] * rstd * ng[j4 * 4 + j] * fsiluf(g[j]);
                st4bf(mp + j4 * 4, y); } }
    }
    asm volatile("s_waitcnt vmcnt(0)" ::: "memory");
    __syncthreads();
#undef RD_ISSUE
#undef RD_STATE
}
DEV void p4_ret_scan(const Args& a, int l) {
    const float* RS = (const float*)(a.ws + WS_RETS); bf16_t* RSB = (bf16_t*)(a.ws + WS_XN);
    for (int it = blockIdx.x; it < 512; it += gridDim.x) {
        const int gid = it * NTHREADS + ltid(), elem = gid & 4095, dir = (gid >> 12) & 1, bh = gid >> 13, h = bh & 3;
        const float gC = expf(a.in[14][l * 8 + dir * 4 + h] * 128.f);
        const float* p = RS + ((size_t)bh * RET_CH * 2 + dir) * 4096 + elem;
        bf16_t* q = RSB + ((size_t)bh * RET_CH * 2 + dir) * 4096 + elem;
        float u[RET_CH];
#pragma unroll
        for (int c = 0; c < RET_CH; ++c) u[c] = p[(size_t)c * 8192];
        float st = 0.f;
        if (dir == 0) {
#pragma unroll
            for (int c = 0; c < RET_CH; ++c) { q[(size_t)c * 8192] = (bf16_t)f2bf(st); st = gC * st + u[c]; } }
        else {
#pragma unroll
            for (int c = 1; c >= 0; --c) { q[(size_t)c * 8192] = (bf16_t)f2bf(st); st = gC * st + u[c]; }
#pragma unroll
            for (int c = RET_CH - 1; c >= 2; --c) { q[(size_t)c * 8192] = (bf16_t)f2bf(st); st = gC * st + u[c]; }
        }
    }
}
DEV void p5_ret_out(const Args& a, int l, float* lds) {
    const int tid = ltid();
    bf16_t* Qs = (bf16_t*)lds; bf16_t* Ks = Qs + 128 * 64; bf16_t* Vs = Ks + 128 * 64; float* S = lds + (3 * 128 * 64) / 2;
    const bf16_t* Y = (const bf16_t*)(a.ws + WS_Y); const float* RS = (const float*)(a.ws + WS_RETS); bf16_t* MIX = (bf16_t*)(a.ws + WS_MIX);
    const int c_lo = l == 0 ? 0 : 2, ncs = RET_CH - c_lo;
    for (int it = blockIdx.x; it < NB * 4 * ncs; it += gridDim.x) {
        const int c = c_lo + it % ncs, bh = it / ncs, h = bh & 3, b = bh >> 2, row0 = ret_row0(b, c);
        for (int i = tid; i < 128 * 16; i += NTHREADS) { const int m = i >> 4, q4 = (i & 15) * 4; const size_t go = (size_t)(row0 + m) * 256 + h * 64 + q4;
            *(u32x2*)(Qs + m * 64 + q4) = *(const u32x2*)(Y + 6 * YARR + go); *(u32x2*)(Ks + m * 64 + q4) = *(const u32x2*)(Y + 7 * YARR + go); *(u32x2*)(Vs + m * 64 + q4) = *(const u32x2*)(Y + 8 * YARR + go); }
        __syncthreads();
        const float lgf = a.in[14][l * 8 + h], lgb = a.in[14][l * 8 + 4 + h];
        { const int n0 = (tid >> 4) * 4, m0 = (tid & 15) * 8; float s[4][8];
#pragma unroll
            for (int i = 0; i < 4; ++i)
#pragma unroll
                for (int j = 0; j < 8; ++j) s[i][j] = 0.f;
            for (int d = 0; d < 64; ++d) { float q[4], k[8];
#pragma unroll
                for (int i = 0; i < 4; ++i) q[i] = bf2f(Qs[(n0 + i) * 64 + d]);
#pragma unroll
                for (int j = 0; j < 8; ++j) k[j] = bf2f(Ks[(m0 + j) * 64 + d]);
#pragma unroll
                for (int i = 0; i < 4; ++i)
#pragma unroll
                    for (int j = 0; j < 8; ++j) s[i][j] += q[i] * k[j]; }
#pragma unroll
            for (int i = 0; i < 4; ++i)
#pragma unroll
                for (int j = 0; j < 8; ++j) { const int n = n0 + i, m = m0 + j; const float dec = n >= m ? expf(lgf * (float)(n - m)) : expf(lgb * (float)(m - n)); S[n * 129 + m] = s[i][j] * 0.125f * dec; } }
        __syncthreads();
        { const int n = tid >> 2, v0 = (tid & 3) * 16; float o[16];
#pragma unroll
            for (int j = 0; j < 16; ++j) o[j] = 0.f;
            for (int m = 0; m < 128; ++m) { const float sv = S[n * 129 + m];
#pragma unroll
                for (int j = 0; j < 16; ++j) o[j] += sv * bf2f(Vs[m * 64 + v0 + j]); }
            const float cf = expf(lgf * (float)(n + 1)), cb = expf(lgb * (float)(128 - n));
            const float* Sf = RS + ((size_t)(bh * RET_CH + c) * 2) * 4096 + v0; const float* Sb = Sf + 4096;
            for (int d = 0; d < 64; ++d) { const float qv = bf2f(Qs[n * 64 + d]), qf = qv * cf, qb = qv * cb;
#pragma unroll
                for (int j4 = 0; j4 < 4; ++j4) { const f32x4 x = *(const f32x4*)(Sf + d * 64 + j4 * 4), y = *(const f32x4*)(Sb + d * 64 + j4 * 4);
                    o[j4 * 4] += qf * x.x + qb * y.x; o[j4 * 4 + 1] += qf * x.y + qb * y.y; o[j4 * 4 + 2] += qf * x.z + qb * y.z; o[j4 * 4 + 3] += qf * x.w + qb * y.w; } }
            float ss = 0.f;
#pragma unroll
            for (int j = 0; j < 16; ++j) ss += o[j] * o[j];
            ss = row_sum4(ss);
            const float rstd = 1.0f / sqrtf(ss * (1.f / 64.f) + EPS);
            const int row = row0 + n; const bf16_t* gp = Y + 9 * YARR + (size_t)row * 256 + h * 64 + v0; const float* ng = a.in[15] + l * 64 + v0;
            bf16_t* mp = MIX + (size_t)row * D + 512 + h * 64 + v0;
#pragma unroll
            for (int j4 = 0; j4 < 4; ++j4) { float g[4]; ld4bf(gp + j4 * 4, g); float y[4];
#pragma unroll
                for (int j = 0; j < 4; ++j) y[j] = o[j4 * 4 + j] * rstd * ng[j4 * 4 + j] * siluf(g[j]);
                st4bf(mp + j4 * 4, y); } }
        __syncthreads();
    }
}

DEV float att_lambda(const Args& a, int l) {
    const float* lp = a.in[12] + l * 256; float s1 = 0.f, s2 = 0.f;
    for (int i = 0; i < 64; ++i) { s1 += lp[i] * lp[64 + i]; s2 += lp[128 + i] * lp[192 + i]; }
    return expf(s1) - expf(s2) + lam_init(l);
}
DEV float att_bound2(const Args& a, int l) {
    float mq = 0.f, mk = 0.f;
    for (int i = 0; i < 64; ++i) { mq = fmaxf(mq, fabsf(a.in[10][l * 64 + i])); mk = fmaxf(mk, fabsf(a.in[11][l * 64 + i])); }
    return 8.f * 1.4426950408889634f * mq * mk * 1.01f;
}

DEV void attn_simple_item(const Args& a, int l, int b, int h, int qblk, bool ctx, float lam, float bound2, float* lds) {
    const int tid = ltid(), q = tid & 63, part = tid >> 6, map = part >> 2, vq = part & 3;
    float* Ks = lds; float* Vs = lds + 64 * 128; float* red = lds + 2 * 64 * 128;
    const bf16_t* Y = (const bf16_t*)(a.ws + WS_Y); bf16_t* MIX = (bf16_t*)(a.ws + WS_MIX);
    const int qrow = (ctx ? ML + b * 256 : b * 4096) + qblk * 64 + q;
    const int arrh = h >> 1, colh = (h & 1) * 128;
    float qv[64];
    { const bf16_t* qp = Y + (size_t)arrh * YARR + (size_t)qrow * 256 + colh + map * 64;
#pragma unroll
        for (int d4 = 0; d4 < 16; ++d4) ld4bf(qp + d4 * 4, qv + d4 * 4); }
    float o[32], lsum = 0.f;
#pragma unroll
    for (int j = 0; j < 32; ++j) o[j] = 0.f;
    const int ntiles = ctx ? 4 : 68;
    for (int tj = 0; tj < ntiles; ++tj) {
        const int krow0 = tj < 4 ? ML + b * 256 + tj * 64 : b * 4096 + (tj - 4) * 64;
        for (int i = tid; i < 64 * 32; i += NTHREADS) { const int kr = i >> 5, c4 = (i & 31) * 4; const size_t go = (size_t)(krow0 + kr) * 256 + colh + c4;
            ld4bf(Y + (size_t)(2 + arrh) * YARR + go, Ks + kr * 128 + c4); ld4bf(Y + (size_t)(4 + arrh) * YARR + go, Vs + kr * 128 + c4); }
        __syncthreads();
        for (int kr = 0; kr < 64; ++kr) {
            const float* kp = Ks + kr * 128 + map * 64; float s = 0.f;
#pragma unroll
            for (int d4 = 0; d4 < 16; ++d4) { const f32x4 kk = *(const f32x4*)(kp + d4 * 4); s += qv[d4 * 4] * kk.x + qv[d4 * 4 + 1] * kk.y + qv[d4 * 4 + 2] * kk.z + qv[d4 * 4 + 3] * kk.w; }
            const float p = exp2f(s - bound2); lsum += p;
            const float* vp = Vs + kr * 128 + vq * 32;
#pragma unroll
            for (int j4 = 0; j4 < 8; ++j4) { const f32x4 vv = *(const f32x4*)(vp + j4 * 4); o[j4 * 4] += p * vv.x; o[j4 * 4 + 1] += p * vv.y; o[j4 * 4 + 2] += p * vv.z; o[j4 * 4 + 3] += p * vv.w; }
        }
        __syncthreads();
    }
    float* Ob = Ks;
    const float il = 1.f / lsum;
    if (map == 0) {
#pragma unroll
        for (int j = 0; j < 32; ++j) Ob[q * 128 + vq * 32 + j] = o[j] * il; }
    __syncthreads();
    if (map == 1) {
#pragma unroll
        for (int j = 0; j < 32; ++j) Ob[q * 128 + vq * 32 + j] -= lam * o[j] * il; }
    __syncthreads();
    float ss = 0.f;
#pragma unroll
    for (int j = 0; j < 16; ++j) { const float x = Ob[q * 128 + part * 16 + j]; ss += x * x; }
    red[q * 8 + part] = ss;
    __syncthreads();
    float tot = 0.f;
#pragma unroll
    for (int p8 = 0; p8 < 8; ++p8) tot += red[q * 8 + p8];
    const float rstd = 1.0f / sqrtf(tot * (1.f / 128.f) + EPS), sc = rstd * (1.f - lam_init(l));
    const float* sg = a.in[13] + l * 128 + part * 16; bf16_t* mp = MIX + (size_t)qrow * D + h * 128 + part * 16;
#pragma unroll
    for (int j4 = 0; j4 < 4; ++j4) { float y[4];
#pragma unroll
        for (int j = 0; j < 4; ++j) y[j] = Ob[q * 128 + part * 16 + j4 * 4 + j] * sc * sg[j4 * 4 + j];
        st4bf(mp + j4 * 4, y); }
    __syncthreads();
}

constexpr int ATT_KROW = 128, ATT_KMAP = 64 * ATT_KROW, ATT_VOFF = 2 * ATT_KMAP, ATT_BUF = ATT_VOFF + 128 * ATT_KROW;
constexpr int ATT_EX = 0, ATT_LW = 2 * ATT_BUF, ATT_STG = ATT_LW + 1024, ATT_STGROW = 272;
DEV void p3_vt(const Args& a, float* ldsf) {
    const int tid = ltid();
    bf16_t* Ls = (bf16_t*)ldsf;
    const bf16_t* Y = (const bf16_t*)(a.ws + WS_Y); bf16_t* VT = (bf16_t*)(a.ws + WS_VT);
    u32x4 pre[2];
#define VT_FETCH(itx) do { const int t_ = (itx) % 68, bh_ = (itx) / 68, h_ = bh_ & 3, b_ = bh_ >> 2, kr0_ = t_ < 4 ? ML + b_ * 256 + t_ * 64 : b_ * 4096 + (t_ - 4) * 64; \
        _Pragma("unroll") for (int q = 0; q < 2; ++q) { const int i = tid + q * NTHREADS, kr = i >> 4, c8 = (i & 15) * 8; \
            pre[q] = *(const u32x4*)(Y + (size_t)(4 + (h_ >> 1)) * YARR + (size_t)(kr0_ + kr) * 256 + (h_ & 1) * 128 + c8); } } while (0)
    if ((int)blockIdx.x < NB * 4 * 68) VT_FETCH(blockIdx.x);
    for (int it = blockIdx.x; it < NB * 4 * 68; it += gridDim.x) {
        const int t = it % 68, bh = it / 68;
#pragma unroll
        for (int q = 0; q < 2; ++q) { const int i = tid + q * NTHREADS, kr = i >> 4, c8 = (i & 15) * 8; *(u32x4*)(Ls + kr * 136 + c8) = pre[q]; }
        __syncthreads();
        if (it + (int)gridDim.x < NB * 4 * 68) VT_FETCH(it + gridDim.x);
        { const int d = tid >> 2, g = tid & 3; unsigned w[8];
#pragma unroll
            for (int p2 = 0; p2 < 8; ++p2) { const int p = 2 * p2, kv0 = 8 * ((p & 7) >> 2) + 4 * (p >> 3) + (p & 3);
                w[p2] = (unsigned)Ls[(g * 16 + kv0) * 136 + d] | ((unsigned)Ls[(g * 16 + kv0 + 1) * 136 + d] << 16); }
            bf16_t* dst = VT + ((size_t)bh * 128 + d) * 4352 + t * 64 + g * 16;
            *(u32x4*)dst = (u32x4){w[0], w[1], w[2], w[3]}; *(u32x4*)(dst + 8) = (u32x4){w[4], w[5], w[6], w[7]}; }
        __syncthreads();
    }
#undef VT_FETCH
}
DEV void attn_unit(const Args& a, int l, int b, int h, int qb, bool ctx, float lam, float bound2, unsigned char* lds) {
    const int tid = ltid(), lane = tid & 63, wave = __builtin_amdgcn_readfirstlane(tid >> 6), r32 = lane & 31, hi = lane >> 5, qg = wave & 3, map = wave >> 2;
    const bf16_t* Y = (const bf16_t*)(a.ws + WS_Y); const bf16_t* VT = (const bf16_t*)(a.ws + WS_VT); bf16_t* MIX = (bf16_t*)(a.ws + WS_MIX);
    const int NT = ctx ? 4 : 68;
    const int qrow0 = (ctx ? ML + b * 256 : b * 4096) + qb * 128 + qg * 32;
    bf16x8_t qf[4];
    { const bf16_t* qp = Y + (size_t)(h >> 1) * YARR + (size_t)(qrow0 + r32) * 256 + (h & 1) * 128 + map * 64 + 8 * hi;
#pragma unroll
        for (int s = 0; s < 4; ++s) qf[s] = *(const bf16x8_t*)(qp + 16 * s); }
    const bf16_t* Kg = Y + (size_t)(2 + (h >> 1)) * YARR + (h & 1) * 128;
    const bf16_t* Vg = VT + (size_t)(b * 4 + h) * 128 * 4352;
    typedef __attribute__((address_space(3))) unsigned char* lptr;
    lptr ldsl = (lptr)lds;
    int dgo[4];
#pragma unroll
    for (int i = 0; i < 4; ++i) { const int P = (wave * 4 + i) * 64 + lane;
        if (wave < 4) { const int m = P >> 9, row = (P >> 3) & 63, c = (P & 7) ^ ((row >> 1) & 7); dgo[i] = row * 256 + m * 64 + c * 8; }
        else { const int P2 = P - 1024, d = P2 >> 3, c = (P2 & 7) ^ ((d >> 1) & 7); dgo[i] = d * 4352 + c * 8; } }
#define ATT_DMA(t, bufb) do { const int t_ = (t); const bf16_t* src_ = wave < 4 ? Kg + (size_t)(t_ < 4 ? ML + b * 256 + t_ * 64 : b * 4096 + (t_ - 4) * 64) * 256 : Vg + t_ * 64; \
        _Pragma("unroll") for (int i = 0; i < 4; ++i) __builtin_amdgcn_global_load_lds((const unsigned*)(src_ + dgo[i]), (__attribute__((address_space(3))) unsigned*)(ldsl + (bufb) + (wave * 4 + i) * 1024), 16, 0, 0); } while (0)
    f32x16 o[4];
#pragma unroll
    for (int dt = 0; dt < 4; ++dt)
#pragma unroll
        for (int r = 0; r < 16; ++r) o[dt][r] = 0.f;
    float lsum = 0.f;
    ATT_DMA(0, 0);
    __builtin_amdgcn_s_waitcnt(0x0F70);
    __syncthreads();
    const int sw = (r32 >> 1) & 7;
    int coff[4];
#pragma unroll
    for (int ks = 0; ks < 4; ++ks) coff[ks] = ((2 * ks + hi) ^ sw) * 16;
    const int kfo = map * ATT_KMAP + r32 * ATT_KROW, vfo = ATT_VOFF + r32 * ATT_KROW;
    typedef const __attribute__((address_space(3))) bf16x8_t* fptr;
    for (int t = 0; t < NT; ++t) {
        const int buf = (t & 1) * ATT_BUF;
        if (t + 1 < NT) ATT_DMA(t + 1, ATT_BUF - buf);
        bf16x8_t pf[4];
#pragma unroll
        for (int kt = 0; kt < 2; ++kt) {
            f32x16 s;
#pragma unroll
            for (int r = 0; r < 16; ++r) s[r] = -bound2;
#pragma unroll
            for (int ks = 0; ks < 4; ++ks) { const bf16x8_t kf = *(fptr)(ldsl + buf + kfo + kt * 32 * ATT_KROW + coff[ks]); s = __builtin_amdgcn_mfma_f32_32x32x16_bf16(kf, qf[ks], s, 0, 0, 0); }
#pragma unroll
            for (int r = 0; r < 16; ++r) { s[r] = __builtin_amdgcn_exp2f(s[r]); lsum += s[r]; }
#pragma unroll
            for (int sp = 0; sp < 2; ++sp) { u32x4 w; w.x = pk2(s[8 * sp], s[8 * sp + 1]); w.y = pk2(s[8 * sp + 2], s[8 * sp + 3]); w.z = pk2(s[8 * sp + 4], s[8 * sp + 5]); w.w = pk2(s[8 * sp + 6], s[8 * sp + 7]);
                pf[2 * kt + sp] = __builtin_bit_cast(bf16x8_t, w); }
        }
#pragma unroll
        for (int dt = 0; dt < 4; ++dt)
#pragma unroll
            for (int g = 0; g < 4; ++g) { const bf16x8_t vf = *(fptr)(ldsl + buf + vfo + dt * 32 * ATT_KROW + coff[g]); o[dt] = __builtin_amdgcn_mfma_f32_32x32x16_bf16(pf[g], vf, o[dt], 0, 0, 0); }
        __builtin_amdgcn_s_waitcnt(0x0F70);
        __syncthreads();
    }
#undef ATT_DMA
    lsum = swap32_sum(lsum, lsum);
    float* LW = (float*)(lds + ATT_LW) + wave * 32;
    if (hi == 0) LW[r32] = lsum;
    float* EX = (float*)(lds + ATT_EX);
    asm volatile("s_waitcnt lgkmcnt(0)" ::: "memory");
    float il[16];
#pragma unroll
    for (int r = 0; r < 16; ++r) il[r] = 1.f / LW[crow16(r, hi)];
    if (map == 1) {
#pragma unroll
        for (int dt = 0; dt < 4; ++dt)
#pragma unroll
            for (int r = 0; r < 16; ++r) EX[(qg * 32 + crow16(r, hi)) * 128 + dt * 32 + r32] = o[dt][r] * il[r] * lam;
    }
    __syncthreads();
    if (map == 0) {
        float ss[16];
#pragma unroll
        for (int r = 0; r < 16; ++r) ss[r] = 0.f;
#pragma unroll
        for (int dt = 0; dt < 4; ++dt)
#pragma unroll
            for (int r = 0; r < 16; ++r) { const float v = o[dt][r] * il[r] - EX[(qg * 32 + crow16(r, hi)) * 128 + dt * 32 + r32]; o[dt][r] = v; ss[r] += v * v; }
#pragma unroll
        for (int r = 0; r < 16; ++r) { float x = row_sum16(ss[r]); x = swap16_sum(x, x);
            ss[r] = (1.f - lam_init(l)) / sqrtf(x * (1.f / 128.f) + EPS); }
        bf16_t* stg = (bf16_t*)(lds + ATT_STG + qg * 32 * ATT_STGROW);
#pragma unroll
        for (int dt = 0; dt < 4; ++dt) { const float sg = a.in[13][l * 128 + dt * 32 + r32];
#pragma unroll
            for (int r = 0; r < 16; ++r) stg[crow16(r, hi) * (ATT_STGROW / 2) + dt * 32 + r32] = (bf16_t)f2bf(o[dt][r] * ss[r] * sg); }
        asm volatile("s_waitcnt lgkmcnt(0)" ::: "memory");
#pragma unroll
        for (int i = 0; i < 8; ++i) { const int id = lane + 64 * i, row = id >> 4, c = id & 15;
            *(u32x4*)(MIX + (size_t)(qrow0 + row) * D + h * 128 + c * 8) = *(const u32x4*)((const unsigned char*)stg + row * ATT_STGROW + c * 16); }
    }
    __syncthreads();
}
constexpr int AT2_LW = 2 * ATT_BUF, AT2_STG = AT2_LW + 2048;
template <bool SHIFT> DEV void attn_unit2(const Args& a, int l, int b, int h, int qb, bool ctx, float lam, float bound2, float oml, unsigned char* lds) {
    const int tid = ltid(), lane = tid & 63, wave = __builtin_amdgcn_readfirstlane(tid >> 6), r32 = lane & 31, hi = lane >> 5;
    const bf16_t* Y = (const bf16_t*)(a.ws + WS_Y); const bf16_t* VT = (const bf16_t*)(a.ws + WS_VT); bf16_t* MIX = (bf16_t*)(a.ws + WS_MIX);
    const int NT = ctx ? 4 : 68;
    const float shift = bound2 > 96.f ? bound2 - 96.f : 0.f;
    const int qrow0 = (ctx ? ML + b * 256 : b * 4096) + qb * 256 + wave * 32;
    bf16x8_t qf[2][4];
    { const bf16_t* qp = Y + (size_t)(h >> 1) * YARR + (size_t)(qrow0 + r32) * 256 + (h & 1) * 128 + 8 * hi;
#pragma unroll
        for (int m = 0; m < 2; ++m)
#pragma unroll
            for (int s = 0; s < 4; ++s) qf[m][s] = *(const bf16x8_t*)(qp + m * 64 + 16 * s); }
    const bf16_t* Kg = Y + (size_t)(2 + (h >> 1)) * YARR + (h & 1) * 128;
    const bf16_t* Vg = VT + (size_t)(b * 4 + h) * 128 * 4352;
    typedef __attribute__((address_space(3))) unsigned char* lptr;
    lptr ldsl = (lptr)lds;
#define ATT_DMA(t, bufb) do { const int t_ = (t); const int ln_ = ltid() & 63; const bool isk_ = wave < 4; \
        const bf16_t* src_ = isk_ ? Kg + (size_t)(t_ < 4 ? ML + b * 256 + t_ * 64 : b * 4096 + (t_ - 4) * 64) * 256 + (wave >> 1) * 64 + (wave & 1) * 32 * 256 : Vg + t_ * 64 + (size_t)(wave - 4) * 32 * 4352; \
        const int st_ = isk_ ? 256 : 4352, ca_ = (ln_ & 7) ^ (ln_ >> 4), g0_ = (ln_ >> 3) * st_ + ca_ * 8, g1_ = (ln_ >> 3) * st_ + (ca_ ^ 4) * 8; \
        _Pragma("unroll") for (int i = 0; i < 4; ++i) \
            __builtin_amdgcn_global_load_lds((const unsigned*)(src_ + (size_t)(i * 8 * st_) + ((i & 1) ? g1_ : g0_)), (__attribute__((address_space(3))) unsigned*)(ldsl + (bufb) + (wave * 4 + i) * 1024), 16, 0, 0); } while (0)
    f32x16 o0[4], o1[4];
#pragma unroll
    for (int dt = 0; dt < 4; ++dt)
#pragma unroll
        for (int r = 0; r < 16; ++r) { o0[dt][r] = 0.f; o1[dt][r] = 0.f; }
    float lsum0 = 0.f, lsum1 = 0.f;
    ATT_DMA(0, 0);
    __builtin_amdgcn_s_waitcnt(0x0F70);
    __syncthreads();
    typedef const __attribute__((address_space(3))) bf16x8_t* fptr;
#pragma unroll 1
    for (int t = 0; t < NT; ++t) {
        const int buf = (t & 1) * ATT_BUF;
        if (t + 1 < NT) ATT_DMA(t + 1, ATT_BUF - buf);
        const int ln = ltid() & 63;
        const int r32l = ln & 31, hil = ln >> 5, sw = (r32l >> 1) & 7, kfo = r32l * ATT_KROW, vfo = ATT_VOFF + r32l * ATT_KROW;
        int coff[4];
#pragma unroll
        for (int ks = 0; ks < 4; ++ks) coff[ks] = ((2 * ks + hil) ^ sw) * 16;
#pragma unroll
        for (int kt = 0; kt < 2; ++kt) {
            bf16x8_t pf0[2], pf1[2];
#pragma unroll
            for (int m = 0; m < 2; ++m) {
                f32x16 s;
#pragma unroll
                for (int r = 0; r < 16; ++r) s[r] = 0.f;
#pragma unroll
                for (int ks = 0; ks < 4; ++ks) { const bf16x8_t kf = *(fptr)(ldsl + buf + m * ATT_KMAP + kfo + kt * 32 * ATT_KROW + coff[ks]); s = __builtin_amdgcn_mfma_f32_32x32x16_bf16(kf, qf[m][ks], s, 0, 0, 0); }
                if (SHIFT) {
#pragma unroll
                    for (int r = 0; r < 16; ++r) s[r] -= shift; }
                float ls = 0.f;
#pragma unroll
                for (int r = 0; r < 16; ++r) { s[r] = __builtin_amdgcn_exp2f(s[r]); ls += s[r]; }
                if (m == 0) lsum0 += ls; else lsum1 += ls;
#pragma unroll
                for (int sp = 0; sp < 2; ++sp) { u32x4 w; w.x = pk2(s[8 * sp], s[8 * sp + 1]); w.y = pk2(s[8 * sp + 2], s[8 * sp + 3]); w.z = pk2(s[8 * sp + 4], s[8 * sp + 5]); w.w = pk2(s[8 * sp + 6], s[8 * sp + 7]);
                    if (m == 0) pf0[sp] = __builtin_bit_cast(bf16x8_t, w); else pf1[sp] = __builtin_bit_cast(bf16x8_t, w); }
            }
#pragma unroll
            for (int dt = 0; dt < 4; ++dt)
#pragma unroll
                for (int sp = 0; sp < 2; ++sp) { const bf16x8_t vf = *(fptr)(ldsl + buf + vfo + dt * 32 * ATT_KROW + coff[2 * kt + sp]);
                    o0[dt] = __builtin_amdgcn_mfma_f32_32x32x16_bf16(pf0[sp], vf, o0[dt], 0, 0, 0); o1[dt] = __builtin_amdgcn_mfma_f32_32x32x16_bf16(pf1[sp], vf, o1[dt], 0, 0, 0); }
        }
        __builtin_amdgcn_s_waitcnt(0x0F70);
        __syncthreads();
    }
#undef ATT_DMA
    lsum0 = swap32_sum(lsum0, lsum0); lsum1 = swap32_sum(lsum1, lsum1);
    const int lane_e = ltid() & 63, r32e = lane_e & 31, hie = lane_e >> 5;
    float* LW = (float*)(lds + AT2_LW) + wave * 64;
    if (hie == 0) { LW[r32e] = lsum0; LW[32 + r32e] = lsum1; }
    asm volatile("s_waitcnt lgkmcnt(0)" ::: "memory");
    float ss[16];
#pragma unroll
    for (int r = 0; r < 16; ++r) { const float il0 = 1.f / LW[crow16(r, hie)], il1 = lam / LW[32 + crow16(r, hie)]; float acc = 0.f;
#pragma unroll
        for (int dt = 0; dt < 4; ++dt) { const float v = o0[dt][r] * il0 - o1[dt][r] * il1; o0[dt][r] = v; acc += v * v; }
        ss[r] = acc; }
#pragma unroll
    for (int r = 0; r < 16; ++r) { float x = row_sum16(ss[r]); x = swap16_sum(x, x);
        ss[r] = oml / sqrtf(x * (1.f / 128.f) + EPS); }
    bf16_t* stg = (bf16_t*)(lds + AT2_STG + wave * 32 * ATT_STGROW);
#pragma unroll
    for (int dt = 0; dt < 4; ++dt) { const float sg = a.in[13][l * 128 + dt * 32 + r32e];
#pragma unroll
        for (int r = 0; r < 16; ++r) stg[crow16(r, hie) * (ATT_STGROW / 2) + dt * 32 + r32e] = (bf16_t)f2bf(o0[dt][r] * ss[r] * sg); }
    asm volatile("s_waitcnt lgkmcnt(0)" ::: "memory");
    const int lane_s = ltid() & 63;
#pragma unroll
    for (int i = 0; i < 8; ++i) { const int id = lane_s + 64 * i, row = id >> 4, c = id & 15;
        *(u32x4*)((bf16_t*)(a.ws + WS_MIX) + (size_t)((ctx ? ML + b * 256 : b * 4096) + qb * 256 + wave * 32 + row) * D + h * 128 + c * 8) = *(const u32x4*)((const unsigned char*)stg + row * ATT_STGROW + c * 16); }
    __syncthreads();
}
DEV void p4_attn_mfma(const Args& a, int l, unsigned char* lds) {
    const float lam = __uint_as_float(__builtin_amdgcn_readfirstlane(__float_as_uint(att_lambda(a, l)))), bound2 = __uint_as_float(__builtin_amdgcn_readfirstlane(__float_as_uint(att_bound2(a, l))));
    const float oml = __uint_as_float(__builtin_amdgcn_readfirstlane(__float_as_uint(1.f - lam_init(l))));
    const int nlat = NB * 4 * 16, nctx = l == 0 ? NB * 4 : 0;
    for (int it = blockIdx.x; it < nlat + nctx; it += gridDim.x) {
        const bool ctx = it >= nlat; const int i2 = it - nlat;
        const int qb = ctx ? 0 : (it & 15), h = ctx ? (i2 & 3) : ((it >> 4) & 3), b = ctx ? (i2 >> 2) : (it >> 6);
        if (bound2 > 96.f) attn_unit2<true>(a, l, b, h, qb, ctx, lam, bound2, oml, lds); else attn_unit2<false>(a, l, b, h, qb, ctx, lam, bound2, oml, lds);
    }
}
DEV void p4_attn_simple(const Args& a, int l, float* lds) {
    const float lam = att_lambda(a, l), bound2 = att_bound2(a, l);
    const int nlat = NB * 4 * 64, nctx = l == 0 ? NB * 4 * 4 : 0;
    for (int it = blockIdx.x; it < nlat + nctx; it += gridDim.x) {
        if (it < nlat) { const int qb = it & 63, h = (it >> 6) & 3, b = it >> 8; attn_simple_item(a, l, b, h, qb, false, lam, bound2, lds); }
        else { const int i2 = it - nlat, qb = i2 & 3, h = (i2 >> 2) & 3, b = i2 >> 4; attn_simple_item(a, l, b, h, qb, true, lam, bound2, lds); }
    }
}

template <int R, bool LAT> DEV void p7_rows(const Args& a, int l, const float* RW, int row_lo, int ngroups, int lane, int gw, int NGW) {
    unsigned char* XN8 = a.ws + WS_XN; bf16_t* XN = (bf16_t*)(a.ws + WS_XN); float* PL = (float*)(a.ws + WS_PROBL); float* PC = (float*)(a.ws + WS_PROBC);
    const int b3 = (lane >> 3) & 1, b2 = (lane >> 2) & 1, my_e = (lane >> 5) * 8 + ((lane >> 4) & 1) * 4 + b3 * 2 + b2;
    constexpr bool lat = LAT;
    u32x2 pre[LAT ? R : 1][4]; f32x4 prf[LAT ? 1 : R][4];
#define P7_LOAD(gg) do { const int r0_ = row_lo + (gg) * R; \
        if constexpr (LAT) { _Pragma("unroll") for (int q = 0; q < R; ++q) { const bf16_t* s_ = resrow(a, r0_ + q); _Pragma("unroll") for (int j = 0; j < 4; ++j) pre[q][j] = *(const u32x2*)(s_ + 256 * j + 4 * lane); } } \
        else { _Pragma("unroll") for (int q = 0; q < R; ++q) { const float* s_ = (const float*)(a.ws + WS_XC) + (size_t)(r0_ + q - ML) * D; _Pragma("unroll") for (int j = 0; j < 4; ++j) prf[q][j] = *(const f32x4*)(s_ + 256 * j + 4 * lane); } } } while (0)
    if (gw < ngroups) P7_LOAD(gw);
    for (int g = gw; g < ngroups; g += NGW) {
        const int r0 = row_lo + g * R;
        f32x4 v[R][4];
#pragma unroll
        for (int q = 0; q < R; ++q)
#pragma unroll
            for (int j = 0; j < 4; ++j) { if constexpr (LAT) v[q][j] = (f32x4){bf2f(pre[q][j].x & 0xffffu), bf2f(pre[q][j].x >> 16), bf2f(pre[q][j].y & 0xffffu), bf2f(pre[q][j].y >> 16)}; else v[q][j] = prf[q][j]; }
        if (g + NGW < ngroups) P7_LOAD(g + NGW);
        float rstd[R];
#pragma unroll
        for (int q = 0; q < R; ++q) { float ss = 0.f;
#pragma unroll
            for (int j = 0; j < 4; ++j) ss += (v[q][j].x * v[q][j].x + v[q][j].y * v[q][j].y) + (v[q][j].z * v[q][j].z + v[q][j].w * v[q][j].w);
            rstd[q] = __builtin_amdgcn_rsqf(wave_sum(ss) * (1.f / D) + EPS); }
        const float* gp = a.in[7] + l * D; const float* sh = modp(a, l, modrow(r0), 3); const float* sc = modp(a, l, modrow(r0), 4);
#pragma unroll
        for (int j = 0; j < 4; ++j) {
            const int c0 = 256 * j + 4 * lane; const f32x4 gm = *(const f32x4*)(gp + c0) * (1.f + *(const f32x4*)(sc + c0)), s0 = *(const f32x4*)(sh + c0);
#pragma unroll
            for (int q = 0; q < R; ++q) { const f32x4 y = v[q][j] * rstd[q] * gm + s0;
                if (USE_FP8_MOE1) *(unsigned*)(XN8 + (size_t)(r0 + q) * D + c0) = pk_fp8x4(y.x, y.y, y.z, y.w); else { float t[4] = {y.x, y.y, y.z, y.w}; st4bf(XN + (size_t)(r0 + q) * D + c0, t); }
                v[q][j] = y; }
        }
        f32x2_t lg2[R][8];
#pragma unroll
        for (int q = 0; q < R; ++q)
#pragma unroll
            for (int e = 0; e < 8; ++e) lg2[q][e] = (f32x2_t){0.f, 0.f};
        { f32x4 wc[4], wn[4];
#pragma unroll
            for (int e4 = 0; e4 < 4; ++e4) wc[e4] = *(const f32x4*)(RW + ((e4 * 64 + lane) * 4));
#pragma unroll
            for (int k = 0; k < 16; ++k) { const int j = k >> 2, i = k & 3;
                if (k + 1 < 16) {
#pragma unroll
                    for (int e4 = 0; e4 < 4; ++e4) wn[e4] = *(const f32x4*)(RW + ((((k + 1) * 4 + e4) * 64 + lane) * 4)); }
#pragma unroll
                for (int e4 = 0; e4 < 4; ++e4)
#pragma unroll
                    for (int q = 0; q < R; ++q) { const float t = i == 0 ? v[q][j].x : i == 1 ? v[q][j].y : i == 2 ? v[q][j].z : v[q][j].w;
                        const f32x2_t t2 = {t, t};
                        lg2[q][e4 * 2] = __builtin_elementwise_fma(t2, (f32x2_t){wc[e4].x, wc[e4].y}, lg2[q][e4 * 2]); lg2[q][e4 * 2 + 1] = __builtin_elementwise_fma(t2, (f32x2_t){wc[e4].z, wc[e4].w}, lg2[q][e4 * 2 + 1]); }
                __builtin_amdgcn_sched_barrier(0);
#pragma unroll
                for (int e4 = 0; e4 < 4; ++e4) wc[e4] = wn[e4]; } }
        float a1 = 0.f;
#pragma unroll
        for (int q = 0; q < R; ++q) { float a8[8], a4[4], a2[2], t1;
#pragma unroll
            for (int i = 0; i < 8; ++i) a8[i] = swap32_sum(lg2[q][i >> 1][i & 1], lg2[q][4 + (i >> 1)][i & 1]);
#pragma unroll
            for (int i = 0; i < 4; ++i) a4[i] = swap16_sum(a8[i], a8[4 + i]);
#pragma unroll
            for (int i = 0; i < 2; ++i) { const float snd = b3 ? a4[i] : a4[2 + i], kp = b3 ? a4[2 + i] : a4[i]; a2[i] = kp + dppf<DPP_X8>(snd); }
            { const float snd = b2 ? a2[0] : a2[1], kp = b2 ? a2[1] : a2[0]; t1 = kp + dppf<DPP_X7>(snd); }
            t1 = row_sum4(t1);
            if (R == 1 || (lane & 3) == q) a1 = t1; }
        float mx = a1;
        mx = fmaxf(mx, dppf<DPP_X7>(dppf<DPP_X3>(mx))); mx = fmaxf(mx, dppf<DPP_X8>(mx)); mx = swap16_max(mx); mx = swap32_max(mx);
        const float pe = __builtin_amdgcn_exp2f((a1 - mx) * 1.4426950408889634f); float den = pe;
        den += dppf<DPP_X7>(dppf<DPP_X3>(den)); den += dppf<DPP_X8>(den); den = swap16_sum(den, den); den = swap32_sum(den, den);
        if (R == 4 || (lane & 3) == 0) { const float p = pe * __builtin_amdgcn_rcpf(den); const int r = r0 + (R == 4 ? (lane & 3) : 0);
            if (r < ML) PL[((size_t)(r >> 12) * 16 + my_e) * 4096 + (r & 4095)] = p; else PC[((size_t)((r - ML) >> 8) * 16 + my_e) * 256 + ((r - ML) & 255)] = p; }
    }
#undef P7_LOAD
}
DEV void p7_norm2_router(const Args& a, int l, float* lds) {
    const int tid = ltid(), lane = tid & 63, wave = tid >> 6;
    const int gw = blockIdx.x * NWAVES + wave, NGW = gridDim.x * NWAVES;
    float* RW = lds;
    for (int i = tid; i < 1024 * 16 / 4; i += NTHREADS) {
        const int col = i >> 2, e4 = i & 3, jj = col >> 8, ln = (col & 255) >> 2, ii = col & 3;
        *(f32x4*)(RW + ((((jj * 4 + ii) * 4 + e4) * 64 + ln) * 4)) = *(const f32x4*)(a.in[22] + (size_t)l * 1024 * 16 + i * 4); }
    __syncthreads();
    p7_rows<4, true>(a, l, RW, 0, ML / 4, lane, gw, NGW);
    if (l == 0) p7_rows<1, false>(a, l, RW, ML, MC, lane, gw, NGW);
}
DEV void p8_topk(const Args& a, int l, float* ldsf) {
    const int tid = ltid(), lane = tid & 63, wave = tid >> 6;
    unsigned* hist = (unsigned*)ldsf;
    unsigned* res = hist + 320;
    unsigned* wtot = hist + 384;
    int* sidx = (int*)(hist + 512);
    const float* PL = (const float*)(a.ws + WS_PROBL); const float* PC = (const float*)(a.ws + WS_PROBC);
    int* IDX = (int*)(a.ws + WS_IDX); float* AFF = (float*)(a.ws + WS_AFF); int* SEL = (int*)(a.ws + WS_SEL);
    const bf16_t* XN = (const bf16_t*)(a.ws + WS_XN); bf16_t* XG = (bf16_t*)(a.ws + WS_XG);
    const int nitems = l == 0 ? 256 : 128;
    for (int it = blockIdx.x; it < nitems; it += gridDim.x) {
        const bool isctx = it >= 128; const int be = it & 127, b = be >> 4, e = be & 15;
        const int k = isctx ? CAPC : CAPL;
        const float* p = isctx ? PC + (size_t)(b * 16 + e) * 256 : PL + (size_t)(b * 16 + e) * 4096;
        const int rowbase = isctx ? ML + b * 256 : b * 4096, slotbase = isctx ? NB * CAPL + b * CAPC : b * CAPL;
        const int cnt = isctx ? (tid < 256 ? 1 : 0) : 8, i0 = isctx ? tid : tid * 8;
        unsigned key[8];
#pragma unroll
        for (int j = 0; j < 8; ++j) key[j] = j < cnt ? __float_as_uint(p[i0 + j]) : 0u;
        unsigned prefix = 0u, mask = 0u; int krem = k;
        for (int pass = 0; pass < 4; ++pass) {
            const int shift = 24 - 8 * pass;
            if (tid < 257) hist[tid] = 0u;
            __syncthreads();
#pragma unroll
            for (int j = 0; j < 8; ++j) if (j < cnt && (key[j] & mask) == prefix) atomicAdd(&hist[(key[j] >> shift) & 255u], 1u);
            __syncthreads();

            if (wave == 0) {
                const unsigned h0 = hist[4 * lane], h1 = hist[4 * lane + 1], h2 = hist[4 * lane + 2], h3 = hist[4 * lane + 3], tot = h0 + h1 + h2 + h3;
                unsigned sfx = tot;
#pragma unroll
                for (int o = 1; o < 64; o <<= 1) { const unsigned t = __shfl_down(sfx, o); if (lane + o < 64) sfx += t; }
                const unsigned above = sfx - tot, s3 = above + h3, s2 = s3 + h2, s1 = s2 + h1, s0 = s1 + h0, kr = (unsigned)krem;
                if (s3 >= kr && above < kr) { res[0] = 4 * lane + 3; res[1] = kr - above; }
                else if (s2 >= kr && s3 < kr) { res[0] = 4 * lane + 2; res[1] = kr - s3; }
                else if (s1 >= kr && s2 < kr) { res[0] = 4 * lane + 1; res[1] = kr - s2; }
                else if (s0 >= kr && s1 < kr) { res[0] = 4 * lane; res[1] = kr - s1; }
            }
            __syncthreads();
            prefix |= res[0] << shift; mask |= 255u << shift; krem = (int)res[1];
            __syncthreads();
        }
        const unsigned Tk = prefix;
        unsigned cntp = 0u;
#pragma unroll
        for (int j = 0; j < 8; ++j) if (j < cnt) cntp += (key[j] > Tk ? 1u : 0u) + (key[j] == Tk ? 65536u : 0u);
        unsigned sc = cntp;
#pragma unroll
        for (int o = 1; o < 64; o <<= 1) { const unsigned t = __shfl_up(sc, o); if (lane >= o) sc += t; }
        if (lane == 63) wtot[wave] = sc;
        __syncthreads();
        unsigned woff = 0u;
        for (int w = 0; w < wave; ++w) woff += wtot[w];
        unsigned ex = woff + sc - cntp;
        unsigned gtr = ex & 0xffffu, eqr = ex >> 16;
        const int total_gt = k - krem;
#pragma unroll
        for (int j = 0; j < 8; ++j) if (j < cnt) {
            int slot = -1;
            if (key[j] > Tk) { slot = (int)gtr; ++gtr; }
            else if (key[j] == Tk) { if ((int)eqr < krem) slot = total_gt + (int)eqr; ++eqr; }
            const int row = rowbase + i0 + j;
            SEL[(size_t)row * 16 + e] = slot >= 0 ? slotbase + slot : -1;
            if (slot >= 0) { IDX[e * SLOTS + slotbase + slot] = row; AFF[e * SLOTS + slotbase + slot] = __uint_as_float(key[j]); sidx[slot] = row; }
        }
        __syncthreads();
    }
}
DEV void p8_gather(const Args& a, int l) {
    const int tid = ltid(), lane = tid & 63, wave = tid >> 6;
    const int gw = blockIdx.x * NWAVES + wave, NGW = gridDim.x * NWAVES;
    const int* IDX = (const int*)(a.ws + WS_IDX); const unsigned char* XN8 = a.ws + WS_XN; unsigned char* XG8 = a.ws + WS_XG;
    const int per_e = l == 0 ? SLOTS : NB * CAPL, total = 16 * per_e;
    for (int base = gw * 8; base < total; base += NGW * 8) {
        u32x4 v[8]; size_t dsto[8];
#pragma unroll
        for (int i = 0; i < 8; ++i) { const int R = base + i, e = R / per_e, s = R - e * per_e; const int row = __builtin_amdgcn_readfirstlane(IDX[e * SLOTS + s]);
            dsto[i] = ((size_t)e * SLOTS + s) * 1024; v[i] = *(const u32x4*)(XN8 + (size_t)row * 1024 + lane * 16); }
#pragma unroll
        for (int i = 0; i < 8; ++i) *(u32x4*)(XG8 + dsto[i] + lane * 16) = v[i];
    }
}


#define LAS __attribute__((address_space(3)))
#define XB_TMO      128
#define XB_XCNT(j)  (256  + 64 * (j))
#define XB_XSUB(j)  (1280 + 64 * (j))
#define XB_XGEN(j)  (2304 + 64 * (j))
#define XB_TOP      3328
#define XB_TOPGEN   3392
#define XCD_BAR_WORDS 3456
#define XB_SPIN_CAP (1u << 18)

__device__ __forceinline__ unsigned xb_ld(unsigned* p)              { return __hip_atomic_load(p, __ATOMIC_RELAXED, __HIP_MEMORY_SCOPE_AGENT); }
__device__ __forceinline__ unsigned xb_add(unsigned* p, unsigned v) { return __hip_atomic_fetch_add(p, v, __ATOMIC_RELAXED, __HIP_MEMORY_SCOPE_AGENT); }
__device__ __forceinline__ unsigned xb_xcc_id() { return (unsigned)__builtin_amdgcn_s_getreg((3 << 11) | 20) & 0xFu; }
#define XB_SPIN(cond, bar) do { unsigned _sp = 0; while (cond) { __builtin_amdgcn_s_sleep(1); \
    if ((++_sp & 255u) == 0u) { if (xb_ld(&(bar)[XB_TMO])) break; if (_sp > XB_SPIN_CAP) { atomicAdd(&(bar)[XB_TMO], 1u); break; } } } } while (0)

struct XcdBarrier {
    unsigned* bar; unsigned x;
    volatile LAS unsigned* st;
};

__device__ __forceinline__ XcdBarrier xcd_barrier_post(unsigned* bar, volatile LAS unsigned* st) {
    XcdBarrier b; b.bar = bar; b.x = xb_xcc_id(); b.st = st;
    if (threadIdx.x == 0) (void)xb_add(&bar[XB_XCNT(b.x)], 1u);
    return b;
}
__device__ __forceinline__ void xcd_barrier_complete(unsigned* bar, unsigned x, unsigned& nloc, unsigned& nx) {
    const unsigned G = gridDim.x * gridDim.y * gridDim.z;
    unsigned sum, cnt, mine, sp = 0u;
    for (;;) {
        sum = 0u; cnt = 0u; mine = 0u;
#pragma unroll
        for (unsigned j = 0; j < 16; ++j) { const unsigned c = xb_ld(&bar[XB_XCNT(j)]); sum += c; cnt += (c > 0u) ? 1u : 0u; mine = (j == x) ? c : mine; }
        if (sum == G) break;
        __builtin_amdgcn_s_sleep(1);
        if ((++sp & 255u) == 0u) { if (xb_ld(&bar[XB_TMO])) break; if (sp > XB_SPIN_CAP) { atomicAdd(&bar[XB_TMO], 1u); break; } }
    }
    nloc = mine > 0u ? mine : 1u; nx = cnt > 0u ? cnt : 1u;
}

__device__ __forceinline__ void xcd_barrier(const XcdBarrier& b) {
    asm volatile("s_waitcnt vmcnt(0)" ::: "memory");
    __syncthreads();
    if (threadIdx.x == 0) {
        unsigned* bar = b.bar;
        __builtin_amdgcn_s_waitcnt(0);
        unsigned nloc = b.st[0], nx = b.st[1];
        if (nloc == 0u) { xcd_barrier_complete(bar, b.x, nloc, nx); b.st[0] = nloc; b.st[1] = nx; }
        const unsigned old = xb_add(&bar[XB_XSUB(b.x)], 1u);
        const unsigned gen = old / nloc;
        if (old + 1u == (gen + 1u) * nloc) {
            __builtin_amdgcn_fence(__ATOMIC_RELEASE, "agent");
            asm volatile("s_waitcnt vmcnt(0)" ::: "memory");
            const unsigned og = xb_add(&bar[XB_TOP], 1u);
            const unsigned tg = og / nx;
            if (og + 1u == (tg + 1u) * nx) xb_add(&bar[XB_TOPGEN], 1u);
            else XB_SPIN(xb_ld(&bar[XB_TOPGEN]) == tg, bar);
            __builtin_amdgcn_fence(__ATOMIC_ACQUIRE, "agent");
            xb_add(&bar[XB_XGEN(b.x)], 1u);
            asm volatile("s_waitcnt vmcnt(0)" ::: "memory");
        } else {
            XB_SPIN(xb_ld(&bar[XB_XGEN(b.x)]) == gen, bar);
            __builtin_amdgcn_fence(__ATOMIC_ACQUIRE, "agent");
            asm volatile("s_waitcnt vmcnt(0)" ::: "memory");
        }
    }
    __syncthreads();
}
constexpr int NPHASES = 22;
#ifndef DUP
#define DUP 0
#endif
#define REP(bit) for (int rep_ = 0; rep_ < (((DUP) & (bit)) ? 2 : 1); ++rep_)
template <int PH> DEV void run_phase(const Args& a, float* lds) {
    if constexpr (PH == 0) { if (PM & 1) p0_mod(a, lds); }
    else if constexpr (PH == NPHASES - 1) { if ((PM & 2) && (PM & 32768)) p1_norm<2>(a); }
    else {
        constexpr int l = (PH - 1) / 10, s = (PH - 1) % 10;
        if constexpr (s == 0) { if (PM & 4) { REP(2048) { p1_weights(a, l, lds); } if (l == 0) p1_norm<0>(a); else p1_norm<1, (PM & 32768) != 0>(a); } }
        if constexpr (s == 1) { if (PM & 8) REP(1) { if (USE_MFMA_GEMM) p2_inproj_mfma(a, l, (unsigned char*)lds); else p2_inproj_simple(a, l, lds); } }
        if constexpr (s == 2) { if (PM & 16) { if (USE_MFMA_ATTN) { REP(4096) { p3_vt(a, lds); __syncthreads(); } } } if (PM & 32) REP(2) { if (USE_MFMA_RET) p3_ret_prep(a, l, (unsigned char*)lds); else p3_retU(a, l, lds); } __syncthreads(); if (PM & 64) REP(4) { if (USE_MFMA_LRU) p3_lru_agg_mfma(a, l, lds); else p3_lru_agg(a, l, lds); } }
        if constexpr (s == 3) { if (PM & 128) { p4_lru_carry(a, lds); p4_ret_scan(a, l); } if (PM & 256) REP(8) { if (USE_MFMA_ATTN) p4_attn_mfma(a, l, (unsigned char*)lds); else p4_attn_simple(a, l, lds); } }
        if constexpr (s == 4) { if (PM & 512) REP(16) { if (USE_MFMA_RET) p5_ret_out_dma(a, l, (unsigned char*)lds); else p5_ret_out(a, l, lds); } __syncthreads(); if (PM & 1024) REP(32) { if (USE_MFMA_LRU) p5_lru_out_mfma(a, l, lds); else p5_lru_out(a, l, lds); } }
        if constexpr (s == 5) { if (PM & 2048) { if (USE_MFMA_GEMM) p6_outproj_mfma(a, l, (unsigned char*)lds); else p6_outproj_simple(a, l, lds); } }
        if constexpr (s == 6) { if (PM & 4096) REP(128) { p7_norm2_router(a, l, lds); __syncthreads(); } }
        if constexpr (s == 7) { if (PM & 8192) REP(256) { p8_topk(a, l, lds); } }
        if constexpr (s == 8) { if (PM & 16384) REP(512) { if (USE_MFMA_GEMM) p9_moe1_mfma(a, l, (unsigned char*)lds); else p9_moe1_simple(a, l, lds); } }
        if constexpr (s == 9) { if (PM & 32768) REP(1024) { if (USE_MFMA_GEMM) p10_moe2_mfma(a, l, (unsigned char*)lds); else p10_moe2_simple(a, l, lds); } }
    }
}
typedef const __attribute__((address_space(4))) Args* KArgP;
template <int PH> DEV void run_from(KArgP ap, float* lds, const XcdBarrier& bar) {
    asm volatile("" : "+s"(ap));
    run_phase<PH>(*(const Args*)ap, lds);
    if constexpr (PH + 1 < NPHASES) {
        if constexpr (PH == 0) { if (((const Args*)ap)->ph_lo < 0) cg::this_grid().sync(); }
        xcd_barrier(bar);
        run_from<PH + 1>(ap, lds, bar);
    }
}
template <int PH> DEV void run_one(const Args& a, float* lds, int ph) {
    if (ph == PH) { run_phase<PH>(a, lds); return; }
    if constexpr (PH + 1 < NPHASES) run_one<PH + 1>(a, lds, ph);
}
__global__ void __launch_bounds__(NTHREADS, 2) mega(Args a) {
    extern __shared__ __attribute__((aligned(16))) unsigned char lds_raw[];
    float* lds = (float*)lds_raw;

#if N_LAUNCH_MODE == 1
    volatile LAS unsigned* bst = (volatile LAS unsigned*)((LAS unsigned char*)lds_raw + (LDS_BYTES - 64));
    if (ltid() < 16) bst[ltid()] = 0u;
    __syncthreads();
    XcdBarrier bar = xcd_barrier_post((unsigned*)(a.ws + WS_CTL) + 4096, bst);
    run_from<0>((KArgP)__builtin_amdgcn_kernarg_segment_ptr(), lds, bar);
#else
    run_one<0>(a, lds, a.ph_lo);
#endif

}

extern "C" void kernel_launch(void* const* d_in, const int* in_sizes, int n_in, void* d_out, int out_size, void* d_ws, size_t ws_size, hipStream_t stream) {
    static int grid = 0;
    if (grid == 0) {
        if (n_in != 26 || out_size != ML * D || ws_size < WS_END) { fprintf(stderr, "kernel_launch: unexpected shapes (n_in %d out %d ws %zu)\n", n_in, out_size, ws_size); grid = -1; return; }
        int dev = 0, cus = 0, per_cu = 0;
        hipGetDevice(&dev); hipDeviceGetAttribute(&cus, hipDeviceAttributeMultiprocessorCount, dev);
        hipFuncSetAttribute((const void*)mega, hipFuncAttributeMaxDynamicSharedMemorySize, LDS_BYTES);
        hipOccupancyMaxActiveBlocksPerMultiprocessor(&per_cu, (const void*)mega, NTHREADS, LDS_BYTES);
        (void)hipGetLastError();
        if (per_cu < 1) { fprintf(stderr, "kernel_launch: occupancy query says %d blocks per CU\n", per_cu); grid = -1; return; }
        grid = cus;
    }
    if (grid < 0) return;
    hipMemsetAsync((char*)d_ws + WS_CTL, 0, 1 * MiB, stream);
    Args a{};
    for (int i = 0; i < 26; ++i) a.in[i] = (const float*)d_in[i];
    a.out = (float*)d_out; a.ws = (unsigned char*)d_ws;

#if N_LAUNCH_MODE == 1
    a.ph_lo = 0; a.ph_hi = NPHASES;
    void* args[] = {&a};
    hipError_t e = hipLaunchCooperativeKernel((const void*)mega, dim3(grid), dim3(NTHREADS), args, LDS_BYTES, stream);
    if (e != hipSuccess) fprintf(stderr, "cooperative launch failed: %s (grid %d)\n", hipGetErrorString(e), grid);
#else
#ifndef PH_STOP
#define PH_STOP NPHASES
#endif
    for (int ph = 0; ph < PH_STOP; ++ph) { a.ph_lo = ph; a.ph_hi = ph + 1; hipLaunchKernelGGL(mega, dim3(grid), dim3(NTHREADS), LDS_BYTES, stream, a); }
#endif

}
```
